# Optimizing an MI355X kernel written in HIP

```python
import math
import jax
import jax.numpy as jnp
from jax import lax
import numpy as np

D_MODEL = 1024
BATCH = 16
SEQ = 4096
DEPTH = 2

MEM_LEN = 256
HEAD_DIM = 64
ROPE_THETA = 500000.0
ROPE_FRACTION = 4
NORM_EPS = 1e-5

DIL_PATTERNS = ((128, 1), (512, 4), (2048, 16))
DIL_GROUPS = len(DIL_PATTERNS)
DIL_HEADS = 4
DIL_BLOCK = 128
DIL_WIDTH = DIL_HEADS * HEAD_DIM
DIFF_HEADS = 4
DIFF_WIDTH = DIFF_HEADS * 2 * HEAD_DIM
Q_BLOCK = 128
HGRN_HEADS = 4
HGRN_DK = 64
HGRN_DV = 64
HGRN_CHUNK = 64
HGRN_KW = HGRN_HEADS * HGRN_DK
HGRN_VW = HGRN_HEADS * HGRN_DV
RWKV_HEADS = 4
RWKV_HEAD_DIM = 64
RWKV_WIDTH = RWKV_HEADS * RWKV_HEAD_DIM
RWKV_DECAY_LORA = 64
RWKV_A_LORA = 64
RWKV_MV_LORA = 32
RWKV_GATE_LORA = 128
RWKV_GN_EPS = 1e-5 * RWKV_HEAD_DIM
N_BRANCH = 4
SEG_A = DIL_GROUPS * 3 * DIL_WIDTH
SEG_B = 3 * DIFF_WIDTH
SEG_C = 2 * HGRN_KW + 2 * HGRN_VW
SEG_D = 3 * RWKV_WIDTH + RWKV_DECAY_LORA + RWKV_A_LORA + RWKV_GATE_LORA
SEG_G = N_BRANCH * D_MODEL
SEGMENTS = (SEG_A, SEG_B, SEG_C, SEG_D, SEG_G)
N_IN = SEG_A + SEG_B + SEG_C + SEG_D + SEG_G
MEM_HEADS = 4
MEM_HEAD_DIM = D_MODEL // MEM_HEADS
D_FF = 2816
CONV_WIDTH = 3

kernel_name = 'hybrid_gated_parallel_mixer_trunk'
F32 = jnp.float32


def split_last(t, sizes):
    return jnp.split(t, np.cumsum(sizes)[:-1].tolist(), axis=-1)


def to_heads(t, n_heads):
    return t.reshape(t.shape[:-1] + (n_heads, t.shape[-1] // n_heads))


def rms_norm(x, g, eps=NORM_EPS):
    xf = x.astype(F32)
    y = xf * lax.rsqrt(jnp.mean(xf * xf, axis=-1, keepdims=True) + eps)
    return (y * g.astype(F32)).astype(x.dtype)


def partial_rotary(t, positions):
    rot = t.shape[-1] // ROPE_FRACTION
    half = rot // 2
    inv_freq = ROPE_THETA ** (-jnp.arange(half, dtype=F32) / half)
    ang = positions.astype(F32)[:, :, None, None] * inv_freq
    cos, sin = jnp.cos(ang), jnp.sin(ang)
    tf = t.astype(F32)
    t1, t2 = tf[..., :half], tf[..., half:rot]
    out = jnp.concatenate([t1 * cos - t2 * sin, t2 * cos + t1 * sin, tf[..., rot:]], axis=-1)
    return out.astype(t.dtype)


def dilated_window_attention(q, k, v, window, dilation):
    B, S, H, dh = q.shape
    span = window // dilation
    blk = DIL_BLOCK
    unit = dilation * blk
    s_pad = -(-S // unit) * unit
    sub_len = s_pad // dilation
    nb = sub_len // blk

    def to_blocks(t):
        t = jnp.pad(t, ((0, 0), (0, s_pad - S), (0, 0), (0, 0)))
        t = t.reshape(B, sub_len, dilation, H, dh).transpose(0, 2, 3, 1, 4)
        return t.reshape(B, dilation, H, nb, blk, dh)

    def with_prev(t):
        prev = jnp.pad(t[:, :, :, :-1], ((0, 0), (0, 0), (0, 0), (1, 0), (0, 0), (0, 0)))
        return jnp.concatenate([prev, t], axis=4)

    qb = to_blocks(q)
    kb = with_prev(to_blocks(k))
    vb = with_prev(to_blocks(v))
    s = jnp.einsum('brhnqd,brhnkd->brhnqk', qb, kb).astype(F32) * dh ** -0.5
    qi = jnp.arange(blk)[None, :, None]
    kj = jnp.arange(2 * blk)[None, None, :]
    bi = jnp.arange(nb)[:, None, None]
    dist = qi + blk - kj
    valid = (dist >= 0) & (dist <= span) & (bi * blk + kj >= blk)
    s = jnp.where(valid, s, -jnp.inf)
    m = jnp.max(s, axis=-1, keepdims=True)
    p = jnp.exp(s - m)
    den = jnp.sum(p, axis=-1, keepdims=True)
    o = jnp.einsum('brhnqk,brhnkd->brhnqd', (p / den).astype(v.dtype), vb)
    lse = (m + jnp.log(den))[..., 0]
    o = o.reshape(B, dilation, H, sub_len, dh).transpose(0, 3, 1, 2, 4).reshape(B, s_pad, H, dh)
    lse = lse.reshape(B, dilation, H, sub_len).transpose(0, 3, 1, 2).reshape(B, s_pad, H)
    return o[:, :S], lse[:, :S]


def dilated_branch(seg, positions):
    B, S, _ = seg.shape
    qkv = seg.reshape(B, S, DIL_GROUPS, 3, DIL_HEADS, HEAD_DIM)
    outs, lses = [], []
    for g, (window, dilation) in enumerate(DIL_PATTERNS):
        q = partial_rotary(qkv[:, :, g, 0], positions)
        k = partial_rotary(qkv[:, :, g, 1], positions)
        o, lse = dilated_window_attention(q, k, qkv[:, :, g, 2], window, dilation)
        outs.append(o)
        lses.append(lse)
    wts = jax.nn.softmax(jnp.stack(lses, 0), axis=0).astype(seg.dtype)
    o = jnp.einsum('gbsh,gbshd->bshd', wts, jnp.stack(outs, 0))
    return o.reshape(B, S, DIL_WIDTH)


def differential_attention(q1, q2, k1, k2, v, lam):
    B, S, H, d = q1.shape
    nb = S // Q_BLOCK
    scale = d ** -0.5
    kpos = jnp.arange(S)

    def blocks(t):
        return jnp.moveaxis(t.reshape(B, nb, Q_BLOCK, H, d), 1, 0)

    def probs(qx, kx, mask):
        s = jnp.einsum('bqhd,bkhd->bhqk', qx, kx).astype(F32) * scale
        return jax.nn.softmax(jnp.where(mask, s, -jnp.inf), axis=-1)

    def one_block(args):
        i, qa, qb = args
        mask = kpos[None, :] <= (i * Q_BLOCK + jnp.arange(Q_BLOCK))[:, None]
        p = probs(qa, k1, mask) - lam * probs(qb, k2, mask)
        return jnp.einsum('bhqk,bkhe->bqhe', p.astype(v.dtype), v)

    o = lax.map(one_block, (jnp.arange(nb), blocks(q1), blocks(q2)))
    return jnp.moveaxis(o, 0, 1).reshape(B, S, H, v.shape[-1])


def diff_branch(seg, positions, lam_vecs, norm_g, lam_init):
    B, S, _ = seg.shape
    q, k, v = split_last(seg, (DIFF_WIDTH, DIFF_WIDTH, DIFF_WIDTH))
    q = q.reshape(B, S, DIFF_HEADS, 2, HEAD_DIM)
    k = k.reshape(B, S, DIFF_HEADS, 2, HEAD_DIM)
    q1 = partial_rotary(q[:, :, :, 0], positions)
    q2 = partial_rotary(q[:, :, :, 1], positions)
    k1 = partial_rotary(k[:, :, :, 0], positions)
    k2 = partial_rotary(k[:, :, :, 1], positions)
    v = v.reshape(B, S, DIFF_HEADS, 2 * HEAD_DIM)
    lv = lam_vecs.astype(F32)
    lam = jnp.exp(jnp.sum(lv[0] * lv[1])) - jnp.exp(jnp.sum(lv[2] * lv[3])) + lam_init
    o = differential_attention(q1, q2, k1, k2, v, lam)
    o = rms_norm(o, norm_g) * (1.0 - lam_init)
    return o.reshape(B, S, DIFF_WIDTH)


def hgrn2_chunked(q, log_f, k, i):
    B, S, H, dk = q.shape
    dv = i.shape[-1]
    C = HGRN_CHUNK
    n = S // C

    def chunks(t):
        return t.astype(F32).reshape(B, n, C, H, t.shape[-1]).transpose(1, 0, 3, 2, 4)

    causal = jnp.tril(jnp.ones((C, C), dtype=bool))[:, :, None]

    def step(state, xs):
        qc, lfc, kc, ic = xs
        b = jnp.cumsum(lfc, axis=2)
        o_inter = jnp.einsum('bhck,bhkv->bhcv', qc * jnp.exp(b), state)
        diff = b[:, :, :, None, :] - b[:, :, None, :, :]
        decay = jnp.exp(jnp.where(causal, diff, -jnp.inf))
        att = jnp.einsum('bhtk,bhtsk,bhsk->bhts', qc, decay, kc)
        o = o_inter + jnp.einsum('bhts,bhsv->bhtv', att, ic)
        b_last = b[:, :, -1:, :]
        state = (jnp.exp(b_last[:, :, 0, :])[..., None] * state
                 + jnp.einsum('bhsk,bhsv->bhkv', kc * jnp.exp(b_last - b), ic))
        return state, o

    s0 = jnp.zeros((B, H, dk, dv), F32)
    _, o = lax.scan(step, s0, (chunks(q), chunks(log_f), chunks(k), chunks(i)))
    return o.transpose(1, 0, 3, 2, 4).reshape(B, S, H, dv)


def hgrn_branch(seg, lb, norm_g):
    B, S, _ = seg.shape
    q, f, i, g = split_last(seg, (HGRN_KW, HGRN_KW, HGRN_VW, HGRN_VW))
    lb = lb.astype(F32)
    f = f.astype(F32)
    log_f = jnp.logaddexp(jnp.log(lb), jnp.log1p(-lb) + jax.nn.log_sigmoid(f))
    k = (1.0 - lb) * jax.nn.sigmoid(-f)
    o = hgrn2_chunked(to_heads(jax.nn.silu(q), HGRN_HEADS), to_heads(log_f, HGRN_HEADS),
                      to_heads(k, HGRN_HEADS), to_heads(i, HGRN_HEADS))
    o = rms_norm(o, norm_g).reshape(B, S, HGRN_VW) * jax.nn.silu(g.astype(F32))
    return o.astype(seg.dtype)


def rwkv7_scan(r, w, k, v, kk, a):
    B, S, H, d = r.shape

    def step(state, xs):
        rt, wt, kt, vt, kkt, at = xs
        sa = jnp.einsum('bhvk,bhk->bhv', state, -kkt)
        state = (state * wt[:, :, None, :] + sa[..., None] * (kkt * at)[:, :, None, :]
                 + vt[..., None] * kt[:, :, None, :])
        return state, jnp.einsum('bhvk,bhk->bhv', state, rt)

    xs = tuple(jnp.moveaxis(t.astype(F32), 1, 0) for t in (r, w, k, v, kk, a))
    _, y = lax.scan(step, jnp.zeros((B, H, d, d), F32), xs)
    return jnp.moveaxis(y, 0, 1)


def rwkv_branch(seg, mu, w0, w2, a0, a2, g2, k_k, k_a, r_k, lnx_g, lnx_b, v_first, vmix):
    B, S, _ = seg.shape
    prev = jnp.pad(seg, ((0, 0), (1, 0), (0, 0)))[:, :-1]
    seg = seg + (prev - seg) * mu
    r, k, v, w_low, a_low, g_low = split_last(
        seg, (RWKV_WIDTH, RWKV_WIDTH, RWKV_WIDTH, RWKV_DECAY_LORA, RWKV_A_LORA, RWKV_GATE_LORA))
    w = -jax.nn.softplus(-(w0 + jnp.tanh(w_low) @ w2).astype(F32)) - 0.5
    decay = jnp.exp(-jnp.exp(w))
    a = jax.nn.sigmoid(a0 + a_low @ a2)
    g = jax.nn.sigmoid(g_low) @ g2
    kk = to_heads(k * k_k, RWKV_HEADS).astype(F32)
    kk = kk / jnp.maximum(jnp.sqrt(jnp.sum(kk * kk, axis=-1, keepdims=True)), 1e-12)
    k = k * (1.0 + (a - 1.0) * k_a)
    if vmix is None:
        v_first = v
    else:
        v0, v1, v2 = vmix
        v = v + (v_first - v) * jax.nn.sigmoid(v0 + (v @ v1) @ v2)
    rh, kh, vh, ah = (to_heads(t, RWKV_HEADS) for t in (r, k, v, a))
    y = rwkv7_scan(rh, to_heads(decay, RWKV_HEADS), kh, vh, kk, ah)
    mean = jnp.mean(y, axis=-1, keepdims=True)
    var = jnp.mean(jnp.square(y - mean), axis=-1, keepdims=True)
    y = ((y - mean) * lax.rsqrt(var + RWKV_GN_EPS)).reshape(B, S, RWKV_WIDTH) * lnx_g + lnx_b
    bonus = (jnp.sum(rh * kh * r_k, axis=-1, keepdims=True) * vh).reshape(B, S, RWKV_WIDTH)
    y = (y + bonus) * g
    return y.astype(seg.dtype), v_first


def setup_inputs(seed: int = 0) -> dict:
    key = jax.random.key(seed)
    keys = iter(jax.random.split(key, 64))
    L, D, W = DEPTH, D_MODEL, RWKV_WIDTH

    def normal(shape, scale):
        return scale * jax.random.normal(next(keys), shape, F32)

    def uniform(shape, lo, hi):
        return jax.random.uniform(next(keys), shape, F32, lo, hi)

    def gain(shape):
        return 1.0 + normal(shape, 0.02)

    def dense(shape):
        return normal(shape, shape[-2] ** -0.5)

    x = normal((BATCH, SEQ, D), 1.0)
    mem = normal((BATCH, MEM_LEN, D), 1.0)
    start = jax.random.randint(next(keys), (BATCH, 1), 0, 1024, jnp.int32)
    positions = start + jnp.arange(SEQ, dtype=jnp.int32)[None, :]
    conv_w = normal((L, CONV_WIDTH, 2 * D_FF), 0.2).at[:, CONV_WIDTH - 1].add(1.0)
    return {
        'x': x,
        'mem': mem,
        'positions': positions,
        'mix_norm_g': gain((L, D)),
        'w_in': dense((L, D, N_IN)),
        'diff_lam': normal((L, 4, HEAD_DIM), 0.1),
        'diff_norm_g': gain((L, 2 * HEAD_DIM)),
        'hgrn_lb_logits': normal((L, HGRN_KW), 1.0),
        'hgrn_norm_g': gain((L, HGRN_DV)),
        'rwkv_mu': uniform((L, SEG_D), 0.0, 1.0),
        'rwkv_w0': uniform((L, W), -5.0, 0.0),
        'rwkv_w2': normal((L, RWKV_DECAY_LORA, W), 0.1 * RWKV_DECAY_LORA ** -0.5),
        'rwkv_a0': normal((L, W), 0.1),
        'rwkv_a2': normal((L, RWKV_A_LORA, W), 0.1 * RWKV_A_LORA ** -0.5),
        'rwkv_g2': dense((L, RWKV_GATE_LORA, W)),
        'rwkv_k_k': 0.85 + normal((L, W), 0.05),
        'rwkv_k_a': 1.0 + normal((L, W), 0.05),
        'rwkv_r_k': normal((L, RWKV_HEADS, RWKV_HEAD_DIM), 0.1),
        'rwkv_lnx_g': gain((L, W)),
        'rwkv_lnx_b': normal((L, W), 0.02),
        'rwkv_v0': 1.0 + normal((L - 1, W), 0.1),
        'rwkv_v1': normal((L - 1, W, RWKV_MV_LORA), 0.1 * W ** -0.5),
        'rwkv_v2': normal((L - 1, RWKV_MV_LORA, W), 0.1 * RWKV_MV_LORA ** -0.5),
        'p_a': dense((L, DIL_WIDTH, D)),
        'p_b': dense((L, DIFF_WIDTH, D)),
        'p_c': dense((L, HGRN_VW, D)),
        'p_d': dense((L, RWKV_WIDTH, D)),
        'w_mix_out': dense((L, D, D)),
        'mem_q_norm_g': gain((L, D)),
        'mem_kv_norm_g': gain((L, D)),
        'w_mem_q': dense((L, D, D)),
        'w_mem_kv': dense((L, D, 2 * D)),
        'w_mem_o': dense((L, D, D)),
        'ffn_norm_g': gain((L, D)),
        'w_ffn_in': dense((L, D, 2 * D_FF)),
        'ffn_conv_w': conv_w,
        'ffn_conv_b': normal((L, 2 * D_FF), 0.02),
        'w_ffn_out': dense((L, D_FF, D)),
        'final_norm_g': gain((D,)),
    }


def reference(x, mem, positions, mix_norm_g, w_in, diff_lam, diff_norm_g, hgrn_lb_logits, hgrn_norm_g,
              rwkv_mu, rwkv_w0, rwkv_w2, rwkv_a0, rwkv_a2, rwkv_g2, rwkv_k_k, rwkv_k_a, rwkv_r_k,
              rwkv_lnx_g, rwkv_lnx_b, rwkv_v0, rwkv_v1, rwkv_v2, p_a, p_b, p_c, p_d, w_mix_out,
              mem_q_norm_g, mem_kv_norm_g, w_mem_q, w_mem_kv, w_mem_o,
              ffn_norm_g, w_ffn_in, ffn_conv_w, ffn_conv_b, w_ffn_out, final_norm_g):
    B, S, D = x.shape
    M = mem.shape[1]
    lb_all = jnp.cumsum(jax.nn.softmax(hgrn_lb_logits.astype(F32), axis=0), axis=0)
    lb_all = lb_all - lb_all[0:1]
    v_first = None
    for l in range(DEPTH):
        lam_init = 0.8 - 0.6 * math.exp(-0.3 * l)
        h = rms_norm(x, mix_norm_g[l])
        seg_a, seg_b, seg_c, seg_d, seg_g = split_last(h @ w_in[l], SEGMENTS)
        y_a = dilated_branch(seg_a, positions)
        y_b = diff_branch(seg_b, positions, diff_lam[l], diff_norm_g[l], lam_init)
        y_c = hgrn_branch(seg_c, lb_all[l], hgrn_norm_g[l])
        vmix = None if l == 0 else (rwkv_v0[l - 1], rwkv_v1[l - 1], rwkv_v2[l - 1])
        y_d, v_first = rwkv_branch(seg_d, rwkv_mu[l], rwkv_w0[l], rwkv_w2[l], rwkv_a0[l], rwkv_a2[l],
                                   rwkv_g2[l], rwkv_k_k[l], rwkv_k_a[l], rwkv_r_k[l], rwkv_lnx_g[l],
                                   rwkv_lnx_b[l], v_first, vmix)
        gates = jax.nn.sigmoid(seg_g.reshape(B, S, N_BRANCH, D))
        merged = (gates[:, :, 0] * (y_a @ p_a[l]) + gates[:, :, 1] * (y_b @ p_b[l])
                  + gates[:, :, 2] * (y_c @ p_c[l]) + gates[:, :, 3] * (y_d @ p_d[l]))
        x = x + merged @ w_mix_out[l]
        hq = to_heads(rms_norm(x, mem_q_norm_g[l]) @ w_mem_q[l], MEM_HEADS)
        kv = (rms_norm(mem, mem_kv_norm_g[l]) @ w_mem_kv[l]).reshape(B, M, 2, MEM_HEADS, MEM_HEAD_DIM)
        s = jnp.einsum('bshd,bmhd->bhsm', hq, kv[:, :, 0]).astype(F32) * MEM_HEAD_DIM ** -0.5
        p = jax.nn.softmax(s, axis=-1).astype(x.dtype)
        o = jnp.einsum('bhsm,bmhd->bshd', p, kv[:, :, 1]).reshape(B, S, D)
        x = x + o @ w_mem_o[l]
        u = rms_norm(x, ffn_norm_g[l]) @ w_ffn_in[l]
        u_pad = jnp.pad(u, ((0, 0), (CONV_WIDTH - 1, 0), (0, 0)))
        conv = ffn_conv_b[l]
        for j in range(CONV_WIDTH):
            conv = conv + u_pad[:, j:j + S] * ffn_conv_w[l, j]
        gate, val = jnp.split(conv, 2, axis=-1)
        x = x + (jax.nn.silu(gate) * val) @ w_ffn_out[l]
    return rms_norm(x, final_norm_g)
```

```cpp
#include <hip/hip_runtime.h>
#include <hip/hip_cooperative_groups.h>
#include <stdint.h>
#include <stdio.h>
namespace cg = cooperative_groups;

#define DI __device__ __forceinline__
typedef unsigned short u16;
using bf16x8 = __attribute__((ext_vector_type(8))) short;
using s16x4  = __attribute__((ext_vector_type(4))) short;
using f32x4  = __attribute__((ext_vector_type(4))) float;
using u32x4  = __attribute__((ext_vector_type(4))) unsigned;
using u32x2  = __attribute__((ext_vector_type(2))) unsigned;

constexpr int NTH = 512;
constexpr int D = 1024, NB = 16, S = 4096, T = NB * S, NL = 2, MEM = 256;
constexpr int BG = 4, TG = BG * S, NGRP = NB / BG;
constexpr int NIN = 9984, DFF = 2816, NFF2 = 2 * DFF;
constexpr int NSG = 8960;
constexpr int GOFF = 4864;
constexpr int YW = 1024;
constexpr float EPS = 1e-5f;

constexpr size_t al(size_t x) { return (x + 255) & ~(size_t)255; }
constexpr size_t E_WIN = (size_t)NIN * D, E_PA = 1024 * 256, E_PB = 1024 * 512, E_PC = 1024 * 256, E_PD = 1024 * 256;
constexpr size_t E_MIX = 1024 * 1024, E_MQ = 1024 * 1024, E_MKV = 2048 * 1024, E_MO = 1024 * 1024;
constexpr size_t E_FIN = (size_t)NFF2 * D, E_FOUT = (size_t)D * DFF;
constexpr size_t O_WIN = 0;
constexpr size_t O_PA = O_WIN + al(NL * E_WIN * 2);
constexpr size_t O_PB = O_PA + al(NL * E_PA * 2);
constexpr size_t O_PC = O_PB + al(NL * E_PB * 2);
constexpr size_t O_PD = O_PC + al(NL * E_PC * 2);
constexpr size_t O_MIX = O_PD + al(NL * E_PD * 2);
constexpr size_t O_MQ = O_MIX + al(NL * E_MIX * 2);
constexpr size_t O_MKV = O_MQ + al(NL * E_MQ * 2);
constexpr size_t O_MO = O_MKV + al(NL * E_MKV * 2);
constexpr size_t O_FIN = O_MO + al(NL * E_MO * 2);
constexpr size_t O_FOUT = O_FIN + al(NL * E_FIN * 2);
constexpr size_t O_ROPE = O_FOUT + al(NL * E_FOUT * 2);
constexpr size_t O_MEMN = O_ROPE + al((size_t)T * 16 * 4);
constexpr size_t O_KV = O_MEMN + al((size_t)NL * 4096 * 1024 * 2);
constexpr size_t O_VFIRST = O_KV + al((size_t)NL * 4096 * 2048 * 2);
constexpr size_t O_SCAL = O_VFIRST + al((size_t)T * 256 * 2);
constexpr size_t O_BAR = O_SCAL + 128;
constexpr size_t O_CNT = O_SCAL + 256;
constexpr size_t SZ_RW = al((size_t)T * 256 * 2);
constexpr size_t O_XBAR = O_CNT + 2048;
constexpr size_t O_RWR = O_XBAR + 16384;
constexpr size_t O_RWK = O_RWR + SZ_RW, O_RWV = O_RWK + SZ_RW, O_RWKK = O_RWV + SZ_RW, O_RWKKA = O_RWKK + SZ_RW, O_RWG = O_RWKKA + SZ_RW;
constexpr size_t O_YD = O_RWG + SZ_RW;
constexpr size_t O_RWW = O_YD + SZ_RW;
constexpr size_t O_RWY = O_RWW + al((size_t)T * 256 * 4);
constexpr size_t O_RWRK = O_RWY + al((size_t)T * 256 * 4);
constexpr size_t O_TR = O_RWRK + al((size_t)T * 4 * 4);
constexpr size_t O_H = O_TR;
constexpr size_t O_SEG = O_H + al((size_t)TG * 1024 * 2);
constexpr size_t O_HGS = O_SEG + al((size_t)TG * NSG * 2);
constexpr size_t O_HGF = O_HGS + al((size_t)BG * 4 * 32 * 4096 * 4);
constexpr size_t O_OG = O_HGF + al((size_t)BG * 4 * 32 * 64 * 4);
constexpr size_t O_LSE = O_OG + al((size_t)TG * 768 * 2);
constexpr size_t O_Y = O_LSE + al((size_t)TG * 12 * 4);
constexpr size_t O_MERGED = O_Y + al((size_t)TG * YW * 2);
constexpr size_t WS_TOTAL = O_MERGED + al((size_t)TG * 1024 * 2);
constexpr size_t O_HALL = O_TR;
constexpr size_t O_SEGD = O_TR + al((size_t)T * 1024 * 2);
constexpr size_t O_Q = O_SEG;
constexpr size_t O_O = O_SEG + al((size_t)TG * 1024 * 2);
constexpr size_t O_U = O_SEG;
constexpr size_t O_ACT = O_SEG + al((size_t)TG * NFF2 * 2);
static_assert(O_ACT + (size_t)TG * DFF * 2 <= O_HGS, "U + ACT fit in SEG");
static_assert(O_SEGD + (size_t)T * 1024 * 2 <= WS_TOTAL, "front buffers fit in the transient region");
static_assert(WS_TOTAL <= ((size_t)1 << 30), "workspace fits 1 GiB");

constexpr int SMEM_BYTES = 131072;

struct Params {
  const float* in[39];
  float* out;
  char* ws;
};

DI int otid() { int t = threadIdx.x; asm volatile("" : "+v"(t)); return t; }
typedef __bf16 bf16x2_t __attribute__((ext_vector_type(2)));
typedef float f32x2_t __attribute__((ext_vector_type(2)));
DI unsigned pack2(float a, float b) { f32x2_t f = {a, b}; bf16x2_t r = __builtin_convertvector(f, bf16x2_t); return __builtin_bit_cast(unsigned, r); }
DI u16 f2bf(float x) { return (u16)(pack2(x, 0.f) & 0xffffu); }
DI float bf2f(u16 b) { return __uint_as_float(((unsigned)b) << 16); }
DI float bflo(unsigned u) { return __uint_as_float(u << 16); }
DI float bfhi(unsigned u) { return __uint_as_float(u & 0xffff0000u); }
DI float sigm(float x) { return __builtin_amdgcn_rcpf(1.f + __expf(-x)); }
DI float silu(float x) { return x * __builtin_amdgcn_rcpf(1.f + __expf(-x)); }
DI float wave_sum_slow(float v) {
#pragma unroll
  for (int o = 32; o > 0; o >>= 1) v += __shfl_xor(v, o);
  return v;
}
DI f32x4 mfma16(bf16x8 a, bf16x8 b, f32x4 c) { return __builtin_amdgcn_mfma_f32_16x16x32_bf16(a, b, c, 0, 0, 0); }
template <int CTRL> DI float dpp_mov(float x) {
  return __int_as_float(__builtin_amdgcn_update_dpp(0, __float_as_int(x), CTRL, 0xF, 0xF, true));
}
DI float red16(float x) {
  x += dpp_mov<0xB1>(x);
  x += dpp_mov<0x4E>(x);
  x += dpp_mov<0x141>(x);
  x += dpp_mov<0x140>(x);
  return x;
}
DI float wave_sum(float v) { v = red16(v); v += __shfl_xor(v, 16); v += __shfl_xor(v, 32); return v; }
DI void red16_2(float& a, float& b) {
  a += dpp_mov<0xB1>(a);  b += dpp_mov<0xB1>(b);
  a += dpp_mov<0x4E>(a);  b += dpp_mov<0x4E>(b);
  a += dpp_mov<0x141>(a); b += dpp_mov<0x141>(b);
  a += dpp_mov<0x140>(a); b += dpp_mov<0x140>(b);
}

#define XB_TMO      128
#define XB_XCNT(j)  (256  + 64 * (j))
#define XB_XSUB(j)  (1280 + 64 * (j))
#define XB_XGEN(j)  (2304 + 64 * (j))
#define XB_TOP      3328
#define XB_TOPGEN   3392
#define XCD_BAR_WORDS 3456
#define XB_SPIN_CAP (1u << 18)
#define LAS __attribute__((address_space(3)))
DI unsigned xb_ld(unsigned* p)              { return __hip_atomic_load(p, __ATOMIC_RELAXED, __HIP_MEMORY_SCOPE_AGENT); }
DI unsigned xb_add(unsigned* p, unsigned v) { return __hip_atomic_fetch_add(p, v, __ATOMIC_RELAXED, __HIP_MEMORY_SCOPE_AGENT); }
DI unsigned xb_xcc_id() { return (unsigned)__builtin_amdgcn_s_getreg((3 << 11) | 20) & 0xFu; }
#define XB_SPIN(cond, bar) do { unsigned _sp = 0; while (cond) { __builtin_amdgcn_s_sleep(1); \
    if ((++_sp & 255u) == 0u) { if (xb_ld(&(bar)[XB_TMO])) break; if (_sp > XB_SPIN_CAP) { atomicAdd(&(bar)[XB_TMO], 1u); break; } } } } while (0)
struct XcdBarrier { unsigned* bar; unsigned x; volatile LAS unsigned* st; };
DI XcdBarrier xcd_barrier_post(unsigned* bar, volatile LAS unsigned* st) {
  XcdBarrier b; b.bar = bar; b.x = xb_xcc_id(); b.st = st;
  if (threadIdx.x == 0) (void)xb_add(&bar[XB_XCNT(b.x)], 1u);
  return b;
}
DI void xcd_barrier_complete(unsigned* bar, unsigned x, unsigned& nloc, unsigned& nx) {
  const unsigned G = gridDim.x * gridDim.y * gridDim.z;
  unsigned sum, cnt, mine, sp = 0u;
  for (;;) {
    sum = 0u; cnt = 0u; mine = 0u;
#pragma unroll
    for (unsigned j = 0; j < 16; ++j) { const unsigned c = xb_ld(&bar[XB_XCNT(j)]); sum += c; cnt += (c > 0u) ? 1u : 0u; mine = (j == x) ? c : mine; }
    if (sum == G) break;
    __builtin_amdgcn_s_sleep(1);
    if ((++sp & 255u) == 0u) { if (xb_ld(&bar[XB_TMO])) break; if (sp > XB_SPIN_CAP) { atomicAdd(&bar[XB_TMO], 1u); break; } }
  }
  nloc = mine > 0u ? mine : 1u; nx = cnt > 0u ? cnt : 1u;
}
DI void xcd_barrier(const XcdBarrier& b) {
  asm volatile("s_waitcnt vmcnt(0)" ::: "memory");
  __syncthreads();
  if (threadIdx.x == 0) {
    unsigned* bar = b.bar;
    __builtin_amdgcn_s_waitcnt(0);
    unsigned nloc = b.st[0], nx = b.st[1];
    if (nloc == 0u) { xcd_barrier_complete(bar, b.x, nloc, nx); b.st[0] = nloc; b.st[1] = nx; }
    const unsigned old = xb_add(&bar[XB_XSUB(b.x)], 1u);
    const unsigned gen = old / nloc;
    if (old + 1u == (gen + 1u) * nloc) {
      __builtin_amdgcn_fence(__ATOMIC_RELEASE, "agent");
      asm volatile("s_waitcnt vmcnt(0)" ::: "memory");
      const unsigned og = xb_add(&bar[XB_TOP], 1u);
      const unsigned tg = og / nx;
      if (og + 1u == (tg + 1u) * nx) xb_add(&bar[XB_TOPGEN], 1u);
      else XB_SPIN(xb_ld(&bar[XB_TOPGEN]) == tg, bar);
      __builtin_amdgcn_fence(__ATOMIC_ACQUIRE, "agent");
      xb_add(&bar[XB_XGEN(b.x)], 1u);
      asm volatile("s_waitcnt vmcnt(0)" ::: "memory");
    } else {
      XB_SPIN(xb_ld(&bar[XB_XGEN(b.x)]) == gen, bar);
      __builtin_amdgcn_fence(__ATOMIC_ACQUIRE, "agent");
      asm volatile("s_waitcnt vmcnt(0)" ::: "memory");
    }
  }
  __syncthreads();
}

DI int lds_byte2(int r, int c) {
  const int st = (r >> 4) * 2 + (c >> 5), ob = (r & 15) * 64 + (c & 31) * 2;
  return st * 1024 + (ob ^ (((ob >> 9) & 1) << 5));
}
typedef __attribute__((address_space(3))) unsigned* lds_u32_ptr;
template <int MI> struct GemmStage {
  static constexpr int AROWS = MI * 32, LA = AROWS / 128;
  static constexpr int A_BYTES = AROWS * 64, STAGE = A_BYTES + 256 * 64;
  static constexpr int LPS = LA + 2;
  unsigned aoff[LA], boff[2]; int wid;
  DI void init(long lda, long ldb) {
    const int tid = otid(), lane = tid & 63;
    wid = tid >> 6;
    const int sb = lane * 16, swz = sb ^ (((sb >> 9) & 1) << 5);
    const int rr = swz >> 6, cc = (swz & 63) >> 1;
#pragma unroll
    for (int i = 0; i < LA; ++i) aoff[i] = (unsigned)(((wid + 8 * i) * 16 + rr) * (int)lda + cc);
#pragma unroll
    for (int i = 0; i < 2; ++i) boff[i] = (unsigned)(((wid + 8 * i) * 16 + rr) * (int)ldb + cc);
  }
  DI void issue(const u16* __restrict__ A, const u16* __restrict__ Bt, int k0, char* buf) const {
#pragma unroll
    for (int i = 0; i < LA; ++i) __builtin_amdgcn_global_load_lds((const unsigned*)(A + aoff[i] + k0), (lds_u32_ptr)(buf + (wid + 8 * i) * 1024), 16, 0, 0);
#pragma unroll
    for (int i = 0; i < 2; ++i) __builtin_amdgcn_global_load_lds((const unsigned*)(Bt + boff[i] + k0), (lds_u32_ptr)(buf + A_BYTES + (wid + 8 * i) * 1024), 16, 0, 0);
  }
};
template <int MI>
DI void gemm_issue0(const u16* __restrict__ A, long lda, const u16* __restrict__ Bt, long ldb, char* smem) {
  GemmStage<MI> gs; gs.init(lda, ldb);
#pragma unroll
  for (int s = 0; s < 3; ++s) gs.issue(A, Bt, s * 32, smem + s * GemmStage<MI>::STAGE);
}
template <int MI>
DI void gemm_run(f32x4 (&acc)[MI][4], const u16* __restrict__ A, long lda, const u16* __restrict__ Bt, long ldb, int K, char* smem, bool preissued) {
  constexpr int A_BYTES = GemmStage<MI>::A_BYTES, STAGE = GemmStage<MI>::STAGE, LPS = GemmStage<MI>::LPS;
  GemmStage<MI> gs; gs.init(lda, ldb);
  const int tid = otid(), lane = tid & 63, wid = tid >> 6, wr = wid >> 2, wc = wid & 3;
  const int li = lane & 15, lg = lane >> 4;
  const int fo = (li * 64 + lg * 16) ^ ((li >> 3) << 5);
  const int nk = K >> 5;
  if (!preissued) {
    __syncthreads();
#pragma unroll
    for (int s = 0; s < 3; ++s) gs.issue(A, Bt, s * 32, smem + s * STAGE);
  }
  for (int kk = 0; kk < nk; ++kk) {
    const int newer = nk - 1 - kk;
    if (newer == 0) asm volatile("s_waitcnt vmcnt(0)" ::: "memory");
    else if (newer == 1) asm volatile("s_waitcnt vmcnt(%0)" :: "n"(LPS) : "memory");
    else asm volatile("s_waitcnt vmcnt(%0)" :: "n"(2 * LPS) : "memory");
    asm volatile("s_waitcnt lgkmcnt(0)" ::: "memory");
    __builtin_amdgcn_s_barrier();
    asm volatile("" ::: "memory");
    char* cur = smem + (kk & 3) * STAGE;
    {
      constexpr int NP = MI / 2;
      bf16x8 bq[4], ap[2][2];
      const char* aB = cur + (wr * MI) * 1024 + fo;
      const char* bB = cur + A_BYTES + (wc * 4) * 1024 + fo;
#pragma unroll
      for (int ni = 0; ni < 4; ++ni) bq[ni] = *(const bf16x8*)(bB + ni * 1024);
#pragma unroll
      for (int i = 0; i < 2; ++i) ap[0][i] = *(const bf16x8*)(aB + i * 1024);
      __builtin_amdgcn_sched_barrier(0);
      if (kk + 3 < nk) gs.issue(A, Bt, (kk + 3) << 5, smem + ((kk + 3) & 3) * STAGE);
      __builtin_amdgcn_sched_barrier(0);
#pragma unroll
      for (int pp = 0; pp < NP; ++pp) {
        if (pp + 1 < NP) {
#pragma unroll
          for (int i = 0; i < 2; ++i) ap[(pp + 1) & 1][i] = *(const bf16x8*)(aB + (2 * (pp + 1) + i) * 1024);
        }
#pragma unroll
        for (int i = 0; i < 2; ++i)
#pragma unroll
          for (int ni = 0; ni < 4; ++ni) acc[2 * pp + i][ni] = mfma16(bq[ni], ap[pp & 1][i], acc[2 * pp + i][ni]);
        __builtin_amdgcn_sched_group_barrier(0x008, 1, 0);
        if (pp + 1 < NP) __builtin_amdgcn_sched_group_barrier(0x100, 2, 0);
        __builtin_amdgcn_sched_group_barrier(0x008, 7, 0);
        __builtin_amdgcn_sched_barrier(0);
      }
    }
  }
}
template <int MI>
DI void gemm_main(f32x4 (&acc)[MI][4], const u16* __restrict__ A, long lda, const u16* __restrict__ Bt, long ldb, int K, char* smem) {
  gemm_run<MI>(acc, A, lda, Bt, ldb, K, smem, false);
}
template <int BH> struct TileWalk {
  int x, j, per, r, NT, total; bool plain;
  DI TileWalk(int MT, int NT_) : NT(NT_), total(MT * NT_) {
    plain = (gridDim.x & 7) != 0 || (MT % BH) != 0;
    x = blockIdx.x & 7; j = blockIdx.x >> 3; per = gridDim.x >> 3; r = 0;
  }
  DI bool next(int& mt, int& nt) {
    int tp;
    if (plain) tp = blockIdx.x + r * gridDim.x; else tp = (r * 8 + x) * per + j;
    ++r;
    if (tp >= total) return false;
    if (plain) { mt = tp / NT; nt = tp % NT; }
    else { const int band = tp / (BH * NT), idx = tp % (BH * NT); mt = band * BH + (idx % BH); nt = idx / BH; }
    return true;
  }
};
template <int MI> DI void zero_acc(f32x4 (&acc)[MI][4]) {
#pragma unroll
  for (int mi = 0; mi < MI; ++mi)
#pragma unroll
    for (int ni = 0; ni < 4; ++ni) acc[mi][ni] = f32x4{0.f, 0.f, 0.f, 0.f};
}
template <int MI, typename F> DI void epi_foreach(f32x4 (&acc)[MI][4], F&& f) {
  const int tid_ = otid(), lane_ = tid_ & 63, wid_ = tid_ >> 6, wr_ = wid_ >> 2, wc_ = wid_ & 3, li_ = lane_ & 15, lg_ = lane_ >> 4;
#pragma unroll
  for (int mi = 0; mi < MI; ++mi) {
    asm volatile("" ::: "memory");
#pragma unroll
    for (int ni = 0; ni < 4; ++ni) f(mi, ni, wr_ * (MI * 16) + mi * 16 + li_, wc_ * 64 + ni * 16 + lg_ * 4, acc[mi][ni]);
  }
}
DI u32x2 pack4(f32x4 v) { u32x2 o; o[0] = pack2(v[0], v[1]); o[1] = pack2(v[2], v[3]); return o; }

struct TrJob { const float* src; u16* dst; int K, N; };
DI TrJob tr_job(const Params& p, int j) {
  const int l = j / 11, w = j % 11;
  TrJob r;
  switch (w) {
    case 0: r = {p.in[4] + (size_t)l * E_WIN, (u16*)(p.ws + O_WIN) + (size_t)l * E_WIN, 1024, NIN}; break;
    case 1: r = {p.in[23] + (size_t)l * E_PA, (u16*)(p.ws + O_PA) + (size_t)l * E_PA, 256, 1024}; break;
    case 2: r = {p.in[24] + (size_t)l * E_PB, (u16*)(p.ws + O_PB) + (size_t)l * E_PB, 512, 1024}; break;
    case 3: r = {p.in[25] + (size_t)l * E_PC, (u16*)(p.ws + O_PC) + (size_t)l * E_PC, 256, 1024}; break;
    case 4: r = {p.in[26] + (size_t)l * E_PD, (u16*)(p.ws + O_PD) + (size_t)l * E_PD, 256, 1024}; break;
    case 5: r = {p.in[27] + (size_t)l * E_MIX, (u16*)(p.ws + O_MIX) + (size_t)l * E_MIX, 1024, 1024}; break;
    case 6: r = {p.in[30] + (size_t)l * E_MQ, (u16*)(p.ws + O_MQ) + (size_t)l * E_MQ, 1024, 1024}; break;
    case 7: r = {p.in[31] + (size_t)l * E_MKV, (u16*)(p.ws + O_MKV) + (size_t)l * E_MKV, 1024, 2048}; break;
    case 8: r = {p.in[32] + (size_t)l * E_MO, (u16*)(p.ws + O_MO) + (size_t)l * E_MO, 1024, 1024}; break;
    case 9: r = {p.in[34] + (size_t)l * E_FIN, (u16*)(p.ws + O_FIN) + (size_t)l * E_FIN, 1024, NFF2}; break;
    default: r = {p.in[37] + (size_t)l * E_FOUT, (u16*)(p.ws + O_FOUT) + (size_t)l * E_FOUT, DFF, 1024}; break;
  }
  return r;
}
DI int tr_tiles(int w) {
  switch (w) {
    case 0: return 16 * 156; case 1: return 4 * 16; case 2: return 8 * 16; case 3: return 4 * 16; case 4: return 4 * 16;
    case 5: return 256; case 6: return 256; case 7: return 16 * 32; case 8: return 256; case 9: return 16 * 88; default: return 44 * 16;
  }
}
constexpr int TR_TILES_L = 16 * 156 + 64 + 128 + 64 + 64 + 256 * 3 + 512 + 16 * 88 + 44 * 16;

DI void transpose_tile(const TrJob& jb, int tile, char* smem) {
  float* ts = (float*)smem;
  const int ntn = jb.N >> 6;
  const int k0 = (tile / ntn) << 6, n0 = (tile % ntn) << 6;
  const int tid = otid(), a = tid >> 6, b = tid & 63;
  __syncthreads();
#pragma unroll
  for (int i = 0; i < 8; ++i) { int k = i * 8 + a; ts[k * 65 + b] = jb.src[(size_t)(k0 + k) * jb.N + n0 + b]; }
  __syncthreads();
#pragma unroll
  for (int i = 0; i < 8; ++i) { int n = i * 8 + a; jb.dst[(size_t)(n0 + n) * jb.K + k0 + b] = f2bf(ts[b * 65 + n]); }
}

DI void sincos_acc(float ang, float& c, float& s) {
  double a = (double)ang;
  const double TWO_PI = 6.283185307179586476925;
  double n = rint(a / TWO_PI);
  double r = a - n * TWO_PI;
  double r2 = r * r;
  double sn = 0.0, cs = 0.0;
  double ts = r, tc = 1.0;
#pragma unroll
  for (int k = 0; k < 13; ++k) {
    cs += tc; sn += ts;
    tc = -tc * r2 / (double)((2 * k + 1) * (2 * k + 2));
    ts = -ts * r2 / (double)((2 * k + 2) * (2 * k + 3));
  }
  c = (float)cs; s = (float)sn;
}

DI void norm_row_bf16(const float* __restrict__ xr, const float* __restrict__ g, u16* __restrict__ outr, int lane) {
  float4 v[4]; float ss = 0.f;
#pragma unroll
  for (int i = 0; i < 4; ++i) { v[i] = ((const float4*)xr)[i * 64 + lane]; ss += v[i].x * v[i].x + v[i].y * v[i].y + v[i].z * v[i].z + v[i].w * v[i].w; }
  ss = wave_sum(ss);
  const float rstd = 1.0f / sqrtf(ss * (1.f / 1024.f) + EPS);
#pragma unroll
  for (int i = 0; i < 4; ++i) {
    float4 gg = ((const float4*)g)[i * 64 + lane];
    u32x2 o; o[0] = pack2(v[i].x * rstd * gg.x, v[i].y * rstd * gg.y); o[1] = pack2(v[i].z * rstd * gg.z, v[i].w * rstd * gg.w);
    *(u32x2*)(outr + (i * 64 + lane) * 4) = o;
  }
}

DI void phase_prologue(const Params& p, char* smem) {
  const int tid = otid(), lane = tid & 63, wave = tid >> 6;
  if (blockIdx.x == 0) {
    ((int*)(p.ws + O_CNT))[tid] = 0;
    if (tid < NL) {
      const float* lv = p.in[5] + tid * 256;
      float s1 = 0.f, s2 = 0.f;
      for (int i = 0; i < 64; ++i) { s1 += lv[i] * lv[64 + i]; s2 += lv[128 + i] * lv[192 + i]; }
      const float lam_init = (tid == 0) ? 0.2f : 0.355509067591f;
      ((float*)(p.ws + O_SCAL))[tid] = expf(s1) - expf(s2) + lam_init;
    }
  }
  for (int t = blockIdx.x; t < NL * TR_TILES_L; t += gridDim.x) {
    int l = t / TR_TILES_L, r = t % TR_TILES_L, w = 0;
    for (; w < 10; ++w) { int n = tr_tiles(w); if (r < n) break; r -= n; }
    TrJob jb = tr_job(p, l * 11 + w);
    transpose_tile(jb, r, smem);
  }
  {
    const int* pos = (const int*)p.in[2];
    float* tab = (float*)(p.ws + O_ROPE);
    for (int idx = blockIdx.x * NTH + tid; idx < T * 8; idx += gridDim.x * NTH) {
      const int t = idx >> 3, i = idx & 7;
      float invf;
      switch (i) {
        case 0: invf = 1.0f; break; case 1: invf = 0.1939227432012558f; break; case 2: invf = 0.03760603070259094f; break;
        case 3: invf = 0.007292664609849453f; break; case 4: invf = 0.0014142135623842478f; break; case 5: invf = 0.00027424818836152554f; break;
        case 6: invf = 5.3182957344688475e-05f; break; default: invf = 1.0313385246263351e-05f; break;
      }
      const float ang = (float)pos[t] * invf;
      float c, s; sincos_acc(ang, c, s);
      tab[t * 16 + i] = c; tab[t * 16 + 8 + i] = s;
    }
  }
  for (int row = blockIdx.x * 8 + wave; row < NL * 4096; row += gridDim.x * 8) {
    const int l = row >> 12, r = row & 4095;
    norm_row_bf16(p.in[1] + (size_t)r * 1024, p.in[29] + l * 1024, (u16*)(p.ws + O_MEMN) + (size_t)row * 1024, lane);
  }
}

DI void phase_kv_gemm(const Params& p, char* smem) {
  for (int t = blockIdx.x; t < NL * 16 * 8; t += gridDim.x) {
    const int l = t >> 7, r = t & 127, mt = r >> 3, nt = r & 7;
    f32x4 acc[8][4]; zero_acc<8>(acc);
    const u16* A = (const u16*)(p.ws + O_MEMN) + (size_t)l * 4096 * 1024 + (size_t)mt * 256 * 1024;
    const u16* B = (const u16*)(p.ws + O_MKV) + (size_t)l * E_MKV + (size_t)nt * 256 * 1024;
    gemm_main<8>(acc, A, 1024, B, 1024, 1024, smem);
    u16* C = (u16*)(p.ws + O_KV) + (size_t)l * 4096 * 2048 + (size_t)mt * 256 * 2048 + nt * 256;
    epi_foreach<8>(acc, [&](int mi, int ni, int r, int c, f32x4& v) { *(u32x2*)(C + (unsigned)(r * 2048 + c)) = pack4(v); });
  }
}

DI void phase_norm(const float* __restrict__ X, const float* __restrict__ g, u16* __restrict__ H, int rows) {
  const int tid = otid(), lane = tid & 63, wave = tid >> 6;
  for (int row = blockIdx.x * 8 + wave; row < rows; row += gridDim.x * 8)
    norm_row_bf16(X + (size_t)row * 1024, g, H + (size_t)row * 1024, lane);
}

DI void phase_final_norm(float* X, const float* __restrict__ g) {
  const int tid = otid(), lane = tid & 63, wave = tid >> 6;
  for (int row = blockIdx.x * 8 + wave; row < T; row += gridDim.x * 8) {
    float* xr = X + (size_t)row * 1024;
    float4 v[4]; float ss = 0.f;
#pragma unroll
    for (int i = 0; i < 4; ++i) { v[i] = ((const float4*)xr)[i * 64 + lane]; ss += v[i].x * v[i].x + v[i].y * v[i].y + v[i].z * v[i].z + v[i].w * v[i].w; }
    ss = wave_sum(ss);
    const float rstd = 1.0f / sqrtf(ss * (1.f / 1024.f) + EPS);
#pragma unroll
    for (int i = 0; i < 4; ++i) {
      float4 gg = ((const float4*)g)[i * 64 + lane];
      float4 o; o.x = v[i].x * rstd * gg.x; o.y = v[i].y * rstd * gg.y; o.z = v[i].z * rstd * gg.z; o.w = v[i].w * rstd * gg.w;
      ((float4*)xr)[i * 64 + lane] = o;
    }
  }
}

DI void phase_gemm1(const Params& p, int l, int grp, char* smem) {
  const u16* H = (const u16*)(p.ws + O_H);
  const u16* W = (const u16*)(p.ws + O_WIN) + (size_t)l * E_WIN;
  u16* SEG = (u16*)(p.ws + O_SEG);
  const float* tab = (const float*)(p.ws + O_ROPE) + (size_t)grp * TG * 16;
  constexpr int NT = NSG / 256;
  TileWalk<4> tw(TG / 256, NT);
  int mt = 0, nt = 0;
  bool have = tw.next(mt, nt);
  if (have) { __syncthreads(); gemm_issue0<8>(H + (size_t)mt * 256 * 1024, 1024, W + (size_t)((nt < 19) ? nt * 256 : (nt + 4) * 256) * 1024, 1024, smem); }
  while (have) {
    const int wrow = (nt < 19) ? nt * 256 : (nt + 4) * 256;
    f32x4 acc[8][4]; zero_acc<8>(acc);
    gemm_run<8>(acc, H + (size_t)mt * 256 * 1024, 1024, W + (size_t)wrow * 1024, 1024, 1024, smem, true);
    int mt2 = 0, nt2 = 0;
    const bool have2 = tw.next(mt2, nt2);
    if (have2) gemm_issue0<8>(H + (size_t)mt2 * 256 * 1024, 1024, W + (size_t)((nt2 < 19) ? nt2 * 256 : (nt2 + 4) * 256) * 1024, 1024, smem);
    u16* segb = SEG + (size_t)mt * 256 * NSG + nt * 256;
    const float* tabb = tab + (size_t)mt * 256 * 16;
    {
      const int tid_ = otid(), lane_ = tid_ & 63, wid_ = __builtin_amdgcn_readfirstlane(tid_ >> 6), wr_ = wid_ >> 2, wc_ = wid_ & 3;
      const int li_ = lane_ & 15, lg_ = lane_ >> 4;
#pragma unroll
      for (int ni = 0; ni < 4; ++ni) {
        const int cb = nt * 256 + wc_ * 64 + ni * 16;
        bool rot = false; float scale = 1.f;
        if (cb < 2304) { const int jj = (cb % 768) >> 8; rot = (jj < 2); if (jj == 0) scale = 0.125f; }
        else if (cb < 3840) { const int c2 = cb - 2304; rot = (c2 < 1024); if (c2 < 512) scale = 0.125f; }
        rot = rot && (ni == 0);
        const bool gate = (cb >= GOFF);
        const int c = wc_ * 64 + ni * 16 + lg_ * 4;
#pragma unroll
        for (int mi = 0; mi < 8; ++mi) {
          if ((mi & 1) == 0) asm volatile("" ::: "memory");
          const int r = wr_ * 128 + mi * 16 + li_;
          f32x4 o = acc[mi][ni];
          if (rot) {
            f32x4 other;
            other[0] = __shfl_xor(o[0], 32); other[1] = __shfl_xor(o[1], 32); other[2] = __shfl_xor(o[2], 32); other[3] = __shfl_xor(o[3], 32);
            const f32x4 cs = *(const f32x4*)(tabb + (unsigned)(r * 16 + (lg_ & 1) * 4));
            const f32x4 sn = *(const f32x4*)(tabb + (unsigned)(r * 16 + 8 + (lg_ & 1) * 4));
            o = (lg_ < 2) ? (o * cs - other * sn) : (o * cs + other * sn);
          }
          if (gate) { o[0] = sigm(o[0]); o[1] = sigm(o[1]); o[2] = sigm(o[2]); o[3] = sigm(o[3]); }
          *(u32x2*)(segb + (unsigned)(r * NSG + c)) = pack4(o * scale);
        }
      }
    }
    mt = mt2; nt = nt2; have = have2;
  }
}

template <int DK> struct TileRegs {
  static constexpr int CPR = DK / 8, NCH = (64 * CPR) / NTH;
  u32x4 r[NCH];
  DI void load(const u16* __restrict__ src, long row_stride, int tid) {
#pragma unroll
    for (int i = 0; i < NCH; ++i) { const int c = tid + NTH * i, row = c / CPR, kc = c % CPR; r[i] = *(const u32x4*)(src + (long)row * row_stride + kc * 8); }
  }
  DI void store(char* dst, int pad, int tid) const {
    const int rs = DK * 2 + pad;
#pragma unroll
    for (int i = 0; i < NCH; ++i) { const int c = tid + NTH * i, row = c / CPR, kc = c % CPR; *(u32x4*)(dst + row * rs + kc * 16) = r[i]; }
  }
};
template <int DK>
DI void attn_scores(f32x4 (&Sa)[4], const bf16x8 (&Qf)[DK / 32], const char* Ks, int li, int lg) {
  constexpr int RS = DK * 2 + 16, NKS = DK / 32;
  const char* kb = Ks + li * RS + lg * 16;
  if (DK == 64) {
    bf16x8 kf[4][NKS];
#pragma unroll
    for (int ksub = 0; ksub < 4; ++ksub)
#pragma unroll
      for (int ks = 0; ks < NKS; ++ks) kf[ksub][ks] = *(const bf16x8*)(kb + ksub * 16 * RS + ks * 64);
#pragma unroll
    for (int ks = 0; ks < NKS; ++ks)
#pragma unroll
      for (int ksub = 0; ksub < 4; ++ksub) Sa[ksub] = mfma16(kf[ksub][ks], Qf[ks], Sa[ksub]);
    __builtin_amdgcn_sched_group_barrier(0x100, 4 * NKS, 0);
    __builtin_amdgcn_sched_group_barrier(0x008, 4 * NKS, 0);
    __builtin_amdgcn_sched_barrier(0);
  } else {
    constexpr int HK = NKS / 2;
    bf16x8 kf[2][HK];
#pragma unroll
    for (int ks = 0; ks < HK; ++ks) kf[0][ks] = *(const bf16x8*)(kb + ks * 64);
#pragma unroll
    for (int g = 0; g < 8; ++g) {
      const int ksub = g >> 1, hf = g & 1;
      if (g + 1 < 8) {
        const int ks2 = (g + 1) >> 1, hf2 = (g + 1) & 1;
#pragma unroll
        for (int ks = 0; ks < HK; ++ks) kf[(g + 1) & 1][ks] = *(const bf16x8*)(kb + ks2 * 16 * RS + (hf2 * HK + ks) * 64);
      }
#pragma unroll
      for (int ks = 0; ks < HK; ++ks) Sa[ksub] = mfma16(kf[g & 1][ks], Qf[hf * HK + ks], Sa[ksub]);
      __builtin_amdgcn_sched_group_barrier(0x008, 1, 0);
      if (g + 1 < 8) __builtin_amdgcn_sched_group_barrier(0x100, HK, 0);
      __builtin_amdgcn_sched_group_barrier(0x008, HK - 1, 0);
      __builtin_amdgcn_sched_barrier(0);
    }
  }
}
DI void softmax_step(f32x4 (&Sa)[4], float& m, float& l, float& alpha, bf16x8 (&P)[2]) {
  float mx = -INFINITY;
#pragma unroll
  for (int ksub = 0; ksub < 4; ++ksub)
#pragma unroll
    for (int j = 0; j < 4; ++j) mx = fmaxf(mx, Sa[ksub][j]);
  mx = fmaxf(mx, __shfl_xor(mx, 16));
  mx = fmaxf(mx, __shfl_xor(mx, 32));
  const float mn = fmaxf(m, mx);
  const float ms = (mn == -INFINITY) ? 0.f : mn;
  alpha = __expf(m - ms);
  float ps = 0.f;
#pragma unroll
  for (int ksub = 0; ksub < 4; ++ksub)
#pragma unroll
    for (int j = 0; j < 4; ++j) { const float e = __expf(Sa[ksub][j] - ms); ps += e; Sa[ksub][j] = e; }
  l = l * alpha + ps;
  m = mn;
#pragma unroll
  for (int kp = 0; kp < 2; ++kp) {
    u32x4 u;
    u[0] = pack2(Sa[2 * kp][0], Sa[2 * kp][1]); u[1] = pack2(Sa[2 * kp][2], Sa[2 * kp][3]);
    u[2] = pack2(Sa[2 * kp + 1][0], Sa[2 * kp + 1][1]); u[3] = pack2(Sa[2 * kp + 1][2], Sa[2 * kp + 1][3]);
    P[kp] = __builtin_bit_cast(bf16x8, u);
  }
}
typedef __attribute__((address_space(3))) s16x4* lds_s16x4_ptr;
template <int DV, int NMAP>
DI void attn_pv_pipe(f32x4 (&O1)[DV / 16], f32x4 (&O2)[DV / 16], const bf16x8 (&P1)[2], const bf16x8 (&P2)[2], float a1, float a2,
                     const char* Vs, int li, int lg) {
  constexpr int RS = DV * 2 + 32, NB = DV / 16, NC = NB / 2;
#pragma unroll
  for (int dt = 0; dt < NB; ++dt) { O1[dt] *= a1; if (NMAP == 2) O2[dt] *= a2; }
  const char* b0 = Vs + (lg * 4 + (li >> 2)) * RS + (li & 3) * 8;
  s16x4 vlo[2][2][2], vhi[2][2][2];
#pragma unroll
  for (int dtl = 0; dtl < 2; ++dtl)
#pragma unroll
    for (int kp = 0; kp < 2; ++kp) {
      const char* b = b0 + kp * 32 * RS + dtl * 32;
      vlo[0][dtl][kp] = __builtin_amdgcn_ds_read_tr16_b64_v4i16((lds_s16x4_ptr)(b));
      vhi[0][dtl][kp] = __builtin_amdgcn_ds_read_tr16_b64_v4i16((lds_s16x4_ptr)(b + 16 * RS));
    }
#pragma unroll
  for (int c = 0; c < NC; ++c) {
    if (c + 1 < NC) {
#pragma unroll
      for (int dtl = 0; dtl < 2; ++dtl)
#pragma unroll
        for (int kp = 0; kp < 2; ++kp) {
          const char* b = b0 + kp * 32 * RS + (2 * (c + 1) + dtl) * 32;
          vlo[(c + 1) & 1][dtl][kp] = __builtin_amdgcn_ds_read_tr16_b64_v4i16((lds_s16x4_ptr)(b));
          vhi[(c + 1) & 1][dtl][kp] = __builtin_amdgcn_ds_read_tr16_b64_v4i16((lds_s16x4_ptr)(b + 16 * RS));
        }
    }
#pragma unroll
    for (int dtl = 0; dtl < 2; ++dtl)
#pragma unroll
      for (int kp = 0; kp < 2; ++kp) {
        const bf16x8 vf = __builtin_shufflevector(vlo[c & 1][dtl][kp], vhi[c & 1][dtl][kp], 0, 1, 2, 3, 4, 5, 6, 7);
        O1[2 * c + dtl] = mfma16(vf, P1[kp], O1[2 * c + dtl]);
        if (NMAP == 2) O2[2 * c + dtl] = mfma16(vf, P2[kp], O2[2 * c + dtl]);
      }
    __builtin_amdgcn_sched_group_barrier(0x008, 1, 0);
    if (c + 1 < NC) __builtin_amdgcn_sched_group_barrier(0x100, 8, 0);
    __builtin_amdgcn_sched_group_barrier(0x008, 4 * NMAP - 1, 0);
    __builtin_amdgcn_sched_barrier(0);
  }
}
template <int DV>
DI void attn_pv(f32x4 (&O)[DV / 16], const bf16x8 (&P)[2], float alpha, const char* Vs, int li, int lg) {
  attn_pv_pipe<DV, 1>(O, O, P, P, alpha, alpha, Vs, li, lg);
}

DI void dil_attn_item(const Params& p, int item, char* smem) {
  const int blk = item & 31, h = (item >> 5) & 3, gb = item >> 7, g = gb % 3, bl = gb / 3;
  const int dil = (g == 0) ? 1 : (g == 1 ? 4 : 16);
  const int nb = 32 / dil, r = blk / nb, n = blk % nb;
  const int tid = otid(), lane = tid & 63, wave = tid >> 6, li = lane & 15, lg = lane >> 4;
  const u16* SEG = (const u16*)(p.ws + O_SEG);
  const long tok0 = (long)bl * S;
  const int qcol = g * 768 + h * 64, kcol = qcol + 256, vcol = qcol + 512;
  const int qi = wave * 16 + li;
  const long qtok = tok0 + (long)(n * 128 + qi) * dil + r;
  bf16x8 Qf[2];
#pragma unroll
  for (int ks = 0; ks < 2; ++ks) Qf[ks] = *(const bf16x8*)(SEG + qtok * NSG + qcol + ks * 32 + lg * 8);
  f32x4 O[4];
  float m = -INFINITY, l = 0.f, alpha;
#pragma unroll
  for (int dt = 0; dt < 4; ++dt) O[dt] = f32x4{0.f, 0.f, 0.f, 0.f};
  char* Ks = smem; char* Vs = smem + 64 * 144;
  const int kt0 = (n == 0) ? 2 : 0;
  TileRegs<64> rk, rv;
  {
    const long s0 = (long)((n - 1) * 128 + kt0 * 64) * dil + r;
    rk.load(SEG + (tok0 + s0) * NSG + kcol, (long)dil * NSG, tid);
    rv.load(SEG + (tok0 + s0) * NSG + vcol, (long)dil * NSG, tid);
  }
  for (int kt = kt0; kt < 4; ++kt) {
    __syncthreads();
    rk.store(Ks, 16, tid); rv.store(Vs, 32, tid);
    __syncthreads();
    if (kt + 1 < 4) {
      const long s0 = (long)((n - 1) * 128 + (kt + 1) * 64) * dil + r;
      rk.load(SEG + (tok0 + s0) * NSG + kcol, (long)dil * NSG, tid);
      rv.load(SEG + (tok0 + s0) * NSG + vcol, (long)dil * NSG, tid);
    }
    const int qlo = wave * 16, klo = kt * 64;
    if (klo + 63 >= qlo && klo <= qlo + 15 + 128) {
      f32x4 Sa[4];
#pragma unroll
      for (int ks = 0; ks < 4; ++ks) Sa[ks] = f32x4{0.f, 0.f, 0.f, 0.f};
      attn_scores<64>(Sa, Qf, Ks, li, lg);
#pragma unroll
      for (int ksub = 0; ksub < 4; ++ksub)
#pragma unroll
        for (int j = 0; j < 4; ++j) {
          const int kj = klo + ksub * 16 + lg * 4 + j;
          const int dist = qi + 128 - kj;
          if (dist < 0 || dist > 128) Sa[ksub][j] = -INFINITY;
        }
      bf16x8 P[2];
      softmax_step(Sa, m, l, alpha, P);
      attn_pv<64>(O, P, alpha, Vs, li, lg);
    }
  }
  u16* OG = (u16*)(p.ws + O_OG);
  float* LSE = (float*)(p.ws + O_LSE);
  float lt = l; lt += __shfl_xor(lt, 16); lt += __shfl_xor(lt, 32);
  const float inv = 1.f / lt;
#pragma unroll
  for (int dt = 0; dt < 4; ++dt) {
    u32x2 o; o[0] = pack2(O[dt][0] * inv, O[dt][1] * inv); o[1] = pack2(O[dt][2] * inv, O[dt][3] * inv);
    *(u32x2*)(OG + qtok * 768 + g * 256 + h * 64 + dt * 16 + lg * 4) = o;
  }
  if (lg == 0) LSE[qtok * 12 + g * 4 + h] = m + __logf(lt);
}

DI void diff_attn_item(const Params& p, int l_, int item, char* smem) {
  const int n = 31 - (item & 31), h = (item >> 5) & 3, bl = item >> 7;
  const int tid = otid(), lane = tid & 63, wave = tid >> 6, li = lane & 15, lg = lane >> 4;
  const u16* SEG = (const u16*)(p.ws + O_SEG);
  const long tok0 = (long)bl * S;
  const int qcol = 2304 + h * 128, kcol = 2304 + 512 + h * 128, vcol = 2304 + 1024 + h * 128;
  const int qlo = n * 128 + wave * 16;
  const int q = qlo + li;
  bf16x8 Q1[2], Q2[2];
#pragma unroll
  for (int ks = 0; ks < 2; ++ks) {
    Q1[ks] = *(const bf16x8*)(SEG + (tok0 + q) * NSG + qcol + ks * 32 + lg * 8);
    Q2[ks] = *(const bf16x8*)(SEG + (tok0 + q) * NSG + qcol + 64 + ks * 32 + lg * 8);
  }
  f32x4 O1[8], O2[8];
  float m1 = -INFINITY, l1 = 0.f, m2 = -INFINITY, l2 = 0.f, alpha;
#pragma unroll
  for (int dt = 0; dt < 8; ++dt) { O1[dt] = f32x4{0.f, 0.f, 0.f, 0.f}; O2[dt] = f32x4{0.f, 0.f, 0.f, 0.f}; }
  char* K1s = smem; char* K2s = smem + 9216; char* Vs = smem + 18432;
  TileRegs<64> rk1, rk2; TileRegs<128> rv;
  rk1.load(SEG + tok0 * NSG + kcol, NSG, tid);
  rk2.load(SEG + tok0 * NSG + kcol + 64, NSG, tid);
  rv.load(SEG + tok0 * NSG + vcol, NSG, tid);
  const int nt = 2 * n + 2;
  for (int kt = 0; kt < nt; ++kt) {
    __syncthreads();
    rk1.store(K1s, 16, tid); rk2.store(K2s, 16, tid); rv.store(Vs, 32, tid);
    __syncthreads();
    if (kt + 1 < nt) {
      const long kr = tok0 + (kt + 1) * 64;
      rk1.load(SEG + kr * NSG + kcol, NSG, tid);
      rk2.load(SEG + kr * NSG + kcol + 64, NSG, tid);
      rv.load(SEG + kr * NSG + vcol, NSG, tid);
    }
    const int klo = kt * 64;
    if (klo <= qlo + 15) {
      const bool need_mask = (klo + 63 > qlo);
      bf16x8 P[2], Pb[2];
      float alpha2;
      f32x4 Sa[4], Sb[4];
#pragma unroll
      for (int ks = 0; ks < 4; ++ks) { Sa[ks] = f32x4{0.f, 0.f, 0.f, 0.f}; Sb[ks] = f32x4{0.f, 0.f, 0.f, 0.f}; }
      attn_scores<64>(Sa, Q1, K1s, li, lg);
      attn_scores<64>(Sb, Q2, K2s, li, lg);
      if (need_mask) {
#pragma unroll
        for (int ksub = 0; ksub < 4; ++ksub)
#pragma unroll
          for (int j = 0; j < 4; ++j) if (klo + ksub * 16 + lg * 4 + j > q) { Sa[ksub][j] = -INFINITY; Sb[ksub][j] = -INFINITY; }
      }
      softmax_step(Sa, m1, l1, alpha, P);
      softmax_step(Sb, m2, l2, alpha2, Pb);
      attn_pv_pipe<128, 2>(O1, O2, P, Pb, alpha, alpha2, Vs, li, lg);
    }
  }
  float lt1 = l1; lt1 += __shfl_xor(lt1, 16); lt1 += __shfl_xor(lt1, 32);
  float lt2 = l2; lt2 += __shfl_xor(lt2, 16); lt2 += __shfl_xor(lt2, 32);
  const float lam = ((const float*)(p.ws + O_SCAL))[l_];
  const float lam_init = (l_ == 0) ? 0.2f : 0.355509067591f;
  const float i1 = 1.f / lt1, i2 = lam / lt2;
  float ss = 0.f;
#pragma unroll
  for (int dt = 0; dt < 8; ++dt)
#pragma unroll
    for (int j = 0; j < 4; ++j) { const float o = O1[dt][j] * i1 - O2[dt][j] * i2; O1[dt][j] = o; ss += o * o; }
  ss += __shfl_xor(ss, 16); ss += __shfl_xor(ss, 32);
  const float rstd = (1.f - lam_init) / sqrtf(ss * (1.f / 128.f) + EPS);
  const float* ng = p.in[6] + l_ * 128;
  u16* Y = (u16*)(p.ws + O_Y);
#pragma unroll
  for (int dt = 0; dt < 8; ++dt) {
    const int dv = dt * 16 + lg * 4;
    const float4 gg = *(const float4*)(ng + dv);
    u32x2 o; o[0] = pack2(O1[dt][0] * rstd * gg.x, O1[dt][1] * rstd * gg.y); o[1] = pack2(O1[dt][2] * rstd * gg.z, O1[dt][3] * rstd * gg.w);
    *(u32x2*)(Y + (tok0 + q) * YW + 256 + h * 128 + dv) = o;
  }
}

DI void cross_attn_item(const Params& p, int l_, int grp, int item, char* smem) {
  const int qb = item & 31, hm = (item >> 5) & 3, bl = item >> 7;
  const int tid = otid(), lane = tid & 63, wave = tid >> 6, li = lane & 15, lg = lane >> 4;
  const u16* Q = (const u16*)(p.ws + O_Q);
  const u16* KV = (const u16*)(p.ws + O_KV) + (size_t)l_ * 4096 * 2048 + (size_t)(grp * BG + bl) * 256 * 2048;
  const long tok = (long)bl * S + qb * 128 + wave * 16 + li;
  bf16x8 Qf[8];
#pragma unroll
  for (int ks = 0; ks < 8; ++ks) Qf[ks] = *(const bf16x8*)(Q + tok * 1024 + hm * 256 + ks * 32 + lg * 8);
  f32x4 O[16];
#pragma unroll
  for (int dt = 0; dt < 16; ++dt) O[dt] = f32x4{0.f, 0.f, 0.f, 0.f};
  float m = -INFINITY, l = 0.f, alpha;
  char* Ks = smem; char* Vs = smem + 64 * 528;
  TileRegs<256> rk, rv;
  rk.load(KV + hm * 256, 2048, tid);
  rv.load(KV + 1024 + hm * 256, 2048, tid);
  for (int kt = 0; kt < 4; ++kt) {
    __syncthreads();
    rk.store(Ks, 16, tid); rv.store(Vs, 32, tid);
    __syncthreads();
    if (kt + 1 < 4) {
      rk.load(KV + (size_t)((kt + 1) * 64) * 2048 + hm * 256, 2048, tid);
      rv.load(KV + (size_t)((kt + 1) * 64) * 2048 + 1024 + hm * 256, 2048, tid);
    }
    f32x4 Sa[4];
#pragma unroll
    for (int ks = 0; ks < 4; ++ks) Sa[ks] = f32x4{0.f, 0.f, 0.f, 0.f};
    attn_scores<256>(Sa, Qf, Ks, li, lg);
    bf16x8 P[2];
    softmax_step(Sa, m, l, alpha, P);
    attn_pv<256>(O, P, alpha, Vs, li, lg);
  }
  float lt = l; lt += __shfl_xor(lt, 16); lt += __shfl_xor(lt, 32);
  const float inv = 1.f / lt;
  u16* OB = (u16*)(p.ws + O_O);
#pragma unroll
  for (int dt = 0; dt < 16; ++dt) {
    u32x2 o; o[0] = pack2(O[dt][0] * inv, O[dt][1] * inv); o[1] = pack2(O[dt][2] * inv, O[dt][3] * inv);
    *(u32x2*)(OB + tok * 1024 + hm * 256 + dt * 16 + lg * 4) = o;
  }
}

template <int PASS>
DI void hgrn_item(const Params& p, int l_, int item, char* smem) {
  const int c = item & 31, h = (item >> 5) & 3, bl = item >> 7;
  const int tid = otid(), v = tid & 63, kq = tid >> 6;
  float* sF = (float*)smem;
  float* sK = sF + 1024;
  float* sQ = sK + 1024;
  float* sI = sQ + 1024;
  float* sG = sI + 1024;
  float* sO = sG + 1024;
  const u16* SEG = (const u16*)(p.ws + O_SEG);
  float* HGS = (float*)(p.ws + O_HGS);
  float* HGF = (float*)(p.ws + O_HGF);
  const int arr = tid >> 7, stok = (tid >> 3) & 15, sch = tid & 7;
  const bool ld_on = (PASS == 3) || (arr == 1) || (arr == 2);
  const u16* sbase = SEG + ((size_t)bl * S + c * 128 + stok) * NSG + 3840 + arr * 256 + h * 64 + sch * 8;
  float lbv[8];
#pragma unroll
  for (int e = 0; e < 8; ++e) {
    lbv[e] = 0.f;
    if (l_ == 1) { const float* lg0 = p.in[7]; const int k = h * 64 + sch * 8 + e; lbv[e] = 1.f / (1.f + __expf(lg0[k] - lg0[256 + k])); }
  }
  u32x4 pre = u32x4{0u, 0u, 0u, 0u};
  if (ld_on) pre = *(const u32x4*)sbase;
  float s[8], Fp[8];
#pragma unroll
  for (int e = 0; e < 8; ++e) { s[e] = 0.f; Fp[e] = 1.f; }
  if (PASS == 3) {
#pragma unroll 4
    for (int cc = 0; cc < c; ++cc) {
      const size_t it = (size_t)((bl * 4 + h) * 32 + cc);
      const float* st = HGS + it * 4096;
      const float* ff = HGF + it * 64;
#pragma unroll
      for (int e = 0; e < 8; ++e) { const int k = kq * 8 + e; s[e] = ff[k] * s[e] + st[k * 64 + v]; }
    }
  }
#pragma unroll 1
  for (int sub = 0; sub < 8; ++sub) {
    const int t0 = c * 128 + sub * 16;
    __syncthreads();
    if (ld_on) {
      float x[8];
      x[0] = bflo(pre[0]); x[1] = bfhi(pre[0]); x[2] = bflo(pre[1]); x[3] = bfhi(pre[1]);
      x[4] = bflo(pre[2]); x[5] = bfhi(pre[2]); x[6] = bflo(pre[3]); x[7] = bfhi(pre[3]);
      const int o = stok * 64 + sch * 8;
      if (arr == 1) {
#pragma unroll
        for (int e = 0; e < 8; ++e) { sF[o + e] = lbv[e] + (1.f - lbv[e]) * sigm(x[e]); sK[o + e] = (1.f - lbv[e]) * sigm(-x[e]); }
      } else if (arr == 2) {
#pragma unroll
        for (int e = 0; e < 8; ++e) sI[o + e] = x[e];
      } else if (arr == 0) {
#pragma unroll
        for (int e = 0; e < 8; ++e) sQ[o + e] = silu(x[e]);
      } else {
#pragma unroll
        for (int e = 0; e < 8; ++e) sG[o + e] = silu(x[e]);
      }
    }
    __syncthreads();
    if (ld_on && sub + 1 < 8) pre = *(const u32x4*)(sbase + (size_t)(sub + 1) * 16 * NSG);
    {
      float ivn = sI[v];
      float4 fn[2], kn[2], qn[2];
#pragma unroll
      for (int e4 = 0; e4 < 2; ++e4) {
        fn[e4] = *(const float4*)(sF + kq * 8 + e4 * 4); kn[e4] = *(const float4*)(sK + kq * 8 + e4 * 4);
        if (PASS == 3) qn[e4] = *(const float4*)(sQ + kq * 8 + e4 * 4);
      }
#pragma unroll 4
      for (int tt = 0; tt < 16; ++tt) {
        const float iv = ivn;
        float4 fc[2], kc[2], qc[2];
#pragma unroll
        for (int e4 = 0; e4 < 2; ++e4) { fc[e4] = fn[e4]; kc[e4] = kn[e4]; if (PASS == 3) qc[e4] = qn[e4]; }
        {
          const int tn = (tt + 1) & 15;
          ivn = sI[tn * 64 + v];
#pragma unroll
          for (int e4 = 0; e4 < 2; ++e4) {
            fn[e4] = *(const float4*)(sF + tn * 64 + kq * 8 + e4 * 4); kn[e4] = *(const float4*)(sK + tn * 64 + kq * 8 + e4 * 4);
            if (PASS == 3) qn[e4] = *(const float4*)(sQ + tn * 64 + kq * 8 + e4 * 4);
          }
        }
        __builtin_amdgcn_sched_barrier(0);
        float o = 0.f;
#pragma unroll
        for (int e4 = 0; e4 < 2; ++e4) {
          const float4 f4 = fc[e4], k4 = kc[e4];
          s[e4 * 4 + 0] = f4.x * s[e4 * 4 + 0] + k4.x * iv;
          s[e4 * 4 + 1] = f4.y * s[e4 * 4 + 1] + k4.y * iv;
          s[e4 * 4 + 2] = f4.z * s[e4 * 4 + 2] + k4.z * iv;
          s[e4 * 4 + 3] = f4.w * s[e4 * 4 + 3] + k4.w * iv;
          if (PASS == 1) { Fp[e4 * 4 + 0] *= f4.x; Fp[e4 * 4 + 1] *= f4.y; Fp[e4 * 4 + 2] *= f4.z; Fp[e4 * 4 + 3] *= f4.w; }
          if (PASS == 3) {
            const float4 q4 = qc[e4];
            o += s[e4 * 4 + 0] * q4.x + s[e4 * 4 + 1] * q4.y + s[e4 * 4 + 2] * q4.z + s[e4 * 4 + 3] * q4.w;
          }
        }
        if (PASS == 3) sO[(tt * 8 + kq) * 64 + v] = o;
        __builtin_amdgcn_sched_barrier(0);
      }
    }
    if (PASS == 3) {
      __syncthreads();
      u16* Y = (u16*)(p.ws + O_Y);
      const float* ng = p.in[8] + l_ * 64;
#pragma unroll
      for (int i = 0; i < 2; ++i) {
        const int tt = i * 8 + kq;
        float o = 0.f;
#pragma unroll
        for (int qq = 0; qq < 8; ++qq) o += sO[(tt * 8 + qq) * 64 + v];
        const float ss = wave_sum(o * o);
        const float rstd = 1.0f / sqrtf(ss * (1.f / 64.f) + EPS);
        const size_t tok = (size_t)bl * S + t0 + tt;
        Y[tok * YW + 768 + h * 64 + v] = f2bf(o * rstd * ng[v] * sG[tt * 64 + v]);
      }
    }
  }
  if (PASS == 1) {
#pragma unroll
    for (int e = 0; e < 8; ++e) {
      HGS[(size_t)item * 4096 + (kq * 8 + e) * 64 + v] = s[e];
      if (v == 0) HGF[(size_t)item * 64 + kq * 8 + e] = Fp[e];
    }
  }
}

DI void rwkv_prep_item(const Params& p, int l_, int item, char* smem) {
  const int tid = otid(), lane = tid & 63, wave = tid >> 6, c = tid & 255, half = tid >> 8;
  float* lin = (float*)smem;
  float* vv = lin + 4096;
  float* t1 = vv + 4096;
  float* sV1 = t1 + 512;
  const u16* SEGD = (const u16*)(p.ws + O_SEGD);
  const float* mu = p.in[9] + l_ * 1024;
  const size_t tokb = (size_t)item * 16 + half * 8;
  u16* VF = (u16*)(p.ws + O_VFIRST);
  float xr[8], xk[8];
  float vfv[8];
  __syncthreads();
  {
    const float mr = mu[c], mk = mu[256 + c], mv = mu[512 + c], ml = mu[768 + c];
    u16 raw[9][4];
    const bool first0 = ((tokb & (S - 1)) == 0);
#pragma unroll
    for (int rr = 0; rr < 9; ++rr) {
      const u16* row = SEGD + (tokb + rr - 1) * 1024;
      if (rr == 0 && first0) { raw[rr][0] = 0; raw[rr][1] = 0; raw[rr][2] = 0; raw[rr][3] = 0; }
      else { raw[rr][0] = row[c]; raw[rr][1] = row[256 + c]; raw[rr][2] = row[512 + c]; raw[rr][3] = row[768 + c]; }
    }
    if (l_ == 1) {
#pragma unroll
      for (int tk = 0; tk < 8; ++tk) vfv[tk] = bf2f(VF[(tokb + tk) * 256 + c]);
      const float4* v1 = (const float4*)p.in[21];
#pragma unroll
      for (int i = 0; i < 4; ++i) ((float4*)sV1)[tid + NTH * i] = v1[tid + NTH * i];
    }
#pragma unroll
    for (int tk = 0; tk < 8; ++tk) {
      float a, b;
      a = bf2f(raw[tk + 1][0]); b = bf2f(raw[tk][0]); xr[tk] = a + (b - a) * mr;
      a = bf2f(raw[tk + 1][1]); b = bf2f(raw[tk][1]); xk[tk] = a + (b - a) * mk;
      a = bf2f(raw[tk + 1][2]); b = bf2f(raw[tk][2]); const float xv_ = a + (b - a) * mv;
      a = bf2f(raw[tk + 1][3]); b = bf2f(raw[tk][3]);
      float x = a + (b - a) * ml;
      if (c < 64) x = 1.f - 2.f / (__expf(2.f * x) + 1.f);
      else if (c >= 128) x = sigm(x);
      lin[(half * 8 + tk) * 256 + c] = x;
      vv[(half * 8 + tk) * 256 + c] = xv_;
    }
  }
  __syncthreads();
  float lw[8], la[8], lgg[8];
#pragma unroll
  for (int tk = 0; tk < 8; ++tk) { lw[tk] = 0.f; la[tk] = 0.f; lgg[tk] = 0.f; }
  const float* w2 = p.in[11] + l_ * 64 * 256;
  const float* a2 = p.in[13] + l_ * 64 * 256;
  const float* g2 = p.in[14] + l_ * 128 * 256;
  float wn[16];
#pragma unroll
  for (int j = 0; j < 16; ++j) wn[j] = w2[j * 256 + c];
#pragma unroll 1
  for (int ch = 0; ch < 16; ++ch) {
    float wr[16];
#pragma unroll
    for (int j = 0; j < 16; ++j) wr[j] = wn[j];
    if (ch + 1 < 16) {
      const int cn = ch + 1;
      const float* wsrc = (cn < 4) ? (w2 + cn * 16 * 256) : (cn < 8 ? (a2 + (cn - 4) * 16 * 256) : (g2 + (cn - 8) * 16 * 256));
#pragma unroll
      for (int j = 0; j < 16; ++j) wn[j] = wsrc[j * 256 + c];
    }
#pragma unroll
    for (int tk = 0; tk < 8; ++tk) {
      float acc = 0.f;
#pragma unroll
      for (int j4 = 0; j4 < 4; ++j4) {
        const float4 x4 = *(const float4*)(lin + (half * 8 + tk) * 256 + ch * 16 + j4 * 4);
        acc += x4.x * wr[j4 * 4] + x4.y * wr[j4 * 4 + 1] + x4.z * wr[j4 * 4 + 2] + x4.w * wr[j4 * 4 + 3];
      }
      if (ch < 4) lw[tk] += acc; else if (ch < 8) la[tk] += acc; else lgg[tk] += acc;
    }
  }
  float vmixw[8];
  if (l_ == 1) {
    {
      const int tk = tid >> 5, j0 = tid & 31;
      float a0 = 0.f, a1 = 0.f;
#pragma unroll 8
      for (int cc = 0; cc < 256; cc += 2) { a0 += vv[tk * 256 + cc] * sV1[cc * 32 + j0]; a1 += vv[tk * 256 + cc + 1] * sV1[(cc + 1) * 32 + j0]; }
      t1[tk * 32 + j0] = a0 + a1;
    }
    const float* v2 = p.in[22];
    float wr[32];
#pragma unroll
    for (int j = 0; j < 32; ++j) wr[j] = v2[j * 256 + c];
    __syncthreads();
#pragma unroll
    for (int tk = 0; tk < 8; ++tk) {
      float acc = 0.f;
#pragma unroll
      for (int j4 = 0; j4 < 8; ++j4) {
        const float4 x4 = *(const float4*)(t1 + (half * 8 + tk) * 32 + j4 * 4);
        acc += x4.x * wr[j4 * 4] + x4.y * wr[j4 * 4 + 1] + x4.z * wr[j4 * 4 + 2] + x4.w * wr[j4 * 4 + 3];
      }
      vmixw[tk] = acc;
    }
  }
  const float w0 = p.in[10][l_ * 256 + c], a0 = p.in[12][l_ * 256 + c];
  const float k_k = p.in[15][l_ * 256 + c], k_a = p.in[16][l_ * 256 + c], r_k = p.in[17][l_ * 256 + c];
  const float v0 = (l_ == 1) ? p.in[20][c] : 0.f;
  u16* RWR = (u16*)(p.ws + O_RWR); u16* RWK = (u16*)(p.ws + O_RWK); u16* RWV = (u16*)(p.ws + O_RWV);
  u16* RWKK = (u16*)(p.ws + O_RWKK); u16* RWKKA = (u16*)(p.ws + O_RWKKA); u16* RWG = (u16*)(p.ws + O_RWG);
  float* RWW = (float*)(p.ws + O_RWW); float* RWRK = (float*)(p.ws + O_RWRK);
#pragma unroll
  for (int tk = 0; tk < 8; ++tk) {
    const size_t tok = tokb + tk;
    const float xv_ = vv[(half * 8 + tk) * 256 + c];
    const float u = w0 + lw[tk];
    const float z = -u;
    const float sp = fmaxf(z, 0.f) + __logf(1.f + __expf(-fabsf(z)));
    const float wv = -sp - 0.5f;
    const float decay = __expf(-__expf(wv));
    const float a = sigm(a0 + la[tk]);
    const float kkx = xk[tk] * k_k;
    const float nrm = sqrtf(wave_sum(kkx * kkx));
    const float kkn = kkx / fmaxf(nrm, 1e-12f);
    const float k2 = xk[tk] * (1.f + (a - 1.f) * k_a);
    float v2v = xv_;
    if (l_ == 0) VF[tok * 256 + c] = f2bf(v2v);
    else v2v = v2v + (vfv[tk] - v2v) * sigm(v0 + vmixw[tk]);
    const float rk = wave_sum(xr[tk] * k2 * r_k);
    RWR[tok * 256 + c] = f2bf(xr[tk]);
    RWK[tok * 256 + c] = f2bf(k2);
    RWV[tok * 256 + c] = f2bf(v2v);
    RWKK[tok * 256 + c] = f2bf(kkn);
    RWKKA[tok * 256 + c] = f2bf(kkn * a);
    RWG[tok * 256 + c] = f2bf(lgg[tk]);
    RWW[tok * 256 + c] = decay;
    if (lane == 0) RWRK[tok * 4 + (wave & 3)] = rk;
  }
}

DI void rwkv_scan_item(const Params& p, int item, char* smem) {
  const int rg = item & 1, h = (item >> 1) & 3, b = item >> 3;
  const int tid = otid(), lane = tid & 63, wave = tid >> 6, kap = lane & 15, rho = lane >> 4;
  const int rowh = rg * 32 + wave * 4 + rho;
  float* sW = (float*)smem;
  float* sKK = sW + 2048;
  float* sKA = sKK + 2048;
  float* sK = sKA + 2048;
  float* sR = sK + 2048;
  float* sV = sR + 2048;
  float* sY = sV + 2048;
  const float* RWW = (const float*)(p.ws + O_RWW);
  const u16* RWR = (const u16*)(p.ws + O_RWR); const u16* RWK = (const u16*)(p.ws + O_RWK); const u16* RWV = (const u16*)(p.ws + O_RWV);
  const u16* RWKK = (const u16*)(p.ws + O_RWKK); const u16* RWKKA = (const u16*)(p.ws + O_RWKKA);
  float* RWY = (float*)(p.ws + O_RWY);
  const size_t tokb = (size_t)b * S;
  u32x4 pw, pa, pb, pv;
  const int wtok = tid >> 4, wch = tid & 15;
  const int hsel = tid >> 8, btok = (tid & 255) >> 3, bch = tid & 7;
  const u16* arrA = hsel ? RWKKA : RWKK;
  const u16* arrB = hsel ? RWR : RWK;
  float* dstA = hsel ? sKA : sKK;
  float* dstB = hsel ? sR : sK;
  const float sgnA = hsel ? 1.f : -1.f;
  pv = u32x4{0u, 0u, 0u, 0u};
  float S0 = 0.f, S1 = 0.f, S2 = 0.f, S3 = 0.f;
  {
    pw = *(const u32x4*)(RWW + (tokb + wtok) * 256 + h * 64 + wch * 4);
    const size_t off = (tokb + btok) * 256 + h * 64 + bch * 8;
    pa = *(const u32x4*)(arrA + off); pb = *(const u32x4*)(arrB + off);
    if (hsel == 0) pv = *(const u32x4*)(RWV + off);
  }
#pragma unroll 1
  for (int c = 0; c < S / 32; ++c) {
    __syncthreads();
    *(u32x4*)(sW + wtok * 64 + wch * 4) = pw;
    {
      float* da = dstA + btok * 64 + bch * 8; float* db = dstB + btok * 64 + bch * 8;
      *(f32x4*)(da) = f32x4{bflo(pa[0]) * sgnA, bfhi(pa[0]) * sgnA, bflo(pa[1]) * sgnA, bfhi(pa[1]) * sgnA};
      *(f32x4*)(da + 4) = f32x4{bflo(pa[2]) * sgnA, bfhi(pa[2]) * sgnA, bflo(pa[3]) * sgnA, bfhi(pa[3]) * sgnA};
      *(f32x4*)(db) = f32x4{bflo(pb[0]), bfhi(pb[0]), bflo(pb[1]), bfhi(pb[1])};
      *(f32x4*)(db + 4) = f32x4{bflo(pb[2]), bfhi(pb[2]), bflo(pb[3]), bfhi(pb[3])};
      if (hsel == 0) {
        float* dv = sV + btok * 64 + bch * 8;
        *(f32x4*)(dv) = f32x4{bflo(pv[0]), bfhi(pv[0]), bflo(pv[1]), bfhi(pv[1])};
        *(f32x4*)(dv + 4) = f32x4{bflo(pv[2]), bfhi(pv[2]), bflo(pv[3]), bfhi(pv[3])};
      }
    }
    __syncthreads();
    if (c + 1 < S / 32) {
      const size_t t0 = tokb + (size_t)(c + 1) * 32;
      pw = *(const u32x4*)(RWW + (t0 + wtok) * 256 + h * 64 + wch * 4);
      const size_t off = (t0 + btok) * 256 + h * 64 + bch * 8;
      pa = *(const u32x4*)(arrA + off); pb = *(const u32x4*)(arrB + off);
      if (hsel == 0) pv = *(const u32x4*)(RWV + off);
    }
    f32x4 w4n = *(const f32x4*)(sW + kap * 4), nk4n = *(const f32x4*)(sKK + kap * 4), ka4n = *(const f32x4*)(sKA + kap * 4);
    f32x4 k4n = *(const f32x4*)(sK + kap * 4), r4n = *(const f32x4*)(sR + kap * 4);
    float vvn = sV[rowh];
    f32x4 rprev = f32x4{0.f, 0.f, 0.f, 0.f};
#pragma unroll 4
    for (int tt = 0; tt < 32; ++tt) {
      const f32x4 w4 = w4n, nk4 = nk4n, ka4 = ka4n, k4 = k4n, r4 = r4n;
      const float vv = vvn;
      {
        const int tn = (tt + 1) & 31;
        w4n = *(const f32x4*)(sW + tn * 64 + kap * 4); nk4n = *(const f32x4*)(sKK + tn * 64 + kap * 4); ka4n = *(const f32x4*)(sKA + tn * 64 + kap * 4);
        k4n = *(const f32x4*)(sK + tn * 64 + kap * 4); r4n = *(const f32x4*)(sR + tn * 64 + kap * 4);
        vvn = sV[tn * 64 + rowh];
      }
      __builtin_amdgcn_sched_barrier(0);
      float sa, y;
      float u0, u1, u2, u3;
      {
        float a1 = S0 * nk4[0], b1 = S0 * rprev[0];
        float a2 = S2 * nk4[2], b2 = S2 * rprev[2];
        a1 = fmaf(S1, nk4[1], a1); b1 = fmaf(S1, rprev[1], b1);
        a2 = fmaf(S3, nk4[3], a2); b2 = fmaf(S3, rprev[3], b2);
        sa = a1 + a2; y = b1 + b2;
        u0 = vv * k4[0]; u1 = vv * k4[1];
        sa += dpp_mov<0xB1>(sa);  y += dpp_mov<0xB1>(y);
        u2 = vv * k4[2]; u3 = vv * k4[3];
        sa += dpp_mov<0x4E>(sa);  y += dpp_mov<0x4E>(y);
        u0 = fmaf(S0, w4[0], u0); u1 = fmaf(S1, w4[1], u1);
        sa += dpp_mov<0x141>(sa); y += dpp_mov<0x141>(y);
        u2 = fmaf(S2, w4[2], u2); u3 = fmaf(S3, w4[3], u3);
        sa += dpp_mov<0x140>(sa); y += dpp_mov<0x140>(y);
      }
      if (tt > 0 && kap == 0) sY[(tt - 1) * 32 + wave * 4 + rho] = y;
      S0 = fmaf(sa, ka4[0], u0);
      S1 = fmaf(sa, ka4[1], u1);
      S2 = fmaf(sa, ka4[2], u2);
      S3 = fmaf(sa, ka4[3], u3);
      rprev = r4;
      __builtin_amdgcn_sched_barrier(0);
    }
    {
      float y = (S0 * rprev[0] + S1 * rprev[1]) + (S2 * rprev[2] + S3 * rprev[3]);
      y = red16(y);
      if (kap == 0) sY[31 * 32 + wave * 4 + rho] = y;
    }
    __syncthreads();
    {
      const size_t t0 = tokb + (size_t)c * 32;
#pragma unroll
      for (int i = 0; i < 2; ++i) {
        const int idx = tid + NTH * i, tt = idx >> 5, rr = idx & 31;
        RWY[(t0 + tt) * 256 + h * 64 + rg * 32 + rr] = sY[idx];
      }
    }
  }
}

DI void rwkv_post_item(const Params& p, int l_, int item) {
  const int tid = otid(), wave = tid >> 6, c = tid & 255, half = tid >> 8;
  const float* RWY = (const float*)(p.ws + O_RWY);
  const float* RWRK = (const float*)(p.ws + O_RWRK);
  const u16* RWV = (const u16*)(p.ws + O_RWV); const u16* RWG = (const u16*)(p.ws + O_RWG);
  u16* YD = (u16*)(p.ws + O_YD);
  const float lg = p.in[18][l_ * 256 + c], lb = p.in[19][l_ * 256 + c];
#pragma unroll 1
  for (int it = 0; it < 8; ++it) {
    float y[4], rk[4], vv[4], gg[4];
#pragma unroll
    for (int u = 0; u < 4; ++u) {
      const size_t tok = (size_t)item * 64 + (it * 4 + u) * 2 + half;
      y[u] = RWY[tok * 256 + c]; rk[u] = RWRK[tok * 4 + (wave & 3)];
      vv[u] = bf2f(RWV[tok * 256 + c]); gg[u] = bf2f(RWG[tok * 256 + c]);
    }
#pragma unroll
    for (int u = 0; u < 4; ++u) {
      const size_t tok = (size_t)item * 64 + (it * 4 + u) * 2 + half;
      const float mean = wave_sum(y[u]) * (1.f / 64.f);
      const float d = y[u] - mean;
      const float var = wave_sum(d * d) * (1.f / 64.f);
      const float yn = d / sqrtf(var + 64e-5f) * lg + lb;
      YD[tok * 256 + c] = f2bf((yn + rk[u] * vv[u]) * gg[u]);
    }
  }
}

DI void dil_combine_item(const Params& p, int item) {
  const int tid = otid(), ch = tid & 31, tl = tid >> 5, h = ch >> 3;
  const u16* OG = (const u16*)(p.ws + O_OG);
  const float* LSE = (const float*)(p.ws + O_LSE);
  u16* Y = (u16*)(p.ws + O_Y);
  u32x4 o0[4], o1[4], o2[4]; float l0[4], l1[4], l2[4];
#pragma unroll
  for (int ps = 0; ps < 4; ++ps) {
    const size_t tok = (size_t)item * 64 + ps * 16 + tl;
    o0[ps] = *(const u32x4*)(OG + tok * 768 + ch * 8);
    o1[ps] = *(const u32x4*)(OG + tok * 768 + 256 + ch * 8);
    o2[ps] = *(const u32x4*)(OG + tok * 768 + 512 + ch * 8);
    l0[ps] = LSE[tok * 12 + h]; l1[ps] = LSE[tok * 12 + 4 + h]; l2[ps] = LSE[tok * 12 + 8 + h];
  }
#pragma unroll
  for (int ps = 0; ps < 4; ++ps) {
    const size_t tok = (size_t)item * 64 + ps * 16 + tl;
    const float mx = fmaxf(l0[ps], fmaxf(l1[ps], l2[ps]));
    float e0 = __expf(l0[ps] - mx), e1 = __expf(l1[ps] - mx), e2 = __expf(l2[ps] - mx);
    const float inv = 1.f / (e0 + e1 + e2);
    e0 *= inv; e1 *= inv; e2 *= inv;
    u32x4 r;
#pragma unroll
    for (int q = 0; q < 4; ++q)
      r[q] = pack2(e0 * bflo(o0[ps][q]) + e1 * bflo(o1[ps][q]) + e2 * bflo(o2[ps][q]), e0 * bfhi(o0[ps][q]) + e1 * bfhi(o1[ps][q]) + e2 * bfhi(o2[ps][q]));
    *(u32x4*)(Y + tok * YW + ch * 8) = r;
  }
}

DI int next_item(int* counter, int* s_item) {
  __syncthreads();
  if (otid() == 0) *s_item = atomicAdd(counter, 1);
  __syncthreads();
  return *s_item;
}
constexpr int N_DIL = BG * 3 * 4 * 32, N_HG = BG * 4 * 32;
constexpr int N_SCAN = NB * 8, N_DIFF = BG * 4 * 32, N_COMB = TG / 64;

DI void phase_stage1(const Params& p, int l, int grp, char* smem, int* s_item) {
  int* counter = (int*)(p.ws + O_CNT) + (l * NGRP + grp) * 2;
  const int nscan = (grp == 0) ? N_SCAN : 0;
  for (;;) {
    int it = next_item(counter, s_item);
    if (it >= nscan + N_DIFF + N_DIL + N_HG) break;
    if (it < nscan) { rwkv_scan_item(p, it, smem); continue; }
    it -= nscan;
    if (it < N_DIFF) { diff_attn_item(p, l, it, smem); continue; }
    it -= N_DIFF;
    if (it < N_DIL) dil_attn_item(p, it, smem);
    else hgrn_item<1>(p, l, it - N_DIL, smem);
  }
}
DI void phase_stage2(const Params& p, int l, int grp, char* smem, int* s_item) {
  int* counter = (int*)(p.ws + O_CNT) + (l * NGRP + grp) * 2 + 1;
  for (;;) {
    int it = next_item(counter, s_item);
    if (it >= N_HG + N_COMB) break;
    if (it < N_HG) hgrn_item<3>(p, l, it, smem);
    else dil_combine_item(p, it - N_HG);
  }
}

DI void phase_merge(const Params& p, int l, int grp, char* smem) {
  const u16* Y = (const u16*)(p.ws + O_Y);
  const u16* YD = (const u16*)(p.ws + O_YD) + (size_t)grp * TG * 256;
  const u16* SEG = (const u16*)(p.ws + O_SEG);
  u16* MG = (u16*)(p.ws + O_MERGED);
  TileWalk<8> tw(TG / 128, 4);
  for (int mt, nt; tw.next(mt, nt);) {
    f32x4 accm[4][4]; zero_acc<4>(accm);
#pragma unroll 1
    for (int i = 0; i < 4; ++i) {
      f32x4 accp[4][4];
      zero_acc<4>(accp);
      const u16* Pi; const u16* Ai; int Ki, lda;
      if (i == 0) { Pi = (const u16*)(p.ws + O_PA) + (size_t)l * E_PA; Ki = 256; Ai = Y + (size_t)mt * 128 * YW; lda = YW; }
      else if (i == 1) { Pi = (const u16*)(p.ws + O_PB) + (size_t)l * E_PB; Ki = 512; Ai = Y + (size_t)mt * 128 * YW + 256; lda = YW; }
      else if (i == 2) { Pi = (const u16*)(p.ws + O_PC) + (size_t)l * E_PC; Ki = 256; Ai = Y + (size_t)mt * 128 * YW + 768; lda = YW; }
      else { Pi = (const u16*)(p.ws + O_PD) + (size_t)l * E_PD; Ki = 256; Ai = YD + (size_t)mt * 128 * 256; lda = 256; }
      gemm_main<4>(accp, Ai, lda, Pi + (size_t)(nt * 256) * Ki, Ki, Ki, smem);
      int mt2 = mt; asm volatile("" : "+s"(mt2));
      const u16* gb = SEG + (size_t)mt2 * 128 * NSG + GOFF + i * 1024 + nt * 256;
      epi_foreach<4>(accp, [&](int mi, int ni, int r, int c, f32x4& v) {
        const u32x2 g = *(const u32x2*)(gb + (unsigned)(r * NSG + c));
        accm[mi][ni][0] += bflo(g[0]) * v[0]; accm[mi][ni][1] += bfhi(g[0]) * v[1];
        accm[mi][ni][2] += bflo(g[1]) * v[2]; accm[mi][ni][3] += bfhi(g[1]) * v[3];
      });
    }
    u16* mgb = MG + (size_t)mt * 128 * 1024 + nt * 256;
    epi_foreach<4>(accm, [&](int mi, int ni, int r, int c, f32x4& v) { *(u32x2*)(mgb + (unsigned)(r * 1024 + c)) = pack4(v); });
  }
}

enum { EPI_RESID = 0, EPI_BF16 = 1 };
template <int KIND>
DI void phase_gemm(const u16* A, int lda, const u16* Wt, int K, int N, int rows, const float* xin, float* xout, u16* cb, int ldc, float scale, char* smem) {
  const int NT = N / 256;
  TileWalk<4> tw(rows / 256, NT);
  int mt = 0, nt = 0;
  bool have = tw.next(mt, nt);
  if (have) { __syncthreads(); gemm_issue0<8>(A + (size_t)mt * 256 * lda, lda, Wt + (size_t)nt * 256 * K, K, smem); }
  while (have) {
    f32x4 acc[8][4]; zero_acc<8>(acc);
    gemm_run<8>(acc, A + (size_t)mt * 256 * lda, lda, Wt + (size_t)nt * 256 * K, K, K, smem, true);
    int mt2 = 0, nt2 = 0;
    const bool have2 = tw.next(mt2, nt2);
    if (have2) gemm_issue0<8>(A + (size_t)mt2 * 256 * lda, lda, Wt + (size_t)nt2 * 256 * K, K, smem);
    if (KIND == EPI_RESID) {
      const float* xib = xin + (size_t)mt * 256 * 1024 + nt * 256;
      float* xob = xout + (size_t)mt * 256 * 1024 + nt * 256;
      epi_foreach<8>(acc, [&](int mi, int ni, int r, int c, f32x4& v) {
        const unsigned o = (unsigned)(r * 1024 + c);
        const f32x4 x = *(const f32x4*)(xib + o);
        *(f32x4*)(xob + o) = x + v;
      });
    } else {
      u16* cbb = cb + (size_t)mt * 256 * ldc + nt * 256;
      epi_foreach<8>(acc, [&](int mi, int ni, int r, int c, f32x4& v) { *(u32x2*)(cbb + (unsigned)(r * ldc + c)) = pack4(v * scale); });
    }
    mt = mt2; nt = nt2; have = have2;
  }
}

DI void phase_cross(const Params& p, int l, int grp, char* smem) {
  const u16* H = (const u16*)(p.ws + O_H);
  const u16* WQ = (const u16*)(p.ws + O_MQ) + (size_t)l * E_MQ;
  u16* Q = (u16*)(p.ws + O_Q);
  for (int it = blockIdx.x; it < BG * 4 * 32; it += gridDim.x) {
    const int qb = it & 31, hm = (it >> 5) & 3, bl = it >> 7;
    const size_t row0 = (size_t)bl * S + qb * 128;
    f32x4 acc[4][4]; zero_acc<4>(acc);
    gemm_main<4>(acc, H + row0 * 1024, 1024, WQ + (size_t)hm * 256 * 1024, 1024, 1024, smem);
    u16* qbase = Q + row0 * 1024 + hm * 256;
    epi_foreach<4>(acc, [&](int mi, int ni, int r, int c, f32x4& v) { *(u32x2*)(qbase + (unsigned)(r * 1024 + c)) = pack4(v * 0.0625f); });
    __threadfence_block();
    __syncthreads();
    cross_attn_item(p, l, grp, it, smem);
  }
}

DI void phase_convact(const Params& p, int l) {
  const u16* U = (const u16*)(p.ws + O_U);
  u16* ACT = (u16*)(p.ws + O_ACT);
  const float* cw = p.in[35] + (size_t)l * 3 * NFF2;
  const float* cbias = p.in[36] + (size_t)l * NFF2;
  constexpr int CH = DFF / 8;
  const int tid = otid();
#pragma unroll 1
  for (int idx = blockIdx.x * NTH + tid; idx < (TG / 8) * CH; idx += gridDim.x * NTH) {
    const int run = idx / CH, ch = idx - run * CH;
    const int tok0 = run * 8, s0 = tok0 & (S - 1);
    u32x4 ug[10], uv[10];
#pragma unroll
    for (int rr = 0; rr < 10; ++rr) {
      if (rr < 2 && s0 == 0) { ug[rr] = u32x4{0u, 0u, 0u, 0u}; uv[rr] = u32x4{0u, 0u, 0u, 0u}; }
      else {
        const u16* row = U + (size_t)(tok0 + rr - 2) * NFF2;
        ug[rr] = *(const u32x4*)(row + ch * 8); uv[rr] = *(const u32x4*)(row + DFF + ch * 8);
      }
    }
    float wg[3][8], wv[3][8], bg[8], bv[8];
#pragma unroll
    for (int jj = 0; jj < 3; ++jj)
#pragma unroll
      for (int e4 = 0; e4 < 2; ++e4) {
        const float4 a = *(const float4*)(cw + jj * NFF2 + ch * 8 + e4 * 4), b = *(const float4*)(cw + jj * NFF2 + DFF + ch * 8 + e4 * 4);
        wg[jj][e4 * 4] = a.x; wg[jj][e4 * 4 + 1] = a.y; wg[jj][e4 * 4 + 2] = a.z; wg[jj][e4 * 4 + 3] = a.w;
        wv[jj][e4 * 4] = b.x; wv[jj][e4 * 4 + 1] = b.y; wv[jj][e4 * 4 + 2] = b.z; wv[jj][e4 * 4 + 3] = b.w;
      }
#pragma unroll
    for (int e4 = 0; e4 < 2; ++e4) {
      const float4 a = *(const float4*)(cbias + ch * 8 + e4 * 4), b = *(const float4*)(cbias + DFF + ch * 8 + e4 * 4);
      bg[e4 * 4] = a.x; bg[e4 * 4 + 1] = a.y; bg[e4 * 4 + 2] = a.z; bg[e4 * 4 + 3] = a.w;
      bv[e4 * 4] = b.x; bv[e4 * 4 + 1] = b.y; bv[e4 * 4 + 2] = b.z; bv[e4 * 4 + 3] = b.w;
    }
#pragma unroll
    for (int t = 0; t < 8; ++t) {
      u32x4 o;
#pragma unroll
      for (int e2 = 0; e2 < 4; ++e2) {
        float g0 = bg[2 * e2], g1 = bg[2 * e2 + 1], v0 = bv[2 * e2], v1 = bv[2 * e2 + 1];
#pragma unroll
        for (int jj = 0; jj < 3; ++jj) {
          g0 += bflo(ug[t + jj][e2]) * wg[jj][2 * e2]; g1 += bfhi(ug[t + jj][e2]) * wg[jj][2 * e2 + 1];
          v0 += bflo(uv[t + jj][e2]) * wv[jj][2 * e2]; v1 += bfhi(uv[t + jj][e2]) * wv[jj][2 * e2 + 1];
        }
        o[e2] = pack2(silu(g0) * v0, silu(g1) * v1);
      }
      *(u32x4*)(ACT + (size_t)(tok0 + t) * DFF + ch * 8) = o;
    }
  }
}

__global__ void __launch_bounds__(NTH, 2) fwd_megakernel(Params p) {
  cg::grid_group grid = cg::this_grid();
  __shared__ __attribute__((aligned(1024))) char smem[SMEM_BYTES];
  __shared__ int s_item;
  __shared__ uint4 xb_words;
  if (threadIdx.x == 0) xb_words = make_uint4(0u, 0u, 0u, 0u);
  __syncthreads();
  const XcdBarrier xb = xcd_barrier_post((unsigned*)(p.ws + O_XBAR), (volatile LAS unsigned*)&xb_words);

  phase_prologue(p, smem);
  grid.sync();
  phase_kv_gemm(p, smem);

#pragma unroll 1
  for (int l = 0; l < NL; ++l) {
    xcd_barrier(xb);
    phase_norm((l == 0) ? p.in[0] : (const float*)p.out, p.in[3] + l * 1024, (u16*)(p.ws + O_HALL), T);
    xcd_barrier(xb);
    phase_gemm<EPI_BF16>((const u16*)(p.ws + O_HALL), 1024, (const u16*)(p.ws + O_WIN) + (size_t)l * E_WIN + (size_t)4864 * 1024, 1024, 1024, T,
                         nullptr, nullptr, (u16*)(p.ws + O_SEGD), 1024, 1.f, smem);
    xcd_barrier(xb);
    for (int it = blockIdx.x; it < T / 16; it += gridDim.x) rwkv_prep_item(p, l, it, smem);
#pragma unroll 1
    for (int grp = 0; grp < NGRP; ++grp) {
      const size_t xoff = (size_t)grp * TG * 1024;
      const float* xin = ((l == 0) ? p.in[0] : (const float*)p.out) + xoff;
      float* xout = p.out + xoff;
      u16* H = (u16*)(p.ws + O_H);
      xcd_barrier(xb);
      phase_norm(xin, p.in[3] + l * 1024, H, TG);
      xcd_barrier(xb);
      phase_gemm1(p, l, grp, smem);
      xcd_barrier(xb);
      phase_stage1(p, l, grp, smem, &s_item);
      xcd_barrier(xb);
      phase_stage2(p, l, grp, smem, &s_item);
      if (grp == 0) {
        xcd_barrier(xb);
        for (int it = blockIdx.x; it < T / 64; it += gridDim.x) rwkv_post_item(p, l, it);
      }
      xcd_barrier(xb);
      phase_merge(p, l, grp, smem);
      xcd_barrier(xb);
      phase_gemm<EPI_RESID>((const u16*)(p.ws + O_MERGED), 1024, (const u16*)(p.ws + O_MIX) + (size_t)l * E_MIX, 1024, 1024, TG, xin, xout, nullptr, 0, 1.f, smem);
      xcd_barrier(xb);
      phase_norm(xout, p.in[28] + l * 1024, H, TG);
      xcd_barrier(xb);
      phase_cross(p, l, grp, smem);
      xcd_barrier(xb);
      phase_gemm<EPI_RESID>((const u16*)(p.ws + O_O), 1024, (const u16*)(p.ws + O_MO) + (size_t)l * E_MO, 1024, 1024, TG, xout, xout, nullptr, 0, 1.f, smem);
      xcd_barrier(xb);
      phase_norm(xout, p.in[33] + l * 1024, H, TG);
      xcd_barrier(xb);
      phase_gemm<EPI_BF16>(H, 1024, (const u16*)(p.ws + O_FIN) + (size_t)l * E_FIN, 1024, NFF2, TG, nullptr, nullptr, (u16*)(p.ws + O_U), NFF2, 1.f, smem);
      xcd_barrier(xb);
      phase_convact(p, l);
      xcd_barrier(xb);
      phase_gemm<EPI_RESID>((const u16*)(p.ws + O_ACT), DFF, (const u16*)(p.ws + O_FOUT) + (size_t)l * E_FOUT, DFF, 1024, TG, xout, xout, nullptr, 0, 1.f, smem);
    }
  }
  xcd_barrier(xb);
  phase_final_norm(p.out, p.in[38]);
}

extern "C" void kernel_launch(void* const* d_in, const int* in_sizes, int n_in, void* d_out, int out_size, void* d_ws, size_t ws_size,
                              hipStream_t stream) {
  static int grid_blocks = 0;
  if (!grid_blocks) {
    int dev = 0, cus = 0, per_cu = 0;
    (void)hipGetDevice(&dev);
    (void)hipDeviceGetAttribute(&cus, hipDeviceAttributeMultiprocessorCount, dev);
    (void)hipOccupancyMaxActiveBlocksPerMultiprocessor(&per_cu, fwd_megakernel, NTH, 0);
    if (per_cu < 1) per_cu = 1;
    if (per_cu > 1) per_cu = 1;
    grid_blocks = cus * per_cu;
  }
  Params p{};
  for (int i = 0; i < 39; ++i) p.in[i] = (const float*)d_in[i];
  p.out = (float*)d_out;
  p.ws = (char*)d_ws;
  (void)hipMemsetAsync((char*)d_ws + O_XBAR, 0, XCD_BAR_WORDS * 4, stream);
  void* args[] = {&p};
  hipError_t e = hipLaunchCooperativeKernel((void*)fwd_megakernel, dim3(grid_blocks), dim3(NTH), args, 0, stream);
  if (e != hipSuccess) fprintf(stderr, "cooperative launch failed: %s (grid %d)\n", hipGetErrorString(e), grid_blocks);
}
```

```cpp
#include <hip/hip_runtime.h>
#include <hip/hip_cooperative_groups.h>
#include <stdint.h>
#include <stdio.h>
namespace cg = cooperative_groups;

#define DI __device__ __forceinline__
typedef unsigned short u16;
using bf16x8 = __attribute__((ext_vector_type(8))) short;
using s16x4  = __attribute__((ext_vector_type(4))) short;
using f32x4  = __attribute__((ext_vector_type(4))) float;
using u32x4  = __attribute__((ext_vector_type(4))) unsigned;
using u32x2  = __attribute__((ext_vector_type(2))) unsigned;

constexpr int NTH = 512;
constexpr int D = 1024, NB = 16, S = 4096, T = NB * S, NL = 2, MEM = 256;
constexpr int BG = 4, TG = BG * S, NGRP = NB / BG;
constexpr int NIN = 9984, DFF = 2816, NFF2 = 2 * DFF;
constexpr int NSG = 8960;
constexpr int GOFF = 4864;
constexpr int YW = 1024;
constexpr float EPS = 1e-5f;

constexpr size_t al(size_t x) { return (x + 255) & ~(size_t)255; }
constexpr size_t E_WIN = (size_t)NIN * D, E_PA = 1024 * 256, E_PB = 1024 * 512, E_PC = 1024 * 256, E_PD = 1024 * 256;
constexpr size_t E_MIX = 1024 * 1024, E_MQ = 1024 * 1024, E_MKV = 2048 * 1024, E_MO = 1024 * 1024;
constexpr size_t E_FIN = (size_t)NFF2 * D, E_FOUT = (size_t)D * DFF;
constexpr size_t O_WIN = 0;
constexpr size_t O_PA = O_WIN + al(NL * E_WIN * 2);
constexpr size_t O_PB = O_PA + al(NL * E_PA * 2);
constexpr size_t O_PC = O_PB + al(NL * E_PB * 2);
constexpr size_t O_PD = O_PC + al(NL * E_PC * 2);
constexpr size_t O_MIX = O_PD + al(NL * E_PD * 2);
constexpr size_t O_MQ = O_MIX + al(NL * E_MIX * 2);
constexpr size_t O_MKV = O_MQ + al(NL * E_MQ * 2);
constexpr size_t O_MO = O_MKV + al(NL * E_MKV * 2);
constexpr size_t O_FIN = O_MO + al(NL * E_MO * 2);
constexpr size_t O_FOUT = O_FIN + al(NL * E_FIN * 2);
constexpr size_t O_ROPE = O_FOUT + al(NL * E_FOUT * 2);
constexpr size_t O_MEMN = O_ROPE + al((size_t)T * 16 * 4);
constexpr size_t O_KV = O_MEMN + al((size_t)NL * 4096 * 1024 * 2);
constexpr size_t O_VFIRST = O_KV + al((size_t)NL * 4096 * 2048 * 2);
constexpr size_t O_SCAL = O_VFIRST + al((size_t)T * 256 * 2);
constexpr size_t O_BAR = O_SCAL + 128;
constexpr size_t O_CNT = O_SCAL + 256;
constexpr size_t SZ_RW = al((size_t)T * 256 * 2);
constexpr size_t O_XBAR = O_CNT + 2048;
constexpr size_t O_RWR = O_XBAR + 16384;
constexpr size_t O_RWK = O_RWR + SZ_RW, O_RWV = O_RWK + SZ_RW, O_RWKK = O_RWV + SZ_RW, O_RWKKA = O_RWKK + SZ_RW, O_RWG = O_RWKKA + SZ_RW;
constexpr size_t O_YD = O_RWG + SZ_RW;
constexpr size_t O_RWW = O_YD + SZ_RW;
constexpr size_t O_RWY = O_RWW + al((size_t)T * 256 * 4);
constexpr size_t O_RWRK = O_RWY + al((size_t)T * 256 * 4);
constexpr size_t O_TR = O_RWRK + al((size_t)T * 4 * 4);
constexpr size_t O_H = O_TR;
constexpr size_t O_SEG = O_H + al((size_t)TG * 1024 * 2);
constexpr size_t O_HGS = O_SEG + al((size_t)TG * NSG * 2);
constexpr size_t O_HGF = O_HGS + al((size_t)BG * 4 * 32 * 4096 * 4);
constexpr size_t O_OG = O_HGF + al((size_t)BG * 4 * 32 * 64 * 4);
constexpr size_t O_LSE = O_OG + al((size_t)TG * 768 * 2);
constexpr size_t O_Y = O_LSE + al((size_t)TG * 12 * 4);
constexpr size_t O_MERGED = O_Y + al((size_t)TG * YW * 2);
constexpr size_t WS_TOTAL = O_MERGED + al((size_t)TG * 1024 * 2);
constexpr size_t O_HALL = O_TR;
constexpr size_t O_SEGD = O_TR + al((size_t)T * 1024 * 2);
constexpr size_t O_Q = O_SEG;
constexpr size_t O_O = O_SEG + al((size_t)TG * 1024 * 2);
constexpr size_t O_U = O_SEG;
constexpr size_t O_ACT = O_SEG + al((size_t)TG * NFF2 * 2);
static_assert(O_ACT + (size_t)TG * DFF * 2 <= O_HGS, "U + ACT fit in SEG");
static_assert(O_SEGD + (size_t)T * 1024 * 2 <= WS_TOTAL, "front buffers fit in the transient region");
static_assert(WS_TOTAL <= ((size_t)1 << 30), "workspace fits 1 GiB");

constexpr int SMEM_BYTES = 163840;

struct Params {
  const float* in[39];
  float* out;
  char* ws;
};

DI int otid() { int t = threadIdx.x; asm volatile("" : "+v"(t)); return t; }
typedef __bf16 bf16x2_t __attribute__((ext_vector_type(2)));
typedef float f32x2_t __attribute__((ext_vector_type(2)));
DI unsigned pack2(float a, float b) { f32x2_t f = {a, b}; bf16x2_t r = __builtin_convertvector(f, bf16x2_t); return __builtin_bit_cast(unsigned, r); }
DI u16 f2bf(float x) { return (u16)(pack2(x, 0.f) & 0xffffu); }
DI float bf2f(u16 b) { return __uint_as_float(((unsigned)b) << 16); }
DI float bflo(unsigned u) { return __uint_as_float(u << 16); }
DI float bfhi(unsigned u) { return __uint_as_float(u & 0xffff0000u); }
DI float sigm(float x) { return __builtin_amdgcn_rcpf(1.f + __expf(-x)); }
DI float silu(float x) { return x * __builtin_amdgcn_rcpf(1.f + __expf(-x)); }
DI float wave_sum_slow(float v) {
#pragma unroll
  for (int o = 32; o > 0; o >>= 1) v += __shfl_xor(v, o);
  return v;
}
DI f32x4 mfma16(bf16x8 a, bf16x8 b, f32x4 c) { return __builtin_amdgcn_mfma_f32_16x16x32_bf16(a, b, c, 0, 0, 0); }
template <int CTRL> DI float dpp_mov(float x) {
  return __int_as_float(__builtin_amdgcn_update_dpp(0, __float_as_int(x), CTRL, 0xF, 0xF, true));
}
DI float red16(float x) {
  x += dpp_mov<0xB1>(x);
  x += dpp_mov<0x4E>(x);
  x += dpp_mov<0x141>(x);
  x += dpp_mov<0x140>(x);
  return x;
}
DI float wave_sum(float v) { v = red16(v); v += __shfl_xor(v, 16); v += __shfl_xor(v, 32); return v; }
DI void red16_2(float& a, float& b) {
  a += dpp_mov<0xB1>(a);  b += dpp_mov<0xB1>(b);
  a += dpp_mov<0x4E>(a);  b += dpp_mov<0x4E>(b);
  a += dpp_mov<0x141>(a); b += dpp_mov<0x141>(b);
  a += dpp_mov<0x140>(a); b += dpp_mov<0x140>(b);
}

#define XB_TMO      128
#define XB_XCNT(j)  (256  + 64 * (j))
#define XB_XSUB(j)  (1280 + 64 * (j))
#define XB_XGEN(j)  (2304 + 64 * (j))
#define XB_TOP      3328
#define XB_TOPGEN   3392
#define XCD_BAR_WORDS 3456
#define XB_SPIN_CAP (1u << 18)
#define LAS __attribute__((address_space(3)))
DI unsigned xb_ld(unsigned* p)              { return __hip_atomic_load(p, __ATOMIC_RELAXED, __HIP_MEMORY_SCOPE_AGENT); }
DI unsigned xb_add(unsigned* p, unsigned v) { return __hip_atomic_fetch_add(p, v, __ATOMIC_RELAXED, __HIP_MEMORY_SCOPE_AGENT); }
DI unsigned xb_xcc_id() { return (unsigned)__builtin_amdgcn_s_getreg((3 << 11) | 20) & 0xFu; }
#define XB_SPIN(cond, bar) do { unsigned _sp = 0; while (cond) { __builtin_amdgcn_s_sleep(1); \
    if ((++_sp & 255u) == 0u) { if (xb_ld(&(bar)[XB_TMO])) break; if (_sp > XB_SPIN_CAP) { atomicAdd(&(bar)[XB_TMO], 1u); break; } } } } while (0)
struct XcdBarrier { unsigned* bar; unsigned x; unsigned nloc, nx; };
DI XcdBarrier xcd_barrier_post(unsigned* bar) {
  XcdBarrier b; b.bar = bar; b.x = xb_xcc_id(); b.nloc = 0u; b.nx = 0u;
  if (threadIdx.x == 0) (void)xb_add(&bar[XB_XCNT(b.x)], 1u);
  return b;
}
DI void xcd_barrier_complete(unsigned* bar, unsigned x, unsigned& nloc, unsigned& nx) {
  const unsigned G = gridDim.x * gridDim.y * gridDim.z;
  unsigned sum, cnt, mine, sp = 0u;
  for (;;) {
    sum = 0u; cnt = 0u; mine = 0u;
#pragma unroll
    for (unsigned j = 0; j < 16; ++j) { const unsigned c = xb_ld(&bar[XB_XCNT(j)]); sum += c; cnt += (c > 0u) ? 1u : 0u; mine = (j == x) ? c : mine; }
    if (sum == G) break;
    __builtin_amdgcn_s_sleep(1);
    if ((++sp & 255u) == 0u) { if (xb_ld(&bar[XB_TMO])) break; if (sp > XB_SPIN_CAP) { atomicAdd(&bar[XB_TMO], 1u); break; } }
  }
  nloc = mine > 0u ? mine : 1u; nx = cnt > 0u ? cnt : 1u;
}
DI void xcd_barrier(XcdBarrier& b) {
  asm volatile("s_waitcnt vmcnt(0)" ::: "memory");
  __syncthreads();
  if (threadIdx.x == 0) {
    unsigned* bar = b.bar;
    __builtin_amdgcn_s_waitcnt(0);
    unsigned nloc = b.nloc, nx = b.nx;
    if (nloc == 0u) { xcd_barrier_complete(bar, b.x, nloc, nx); b.nloc = nloc; b.nx = nx; }
    const unsigned old = xb_add(&bar[XB_XSUB(b.x)], 1u);
    const unsigned gen = old / nloc;
    if (old + 1u == (gen + 1u) * nloc) {
      __builtin_amdgcn_fence(__ATOMIC_RELEASE, "agent");
      asm volatile("s_waitcnt vmcnt(0)" ::: "memory");
      const unsigned og = xb_add(&bar[XB_TOP], 1u);
      const unsigned tg = og / nx;
      if (og + 1u == (tg + 1u) * nx) xb_add(&bar[XB_TOPGEN], 1u);
      else XB_SPIN(xb_ld(&bar[XB_TOPGEN]) == tg, bar);
      __builtin_amdgcn_fence(__ATOMIC_ACQUIRE, "agent");
      xb_add(&bar[XB_XGEN(b.x)], 1u);
      asm volatile("s_waitcnt vmcnt(0)" ::: "memory");
    } else {
      XB_SPIN(xb_ld(&bar[XB_XGEN(b.x)]) == gen, bar);
      __builtin_amdgcn_fence(__ATOMIC_ACQUIRE, "agent");
      asm volatile("s_waitcnt vmcnt(0)" ::: "memory");
    }
  }
  __syncthreads();
}

DI int lds_byte2(int r, int c) {
  const int st = (r >> 4) * 2 + (c >> 5), ob = (r & 15) * 64 + (c & 31) * 2;
  return st * 1024 + (ob ^ (((ob >> 9) & 1) << 5));
}
typedef __attribute__((address_space(3))) unsigned* lds_u32_ptr;
template <int MI> struct GemmStage {
  static constexpr int AROWS = MI * 32, LA = AROWS / 128;
  static constexpr int A_BYTES = AROWS * 64, STAGE = A_BYTES + 256 * 64;
  static constexpr int LPS = LA + 2;
  unsigned aoff[LA], boff[2]; int wid;
  DI void init(long lda, long ldb) {
    const int tid = otid(), lane = tid & 63;
    wid = tid >> 6;
    const int sb = lane * 16, swz = sb ^ (((sb >> 9) & 1) << 5);
    const int rr = swz >> 6, cc = (swz & 63) >> 1;
#pragma unroll
    for (int i = 0; i < LA; ++i) aoff[i] = (unsigned)(((wid + 8 * i) * 16 + rr) * (int)lda + cc);
#pragma unroll
    for (int i = 0; i < 2; ++i) boff[i] = (unsigned)(((wid + 8 * i) * 16 + rr) * (int)ldb + cc);
  }
  DI void issue(const u16* __restrict__ A, const u16* __restrict__ Bt, int k0, char* buf) const {
#pragma unroll
    for (int i = 0; i < LA; ++i) __builtin_amdgcn_global_load_lds((const unsigned*)(A + aoff[i] + k0), (lds_u32_ptr)(buf + (wid + 8 * i) * 1024), 16, 0, 0);
#pragma unroll
    for (int i = 0; i < 2; ++i) __builtin_amdgcn_global_load_lds((const unsigned*)(Bt + boff[i] + k0), (lds_u32_ptr)(buf + A_BYTES + (wid + 8 * i) * 1024), 16, 0, 0);
  }
};
constexpr int NSTG = 5;
DI int ring_next(int b) { return (b + 1 == NSTG) ? 0 : b + 1; }
DI int ring_add(int b, int s) { int r = b + s; return (r >= NSTG) ? r - NSTG : r; }
template <int MI>
DI void gemm_issue0(const u16* __restrict__ A, long lda, const u16* __restrict__ Bt, long ldb, char* smem, int rb) {
  GemmStage<MI> gs; gs.init(lda, ldb);
#pragma unroll
  for (int s = 0; s < 4; ++s) gs.issue(A, Bt, s * 32, smem + ring_add(rb, s) * GemmStage<MI>::STAGE);
}
template <int MI>
DI void gemm_run(f32x4 (&acc)[MI][4], const u16* __restrict__ A, long lda, const u16* __restrict__ Bt, long ldb, int K, char* smem, bool preissued, int& rb) {
  constexpr int A_BYTES = GemmStage<MI>::A_BYTES, STAGE = GemmStage<MI>::STAGE, LPS = GemmStage<MI>::LPS;
  GemmStage<MI> gs; gs.init(lda, ldb);
  const int tid = otid(), lane = tid & 63, wid = tid >> 6, wr = wid >> 2, wc = wid & 3;
  const int li = lane & 15, lg = lane >> 4;
  const int fo = (li * 64 + lg * 16) ^ ((li >> 3) << 5);
  const int nk = K >> 5;
  if (!preissued) {
    __syncthreads();
#pragma unroll
    for (int s = 0; s < 4; ++s) gs.issue(A, Bt, s * 32, smem + ring_add(rb, s) * STAGE);
  }
  int cb = rb;
  for (int kk = 0; kk < nk; ++kk) {
    const int newer = nk - 1 - kk;
    if (newer == 0) asm volatile("s_waitcnt vmcnt(0)" ::: "memory");
    else if (newer == 1) asm volatile("s_waitcnt vmcnt(%0)" :: "n"(LPS) : "memory");
    else if (newer == 2) asm volatile("s_waitcnt vmcnt(%0)" :: "n"(2 * LPS) : "memory");
    else asm volatile("s_waitcnt vmcnt(%0)" :: "n"(3 * LPS) : "memory");
    asm volatile("s_waitcnt lgkmcnt(0)" ::: "memory");
    __builtin_amdgcn_s_barrier();
    asm volatile("" ::: "memory");
    char* cur = smem + cb * STAGE;
    {
      constexpr int NP = MI / 2;
      bf16x8 bq[4], ap[2][2];
      const char* aB = cur + (wr * MI) * 1024 + fo;
      const char* bB = cur + A_BYTES + (wc * 4) * 1024 + fo;
#pragma unroll
      for (int ni = 0; ni < 4; ++ni) bq[ni] = *(const bf16x8*)(bB + ni * 1024);
#pragma unroll
      for (int i = 0; i < 2; ++i) ap[0][i] = *(const bf16x8*)(aB + i * 1024);
      __builtin_amdgcn_sched_barrier(0);
      if (kk + 4 < nk) gs.issue(A, Bt, (kk + 4) << 5, smem + ring_add(cb, 4) * STAGE);
      __builtin_amdgcn_sched_barrier(0);
#pragma unroll
      for (int pp = 0; pp < NP; ++pp) {
        if (pp + 1 < NP) {
#pragma unroll
          for (int i = 0; i < 2; ++i) ap[(pp + 1) & 1][i] = *(const bf16x8*)(aB + (2 * (pp + 1) + i) * 1024);
        }
#pragma unroll
        for (int i = 0; i < 2; ++i)
#pragma unroll
          for (int ni = 0; ni < 4; ++ni) acc[2 * pp + i][ni] = mfma16(bq[ni], ap[pp & 1][i], acc[2 * pp + i][ni]);
        __builtin_amdgcn_sched_group_barrier(0x008, 1, 0);
        if (pp + 1 < NP) __builtin_amdgcn_sched_group_barrier(0x100, 2, 0);
        __builtin_amdgcn_sched_group_barrier(0x008, 7, 0);
        __builtin_amdgcn_sched_barrier(0);
      }
    }
    cb = ring_next(cb);
  }
  rb = cb;
}
template <int MI>
DI void gemm_main(f32x4 (&acc)[MI][4], const u16* __restrict__ A, long lda, const u16* __restrict__ Bt, long ldb, int K, char* smem) {
  int rb = 0;
  gemm_run<MI>(acc, A, lda, Bt, ldb, K, smem, false, rb);
}
template <int BH> struct TileWalk {
  int x, j, per, r, NT, total; bool plain;
  DI TileWalk(int MT, int NT_) : NT(NT_), total(MT * NT_) {
    plain = (gridDim.x & 7) != 0 || (MT % BH) != 0;
    x = blockIdx.x & 7; j = blockIdx.x >> 3; per = gridDim.x >> 3; r = 0;
  }
  DI bool next(int& mt, int& nt) {
    int tp;
    if (plain) tp = blockIdx.x + r * gridDim.x; else tp = (r * 8 + x) * per + j;
    ++r;
    if (tp >= total) return false;
    if (plain) { mt = tp / NT; nt = tp % NT; }
    else { const int band = tp / (BH * NT), idx = tp % (BH * NT); mt = band * BH + (idx % BH); nt = idx / BH; }
    return true;
  }
};
template <int MI> DI void zero_acc(f32x4 (&acc)[MI][4]) {
#pragma unroll
  for (int mi = 0; mi < MI; ++mi)
#pragma unroll
    for (int ni = 0; ni < 4; ++ni) acc[mi][ni] = f32x4{0.f, 0.f, 0.f, 0.f};
}
template <int MI, typename F> DI void epi_foreach(f32x4 (&acc)[MI][4], F&& f) {
  const int tid_ = otid(), lane_ = tid_ & 63, wid_ = tid_ >> 6, wr_ = wid_ >> 2, wc_ = wid_ & 3, li_ = lane_ & 15, lg_ = lane_ >> 4;
#pragma unroll
  for (int mi = 0; mi < MI; ++mi) {
    asm volatile("" ::: "memory");
#pragma unroll
    for (int ni = 0; ni < 4; ++ni) f(mi, ni, wr_ * (MI * 16) + mi * 16 + li_, wc_ * 64 + ni * 16 + lg_ * 4, acc[mi][ni]);
  }
}
DI u32x2 pack4(f32x4 v) { u32x2 o; o[0] = pack2(v[0], v[1]); o[1] = pack2(v[2], v[3]); return o; }

struct TrJob { const float* src; u16* dst; int K, N; };
DI TrJob tr_job(const Params& p, int j) {
  const int l = j / 11, w = j % 11;
  TrJob r;
  switch (w) {
    case 0: r = {p.in[4] + (size_t)l * E_WIN, (u16*)(p.ws + O_WIN) + (size_t)l * E_WIN, 1024, NIN}; break;
    case 1: r = {p.in[23] + (size_t)l * E_PA, (u16*)(p.ws + O_PA) + (size_t)l * E_PA, 256, 1024}; break;
    case 2: r = {p.in[24] + (size_t)l * E_PB, (u16*)(p.ws + O_PB) + (size_t)l * E_PB, 512, 1024}; break;
    case 3: r = {p.in[25] + (size_t)l * E_PC, (u16*)(p.ws + O_PC) + (size_t)l * E_PC, 256, 1024}; break;
    case 4: r = {p.in[26] + (size_t)l * E_PD, (u16*)(p.ws + O_PD) + (size_t)l * E_PD, 256, 1024}; break;
    case 5: r = {p.in[27] + (size_t)l * E_MIX, (u16*)(p.ws + O_MIX) + (size_t)l * E_MIX, 1024, 1024}; break;
    case 6: r = {p.in[30] + (size_t)l * E_MQ, (u16*)(p.ws + O_MQ) + (size_t)l * E_MQ, 1024, 1024}; break;
    case 7: r = {p.in[31] + (size_t)l * E_MKV, (u16*)(p.ws + O_MKV) + (size_t)l * E_MKV, 1024, 2048}; break;
    case 8: r = {p.in[32] + (size_t)l * E_MO, (u16*)(p.ws + O_MO) + (size_t)l * E_MO, 1024, 1024}; break;
    case 9: r = {p.in[34] + (size_t)l * E_FIN, (u16*)(p.ws + O_FIN) + (size_t)l * E_FIN, 1024, NFF2}; break;
    default: r = {p.in[37] + (size_t)l * E_FOUT, (u16*)(p.ws + O_FOUT) + (size_t)l * E_FOUT, DFF, 1024}; break;
  }
  return r;
}
DI int tr_tiles(int w) {
  switch (w) {
    case 0: return 16 * 156; case 1: return 4 * 16; case 2: return 8 * 16; case 3: return 4 * 16; case 4: return 4 * 16;
    case 5: return 256; case 6: return 256; case 7: return 16 * 32; case 8: return 256; case 9: return 16 * 88; default: return 44 * 16;
  }
}
constexpr int TR_TILES_L = 16 * 156 + 64 + 128 + 64 + 64 + 256 * 3 + 512 + 16 * 88 + 44 * 16;

DI void transpose_tile(const TrJob& jb, int tile, char* smem) {
  float* ts = (float*)smem;
  const int ntn = jb.N >> 6;
  const int k0 = (tile / ntn) << 6, n0 = (tile % ntn) << 6;
  const int tid = otid(), a = tid >> 6, b = tid & 63;
  __syncthreads();
#pragma unroll
  for (int i = 0; i < 8; ++i) { int k = i * 8 + a; ts[k * 65 + b] = jb.src[(size_t)(k0 + k) * jb.N + n0 + b]; }
  __syncthreads();
#pragma unroll
  for (int i = 0; i < 8; ++i) { int n = i * 8 + a; jb.dst[(size_t)(n0 + n) * jb.K + k0 + b] = f2bf(ts[b * 65 + n]); }
}

DI void sincos_acc(float ang, float& c, float& s) {
  double a = (double)ang;
  const double TWO_PI = 6.283185307179586476925;
  double n = rint(a / TWO_PI);
  double r = a - n * TWO_PI;
  double r2 = r * r;
  double sn = 0.0, cs = 0.0;
  double ts = r, tc = 1.0;
#pragma unroll
  for (int k = 0; k < 13; ++k) {
    cs += tc; sn += ts;
    tc = -tc * r2 / (double)((2 * k + 1) * (2 * k + 2));
    ts = -ts * r2 / (double)((2 * k + 2) * (2 * k + 3));
  }
  c = (float)cs; s = (float)sn;
}

DI void norm_row_bf16(const float* __restrict__ xr, const float* __restrict__ g, u16* __restrict__ outr, int lane) {
  float4 v[4]; float ss = 0.f;
#pragma unroll
  for (int i = 0; i < 4; ++i) { v[i] = ((const float4*)xr)[i * 64 + lane]; ss += v[i].x * v[i].x + v[i].y * v[i].y + v[i].z * v[i].z + v[i].w * v[i].w; }
  ss = wave_sum(ss);
  const float rstd = 1.0f / sqrtf(ss * (1.f / 1024.f) + EPS);
#pragma unroll
  for (int i = 0; i < 4; ++i) {
    float4 gg = ((const float4*)g)[i * 64 + lane];
    u32x2 o; o[0] = pack2(v[i].x * rstd * gg.x, v[i].y * rstd * gg.y); o[1] = pack2(v[i].z * rstd * gg.z, v[i].w * rstd * gg.w);
    *(u32x2*)(outr + (i * 64 + lane) * 4) = o;
  }
}

DI void phase_prologue(const Params& p, char* smem) {
  const int tid = otid(), lane = tid & 63, wave = tid >> 6;
  if (blockIdx.x == 0) {
    ((int*)(p.ws + O_CNT))[tid] = 0;
    if (tid < NL) {
      const float* lv = p.in[5] + tid * 256;
      float s1 = 0.f, s2 = 0.f;
      for (int i = 0; i < 64; ++i) { s1 += lv[i] * lv[64 + i]; s2 += lv[128 + i] * lv[192 + i]; }
      const float lam_init = (tid == 0) ? 0.2f : 0.355509067591f;
      ((float*)(p.ws + O_SCAL))[tid] = expf(s1) - expf(s2) + lam_init;
    }
  }
  for (int t = blockIdx.x; t < NL * TR_TILES_L; t += gridDim.x) {
    int l = t / TR_TILES_L, r = t % TR_TILES_L, w = 0;
    for (; w < 10; ++w) { int n = tr_tiles(w); if (r < n) break; r -= n; }
    TrJob jb = tr_job(p, l * 11 + w);
    transpose_tile(jb, r, smem);
  }
  {
    const int* pos = (const int*)p.in[2];
    float* tab = (float*)(p.ws + O_ROPE);
    for (int idx = blockIdx.x * NTH + tid; idx < T * 8; idx += gridDim.x * NTH) {
      const int t = idx >> 3, i = idx & 7;
      float invf;
      switch (i) {
        case 0: invf = 1.0f; break; case 1: invf = 0.1939227432012558f; break; case 2: invf = 0.03760603070259094f; break;
        case 3: invf = 0.007292664609849453f; break; case 4: invf = 0.0014142135623842478f; break; case 5: invf = 0.00027424818836152554f; break;
        case 6: invf = 5.3182957344688475e-05f; break; default: invf = 1.0313385246263351e-05f; break;
      }
      const float ang = (float)pos[t] * invf;
      float c, s; sincos_acc(ang, c, s);
      tab[t * 16 + i] = c; tab[t * 16 + 8 + i] = s;
    }
  }
  for (int row = blockIdx.x * 8 + wave; row < NL * 4096; row += gridDim.x * 8) {
    const int l = row >> 12, r = row & 4095;
    norm_row_bf16(p.in[1] + (size_t)r * 1024, p.in[29] + l * 1024, (u16*)(p.ws + O_MEMN) + (size_t)row * 1024, lane);
  }
}

DI void phase_kv_gemm(const Params& p, char* smem) {
  for (int t = blockIdx.x; t < NL * 16 * 8; t += gridDim.x) {
    const int l = t >> 7, r = t & 127, mt = r >> 3, nt = r & 7;
    f32x4 acc[8][4]; zero_acc<8>(acc);
    const u16* A = (const u16*)(p.ws + O_MEMN) + (size_t)l * 4096 * 1024 + (size_t)mt * 256 * 1024;
    const u16* B = (const u16*)(p.ws + O_MKV) + (size_t)l * E_MKV + (size_t)nt * 256 * 1024;
    gemm_main<8>(acc, A, 1024, B, 1024, 1024, smem);
    u16* C = (u16*)(p.ws + O_KV) + (size_t)l * 4096 * 2048 + (size_t)mt * 256 * 2048 + nt * 256;
    epi_foreach<8>(acc, [&](int mi, int ni, int r, int c, f32x4& v) { *(u32x2*)(C + (unsigned)(r * 2048 + c)) = pack4(v); });
  }
}

DI void phase_norm(const float* __restrict__ X, const float* __restrict__ g, u16* __restrict__ H, int rows) {
  const int tid = otid(), lane = tid & 63, wave = tid >> 6;
  for (int row = blockIdx.x * 8 + wave; row < rows; row += gridDim.x * 8)
    norm_row_bf16(X + (size_t)row * 1024, g, H + (size_t)row * 1024, lane);
}

DI void phase_final_norm(float* X, const float* __restrict__ g) {
  const int tid = otid(), lane = tid & 63, wave = tid >> 6;
  for (int row = blockIdx.x * 8 + wave; row < T; row += gridDim.x * 8) {
    float* xr = X + (size_t)row * 1024;
    float4 v[4]; float ss = 0.f;
#pragma unroll
    for (int i = 0; i < 4; ++i) { v[i] = ((const float4*)xr)[i * 64 + lane]; ss += v[i].x * v[i].x + v[i].y * v[i].y + v[i].z * v[i].z + v[i].w * v[i].w; }
    ss = wave_sum(ss);
    const float rstd = 1.0f / sqrtf(ss * (1.f / 1024.f) + EPS);
#pragma unroll
    for (int i = 0; i < 4; ++i) {
      float4 gg = ((const float4*)g)[i * 64 + lane];
      float4 o; o.x = v[i].x * rstd * gg.x; o.y = v[i].y * rstd * gg.y; o.z = v[i].z * rstd * gg.z; o.w = v[i].w * rstd * gg.w;
      ((float4*)xr)[i * 64 + lane] = o;
    }
  }
}

DI void phase_gemm1(const Params& p, int l, int grp, char* smem) {
  const u16* H = (const u16*)(p.ws + O_H);
  const u16* W = (const u16*)(p.ws + O_WIN) + (size_t)l * E_WIN;
  u16* SEG = (u16*)(p.ws + O_SEG);
  const float* tab = (const float*)(p.ws + O_ROPE) + (size_t)grp * TG * 16;
  constexpr int NT = NSG / 256;
  TileWalk<4> tw(TG / 256, NT);
  int mt = 0, nt = 0;
  bool have = tw.next(mt, nt);
  int rb = 0;
  if (have) { __syncthreads(); gemm_issue0<8>(H + (size_t)mt * 256 * 1024, 1024, W + (size_t)((nt < 19) ? nt * 256 : (nt + 4) * 256) * 1024, 1024, smem, rb); }
  while (have) {
    const int wrow = (nt < 19) ? nt * 256 : (nt + 4) * 256;
    f32x4 acc[8][4]; zero_acc<8>(acc);
    gemm_run<8>(acc, H + (size_t)mt * 256 * 1024, 1024, W + (size_t)wrow * 1024, 1024, 1024, smem, true, rb);
    int mt2 = 0, nt2 = 0;
    const bool have2 = tw.next(mt2, nt2);
    if (have2) gemm_issue0<8>(H + (size_t)mt2 * 256 * 1024, 1024, W + (size_t)((nt2 < 19) ? nt2 * 256 : (nt2 + 4) * 256) * 1024, 1024, smem, rb);
    u16* segb = SEG + (size_t)mt * 256 * NSG + nt * 256;
    const float* tabb = tab + (size_t)mt * 256 * 16;
    {
      const int tid_ = otid(), lane_ = tid_ & 63, wid_ = __builtin_amdgcn_readfirstlane(tid_ >> 6), wr_ = wid_ >> 2, wc_ = wid_ & 3;
      const int li_ = lane_ & 15, lg_ = lane_ >> 4;
#pragma unroll
      for (int ni = 0; ni < 4; ++ni) {
        const int cb = nt * 256 + wc_ * 64 + ni * 16;
        bool rot = false; float scale = 1.f;
        if (cb < 2304) { const int jj = (cb % 768) >> 8; rot = (jj < 2); if (jj == 0) scale = 0.125f; }
        else if (cb < 3840) { const int c2 = cb - 2304; rot = (c2 < 1024); if (c2 < 512) scale = 0.125f; }
        rot = rot && (ni == 0);
        const bool gate = (cb >= GOFF);
        const int c = wc_ * 64 + ni * 16 + lg_ * 4;
#pragma unroll
        for (int mi = 0; mi < 8; ++mi) {
          if ((mi & 1) == 0) asm volatile("" ::: "memory");
          const int r = wr_ * 128 + mi * 16 + li_;
          f32x4 o = acc[mi][ni];
          if (rot) {
            f32x4 other;
            other[0] = __shfl_xor(o[0], 32); other[1] = __shfl_xor(o[1], 32); other[2] = __shfl_xor(o[2], 32); other[3] = __shfl_xor(o[3], 32);
            const f32x4 cs = *(const f32x4*)(tabb + (unsigned)(r * 16 + (lg_ & 1) * 4));
            const f32x4 sn = *(const f32x4*)(tabb + (unsigned)(r * 16 + 8 + (lg_ & 1) * 4));
            o = (lg_ < 2) ? (o * cs - other * sn) : (o * cs + other * sn);
          }
          if (gate) { o[0] = sigm(o[0]); o[1] = sigm(o[1]); o[2] = sigm(o[2]); o[3] = sigm(o[3]); }
          *(u32x2*)(segb + (unsigned)(r * NSG + c)) = pack4(o * scale);
        }
      }
    }
    mt = mt2; nt = nt2; have = have2;
  }
}

template <int DK> struct TileRegs {
  static constexpr int CPR = DK / 8, NCH = (64 * CPR) / NTH;
  u32x4 r[NCH];
  DI void load(const u16* __restrict__ src, long row_stride, int tid) {
#pragma unroll
    for (int i = 0; i < NCH; ++i) { const int c = tid + NTH * i, row = c / CPR, kc = c % CPR; r[i] = *(const u32x4*)(src + (long)row * row_stride + kc * 8); }
  }
  DI void store(char* dst, int pad, int tid) const {
    const int rs = DK * 2 + pad;
#pragma unroll
    for (int i = 0; i < NCH; ++i) { const int c = tid + NTH * i, row = c / CPR, kc = c % CPR; *(u32x4*)(dst + row * rs + kc * 16) = r[i]; }
  }
};
template <int DK>
DI void attn_scores(f32x4 (&Sa)[4], const bf16x8 (&Qf)[DK / 32], const char* Ks, int li, int lg) {
  constexpr int RS = DK * 2 + 16, NKS = DK / 32;
  const char* kb = Ks + li * RS + lg * 16;
  if (DK == 64) {
    bf16x8 kf[4][NKS];
#pragma unroll
    for (int ksub = 0; ksub < 4; ++ksub)
#pragma unroll
      for (int ks = 0; ks < NKS; ++ks) kf[ksub][ks] = *(const bf16x8*)(kb + ksub * 16 * RS + ks * 64);
#pragma unroll
    for (int ks = 0; ks < NKS; ++ks)
#pragma unroll
      for (int ksub = 0; ksub < 4; ++ksub) Sa[ksub] = mfma16(kf[ksub][ks], Qf[ks], Sa[ksub]);
    __builtin_amdgcn_sched_group_barrier(0x100, 4 * NKS, 0);
    __builtin_amdgcn_sched_group_barrier(0x008, 4 * NKS, 0);
    __builtin_amdgcn_sched_barrier(0);
  } else {
    constexpr int HK = NKS / 2;
    bf16x8 kf[2][HK];
#pragma unroll
    for (int ks = 0; ks < HK; ++ks) kf[0][ks] = *(const bf16x8*)(kb + ks * 64);
#pragma unroll
    for (int g = 0; g < 8; ++g) {
      const int ksub = g >> 1, hf = g & 1;
      if (g + 1 < 8) {
        const int ks2 = (g + 1) >> 1, hf2 = (g + 1) & 1;
#pragma unroll
        for (int ks = 0; ks < HK; ++ks) kf[(g + 1) & 1][ks] = *(const bf16x8*)(kb + ks2 * 16 * RS + (hf2 * HK + ks) * 64);
      }
#pragma unroll
      for (int ks = 0; ks < HK; ++ks) Sa[ksub] = mfma16(kf[g & 1][ks], Qf[hf * HK + ks], Sa[ksub]);
      __builtin_amdgcn_sched_group_barrier(0x008, 1, 0);
      if (g + 1 < 8) __builtin_amdgcn_sched_group_barrier(0x100, HK, 0);
      __builtin_amdgcn_sched_group_barrier(0x008, HK - 1, 0);
      __builtin_amdgcn_sched_barrier(0);
    }
  }
}
DI void softmax_step(f32x4 (&Sa)[4], float& m, float& l, float& alpha, bf16x8 (&P)[2]) {
  float mx = -INFINITY;
#pragma unroll
  for (int ksub = 0; ksub < 4; ++ksub)
#pragma unroll
    for (int j = 0; j < 4; ++j) mx = fmaxf(mx, Sa[ksub][j]);
  mx = fmaxf(mx, __shfl_xor(mx, 16));
  mx = fmaxf(mx, __shfl_xor(mx, 32));
  const float mn = fmaxf(m, mx);
  const float ms = (mn == -INFINITY) ? 0.f : mn;
  alpha = __expf(m - ms);
  float ps = 0.f;
#pragma unroll
  for (int ksub = 0; ksub < 4; ++ksub)
#pragma unroll
    for (int j = 0; j < 4; ++j) { const float e = __expf(Sa[ksub][j] - ms); ps += e; Sa[ksub][j] = e; }
  l = l * alpha + ps;
  m = mn;
#pragma unroll
  for (int kp = 0; kp < 2; ++kp) {
    u32x4 u;
    u[0] = pack2(Sa[2 * kp][0], Sa[2 * kp][1]); u[1] = pack2(Sa[2 * kp][2], Sa[2 * kp][3]);
    u[2] = pack2(Sa[2 * kp + 1][0], Sa[2 * kp + 1][1]); u[3] = pack2(Sa[2 * kp + 1][2], Sa[2 * kp + 1][3]);
    P[kp] = __builtin_bit_cast(bf16x8, u);
  }
}
typedef __attribute__((address_space(3))) s16x4* lds_s16x4_ptr;
template <int DV, int NMAP>
DI void attn_pv_pipe(f32x4 (&O1)[DV / 16], f32x4 (&O2)[DV / 16], const bf16x8 (&P1)[2], const bf16x8 (&P2)[2], float a1, float a2,
                     const char* Vs, int li, int lg) {
  constexpr int RS = DV * 2 + 32, NB = DV / 16, NC = NB / 2;
#pragma unroll
  for (int dt = 0; dt < NB; ++dt) { O1[dt] *= a1; if (NMAP == 2) O2[dt] *= a2; }
  const char* b0 = Vs + (lg * 4 + (li >> 2)) * RS + (li & 3) * 8;
  s16x4 vlo[2][2][2], vhi[2][2][2];
#pragma unroll
  for (int dtl = 0; dtl < 2; ++dtl)
#pragma unroll
    for (int kp = 0; kp < 2; ++kp) {
      const char* b = b0 + kp * 32 * RS + dtl * 32;
      vlo[0][dtl][kp] = __builtin_amdgcn_ds_read_tr16_b64_v4i16((lds_s16x4_ptr)(b));
      vhi[0][dtl][kp] = __builtin_amdgcn_ds_read_tr16_b64_v4i16((lds_s16x4_ptr)(b + 16 * RS));
    }
#pragma unroll
  for (int c = 0; c < NC; ++c) {
    if (c + 1 < NC) {
#pragma unroll
      for (int dtl = 0; dtl < 2; ++dtl)
#pragma unroll
        for (int kp = 0; kp < 2; ++kp) {
          const char* b = b0 + kp * 32 * RS + (2 * (c + 1) + dtl) * 32;
          vlo[(c + 1) & 1][dtl][kp] = __builtin_amdgcn_ds_read_tr16_b64_v4i16((lds_s16x4_ptr)(b));
          vhi[(c + 1) & 1][dtl][kp] = __builtin_amdgcn_ds_read_tr16_b64_v4i16((lds_s16x4_ptr)(b + 16 * RS));
        }
    }
#pragma unroll
    for (int dtl = 0; dtl < 2; ++dtl)
#pragma unroll
      for (int kp = 0; kp < 2; ++kp) {
        const bf16x8 vf = __builtin_shufflevector(vlo[c & 1][dtl][kp], vhi[c & 1][dtl][kp], 0, 1, 2, 3, 4, 5, 6, 7);
        O1[2 * c + dtl] = mfma16(vf, P1[kp], O1[2 * c + dtl]);
        if (NMAP == 2) O2[2 * c + dtl] = mfma16(vf, P2[kp], O2[2 * c + dtl]);
      }
    __builtin_amdgcn_sched_group_barrier(0x008, 1, 0);
    if (c + 1 < NC) __builtin_amdgcn_sched_group_barrier(0x100, 8, 0);
    __builtin_amdgcn_sched_group_barrier(0x008, 4 * NMAP - 1, 0);
    __builtin_amdgcn_sched_barrier(0);
  }
}
template <int DV>
DI void attn_pv(f32x4 (&O)[DV / 16], const bf16x8 (&P)[2], float alpha, const char* Vs, int li, int lg) {
  attn_pv_pipe<DV, 1>(O, O, P, P, alpha, alpha, Vs, li, lg);
}

DI void dil_attn_item(const Params& p, int item, char* smem) {
  const int blk = item & 31, h = (item >> 5) & 3, gb = item >> 7, g = gb % 3, bl = gb / 3;
  const int dil = (g == 0) ? 1 : (g == 1 ? 4 : 16);
  const int nb = 32 / dil, r = blk / nb, n = blk % nb;
  const int tid = otid(), lane = tid & 63, wave = tid >> 6, li = lane & 15, lg = lane >> 4;
  const u16* SEG = (const u16*)(p.ws + O_SEG);
  const long tok0 = (long)bl * S;
  const int qcol = g * 768 + h * 64, kcol = qcol + 256, vcol = qcol + 512;
  const int qi = wave * 16 + li;
  const long qtok = tok0 + (long)(n * 128 + qi) * dil + r;
  bf16x8 Qf[2];
#pragma unroll
  for (int ks = 0; ks < 2; ++ks) Qf[ks] = *(const bf16x8*)(SEG + qtok * NSG + qcol + ks * 32 + lg * 8);
  f32x4 O[4];
  float m = -INFINITY, l = 0.f, alpha;
#pragma unroll
  for (int dt = 0; dt < 4; ++dt) O[dt] = f32x4{0.f, 0.f, 0.f, 0.f};
  char* Ks = smem; char* Vs = smem + 64 * 144;
  const int kt0 = (n == 0) ? 2 : 0;
  TileRegs<64> rk, rv;
  {
    const long s0 = (long)((n - 1) * 128 + kt0 * 64) * dil + r;
    rk.load(SEG + (tok0 + s0) * NSG + kcol, (long)dil * NSG, tid);
    rv.load(SEG + (tok0 + s0) * NSG + vcol, (long)dil * NSG, tid);
  }
  for (int kt = kt0; kt < 4; ++kt) {
    __syncthreads();
    rk.store(Ks, 16, tid); rv.store(Vs, 32, tid);
    __syncthreads();
    if (kt + 1 < 4) {
      const long s0 = (long)((n - 1) * 128 + (kt + 1) * 64) * dil + r;
      rk.load(SEG + (tok0 + s0) * NSG + kcol, (long)dil * NSG, tid);
      rv.load(SEG + (tok0 + s0) * NSG + vcol, (long)dil * NSG, tid);
    }
    const int qlo = wave * 16, klo = kt * 64;
    if (klo + 63 >= qlo && klo <= qlo + 15 + 128) {
      f32x4 Sa[4];
#pragma unroll
      for (int ks = 0; ks < 4; ++ks) Sa[ks] = f32x4{0.f, 0.f, 0.f, 0.f};
      attn_scores<64>(Sa, Qf, Ks, li, lg);
#pragma unroll
      for (int ksub = 0; ksub < 4; ++ksub)
#pragma unroll
        for (int j = 0; j < 4; ++j) {
          const int kj = klo + ksub * 16 + lg * 4 + j;
          const int dist = qi + 128 - kj;
          if (dist < 0 || dist > 128) Sa[ksub][j] = -INFINITY;
        }
      bf16x8 P[2];
      softmax_step(Sa, m, l, alpha, P);
      attn_pv<64>(O, P, alpha, Vs, li, lg);
    }
  }
  u16* OG = (u16*)(p.ws + O_OG);
  float* LSE = (float*)(p.ws + O_LSE);
  float lt = l; lt += __shfl_xor(lt, 16); lt += __shfl_xor(lt, 32);
  const float inv = 1.f / lt;
#pragma unroll
  for (int dt = 0; dt < 4; ++dt) {
    u32x2 o; o[0] = pack2(O[dt][0] * inv, O[dt][1] * inv); o[1] = pack2(O[dt][2] * inv, O[dt][3] * inv);
    *(u32x2*)(OG + qtok * 768 + g * 256 + h * 64 + dt * 16 + lg * 4) = o;
  }
  if (lg == 0) LSE[qtok * 12 + g * 4 + h] = m + __logf(lt);
}

DI void diff_attn_item(const Params& p, int l_, int item, char* smem) {
  const int n = 31 - (item & 31), h = (item >> 5) & 3, bl = item >> 7;
  const int tid = otid(), lane = tid & 63, wave = tid >> 6, li = lane & 15, lg = lane >> 4;
  const u16* SEG = (const u16*)(p.ws + O_SEG);
  const long tok0 = (long)bl * S;
  const int qcol = 2304 + h * 128, kcol = 2304 + 512 + h * 128, vcol = 2304 + 1024 + h * 128;
  const int qlo = n * 128 + wave * 16;
  const int q = qlo + li;
  bf16x8 Q1[2], Q2[2];
#pragma unroll
  for (int ks = 0; ks < 2; ++ks) {
    Q1[ks] = *(const bf16x8*)(SEG + (tok0 + q) * NSG + qcol + ks * 32 + lg * 8);
    Q2[ks] = *(const bf16x8*)(SEG + (tok0 + q) * NSG + qcol + 64 + ks * 32 + lg * 8);
  }
  f32x4 O1[8], O2[8];
  float m1 = -INFINITY, l1 = 0.f, m2 = -INFINITY, l2 = 0.f, alpha;
#pragma unroll
  for (int dt = 0; dt < 8; ++dt) { O1[dt] = f32x4{0.f, 0.f, 0.f, 0.f}; O2[dt] = f32x4{0.f, 0.f, 0.f, 0.f}; }
  char* K1s = smem; char* K2s = smem + 9216; char* Vs = smem + 18432;
  TileRegs<64> rk1, rk2; TileRegs<128> rv;
  rk1.load(SEG + tok0 * NSG + kcol, NSG, tid);
  rk2.load(SEG + tok0 * NSG + kcol + 64, NSG, tid);
  rv.load(SEG + tok0 * NSG + vcol, NSG, tid);
  const int nt = 2 * n + 2;
  for (int kt = 0; kt < nt; ++kt) {
    __syncthreads();
    rk1.store(K1s, 16, tid); rk2.store(K2s, 16, tid); rv.store(Vs, 32, tid);
    __syncthreads();
    if (kt + 1 < nt) {
      const long kr = tok0 + (kt + 1) * 64;
      rk1.load(SEG + kr * NSG + kcol, NSG, tid);
      rk2.load(SEG + kr * NSG + kcol + 64, NSG, tid);
      rv.load(SEG + kr * NSG + vcol, NSG, tid);
    }
    const int klo = kt * 64;
    if (klo <= qlo + 15) {
      const bool need_mask = (klo + 63 > qlo);
      bf16x8 P[2], Pb[2];
      float alpha2;
      f32x4 Sa[4], Sb[4];
#pragma unroll
      for (int ks = 0; ks < 4; ++ks) { Sa[ks] = f32x4{0.f, 0.f, 0.f, 0.f}; Sb[ks] = f32x4{0.f, 0.f, 0.f, 0.f}; }
      attn_scores<64>(Sa, Q1, K1s, li, lg);
      attn_scores<64>(Sb, Q2, K2s, li, lg);
      if (need_mask) {
#pragma unroll
        for (int ksub = 0; ksub < 4; ++ksub)
#pragma unroll
          for (int j = 0; j < 4; ++j) if (klo + ksub * 16 + lg * 4 + j > q) { Sa[ksub][j] = -INFINITY; Sb[ksub][j] = -INFINITY; }
      }
      softmax_step(Sa, m1, l1, alpha, P);
      softmax_step(Sb, m2, l2, alpha2, Pb);
      attn_pv_pipe<128, 2>(O1, O2, P, Pb, alpha, alpha2, Vs, li, lg);
    }
  }
  float lt1 = l1; lt1 += __shfl_xor(lt1, 16); lt1 += __shfl_xor(lt1, 32);
  float lt2 = l2; lt2 += __shfl_xor(lt2, 16); lt2 += __shfl_xor(lt2, 32);
  const float lam = ((const float*)(p.ws + O_SCAL))[l_];
  const float lam_init = (l_ == 0) ? 0.2f : 0.355509067591f;
  const float i1 = 1.f / lt1, i2 = lam / lt2;
  float ss = 0.f;
#pragma unroll
  for (int dt = 0; dt < 8; ++dt)
#pragma unroll
    for (int j = 0; j < 4; ++j) { const float o = O1[dt][j] * i1 - O2[dt][j] * i2; O1[dt][j] = o; ss += o * o; }
  ss += __shfl_xor(ss, 16); ss += __shfl_xor(ss, 32);
  const float rstd = (1.f - lam_init) / sqrtf(ss * (1.f / 128.f) + EPS);
  const float* ng = p.in[6] + l_ * 128;
  u16* Y = (u16*)(p.ws + O_Y);
#pragma unroll
  for (int dt = 0; dt < 8; ++dt) {
    const int dv = dt * 16 + lg * 4;
    const float4 gg = *(const float4*)(ng + dv);
    u32x2 o; o[0] = pack2(O1[dt][0] * rstd * gg.x, O1[dt][1] * rstd * gg.y); o[1] = pack2(O1[dt][2] * rstd * gg.z, O1[dt][3] * rstd * gg.w);
    *(u32x2*)(Y + (tok0 + q) * YW + 256 + h * 128 + dv) = o;
  }
}

DI void cross_attn_item(const Params& p, int l_, int grp, int item, char* smem) {
  const int qb = item & 31, hm = (item >> 5) & 3, bl = item >> 7;
  const int tid = otid(), lane = tid & 63, wave = tid >> 6, li = lane & 15, lg = lane >> 4;
  const u16* Q = (const u16*)(p.ws + O_Q);
  const u16* KV = (const u16*)(p.ws + O_KV) + (size_t)l_ * 4096 * 2048 + (size_t)(grp * BG + bl) * 256 * 2048;
  const long tok = (long)bl * S + qb * 128 + wave * 16 + li;
  bf16x8 Qf[8];
#pragma unroll
  for (int ks = 0; ks < 8; ++ks) Qf[ks] = *(const bf16x8*)(Q + tok * 1024 + hm * 256 + ks * 32 + lg * 8);
  f32x4 O[16];
#pragma unroll
  for (int dt = 0; dt < 16; ++dt) O[dt] = f32x4{0.f, 0.f, 0.f, 0.f};
  float m = -INFINITY, l = 0.f, alpha;
  char* Ks = smem; char* Vs = smem + 64 * 528;
  TileRegs<256> rk, rv;
  rk.load(KV + hm * 256, 2048, tid);
  rv.load(KV + 1024 + hm * 256, 2048, tid);
  for (int kt = 0; kt < 4; ++kt) {
    __syncthreads();
    rk.store(Ks, 16, tid); rv.store(Vs, 32, tid);
    __syncthreads();
    if (kt + 1 < 4) {
      rk.load(KV + (size_t)((kt + 1) * 64) * 2048 + hm * 256, 2048, tid);
      rv.load(KV + (size_t)((kt + 1) * 64) * 2048 + 1024 + hm * 256, 2048, tid);
    }
    f32x4 Sa[4];
#pragma unroll
    for (int ks = 0; ks < 4; ++ks) Sa[ks] = f32x4{0.f, 0.f, 0.f, 0.f};
    attn_scores<256>(Sa, Qf, Ks, li, lg);
    bf16x8 P[2];
    softmax_step(Sa, m, l, alpha, P);
    attn_pv<256>(O, P, alpha, Vs, li, lg);
  }
  float lt = l; lt += __shfl_xor(lt, 16); lt += __shfl_xor(lt, 32);
  const float inv = 1.f / lt;
  u16* OB = (u16*)(p.ws + O_O);
#pragma unroll
  for (int dt = 0; dt < 16; ++dt) {
    u32x2 o; o[0] = pack2(O[dt][0] * inv, O[dt][1] * inv); o[1] = pack2(O[dt][2] * inv, O[dt][3] * inv);
    *(u32x2*)(OB + tok * 1024 + hm * 256 + dt * 16 + lg * 4) = o;
  }
}

template <int PASS>
DI void hgrn_item(const Params& p, int l_, int item, char* smem) {
  const int c = item & 31, h = (item >> 5) & 3, bl = item >> 7;
  const int tid = otid(), v = tid & 63, kq = tid >> 6;
  float* sF = (float*)smem;
  float* sK = sF + 1024;
  float* sQ = sK + 1024;
  float* sI = sQ + 1024;
  float* sG = sI + 1024;
  float* sO = sG + 1024;
  const u16* SEG = (const u16*)(p.ws + O_SEG);
  float* HGS = (float*)(p.ws + O_HGS);
  float* HGF = (float*)(p.ws + O_HGF);
  const int arr = tid >> 7, stok = (tid >> 3) & 15, sch = tid & 7;
  const bool ld_on = (PASS == 3) || (arr == 1) || (arr == 2);
  const u16* sbase = SEG + ((size_t)bl * S + c * 128 + stok) * NSG + 3840 + arr * 256 + h * 64 + sch * 8;
  float lbv[8];
#pragma unroll
  for (int e = 0; e < 8; ++e) {
    lbv[e] = 0.f;
    if (l_ == 1) { const float* lg0 = p.in[7]; const int k = h * 64 + sch * 8 + e; lbv[e] = 1.f / (1.f + __expf(lg0[k] - lg0[256 + k])); }
  }
  u32x4 pre = u32x4{0u, 0u, 0u, 0u};
  if (ld_on) pre = *(const u32x4*)sbase;
  float s[8], Fp[8];
#pragma unroll
  for (int e = 0; e < 8; ++e) { s[e] = 0.f; Fp[e] = 1.f; }
  if (PASS == 3) {
#pragma unroll 4
    for (int cc = 0; cc < c; ++cc) {
      const size_t it = (size_t)((bl * 4 + h) * 32 + cc);
      const float* st = HGS + it * 4096;
      const float* ff = HGF + it * 64;
#pragma unroll
      for (int e = 0; e < 8; ++e) { const int k = kq * 8 + e; s[e] = ff[k] * s[e] + st[k * 64 + v]; }
    }
  }
#pragma unroll 1
  for (int sub = 0; sub < 8; ++sub) {
    const int t0 = c * 128 + sub * 16;
    __syncthreads();
    if (ld_on) {
      float x[8];
      x[0] = bflo(pre[0]); x[1] = bfhi(pre[0]); x[2] = bflo(pre[1]); x[3] = bfhi(pre[1]);
      x[4] = bflo(pre[2]); x[5] = bfhi(pre[2]); x[6] = bflo(pre[3]); x[7] = bfhi(pre[3]);
      const int o = stok * 64 + sch * 8;
      if (arr == 1) {
#pragma unroll
        for (int e = 0; e < 8; ++e) { sF[o + e] = lbv[e] + (1.f - lbv[e]) * sigm(x[e]); sK[o + e] = (1.f - lbv[e]) * sigm(-x[e]); }
      } else if (arr == 2) {
#pragma unroll
        for (int e = 0; e < 8; ++e) sI[o + e] = x[e];
      } else if (arr == 0) {
#pragma unroll
        for (int e = 0; e < 8; ++e) sQ[o + e] = silu(x[e]);
      } else {
#pragma unroll
        for (int e = 0; e < 8; ++e) sG[o + e] = silu(x[e]);
      }
    }
    __syncthreads();
    if (ld_on && sub + 1 < 8) pre = *(const u32x4*)(sbase + (size_t)(sub + 1) * 16 * NSG);
    {
      float ivn = sI[v];
      float4 fn[2], kn[2], qn[2];
#pragma unroll
      for (int e4 = 0; e4 < 2; ++e4) {
        fn[e4] = *(const float4*)(sF + kq * 8 + e4 * 4); kn[e4] = *(const float4*)(sK + kq * 8 + e4 * 4);
        if (PASS == 3) qn[e4] = *(const float4*)(sQ + kq * 8 + e4 * 4);
      }
#pragma unroll 4
      for (int tt = 0; tt < 16; ++tt) {
        const float iv = ivn;
        float4 fc[2], kc[2], qc[2];
#pragma unroll
        for (int e4 = 0; e4 < 2; ++e4) { fc[e4] = fn[e4]; kc[e4] = kn[e4]; if (PASS == 3) qc[e4] = qn[e4]; }
        {
          const int tn = (tt + 1) & 15;
          ivn = sI[tn * 64 + v];
#pragma unroll
          for (int e4 = 0; e4 < 2; ++e4) {
            fn[e4] = *(const float4*)(sF + tn * 64 + kq * 8 + e4 * 4); kn[e4] = *(const float4*)(sK + tn * 64 + kq * 8 + e4 * 4);
            if (PASS == 3) qn[e4] = *(const float4*)(sQ + tn * 64 + kq * 8 + e4 * 4);
          }
        }
        __builtin_amdgcn_sched_barrier(0);
        float o = 0.f;
#pragma unroll
        for (int e4 = 0; e4 < 2; ++e4) {
          const float4 f4 = fc[e4], k4 = kc[e4];
          s[e4 * 4 + 0] = f4.x * s[e4 * 4 + 0] + k4.x * iv;
          s[e4 * 4 + 1] = f4.y * s[e4 * 4 + 1] + k4.y * iv;
          s[e4 * 4 + 2] = f4.z * s[e4 * 4 + 2] + k4.z * iv;
          s[e4 * 4 + 3] = f4.w * s[e4 * 4 + 3] + k4.w * iv;
          if (PASS == 1) { Fp[e4 * 4 + 0] *= f4.x; Fp[e4 * 4 + 1] *= f4.y; Fp[e4 * 4 + 2] *= f4.z; Fp[e4 * 4 + 3] *= f4.w; }
          if (PASS == 3) {
            const float4 q4 = qc[e4];
            o += s[e4 * 4 + 0] * q4.x + s[e4 * 4 + 1] * q4.y + s[e4 * 4 + 2] * q4.z + s[e4 * 4 + 3] * q4.w;
          }
        }
        if (PASS == 3) sO[(tt * 8 + kq) * 64 + v] = o;
        __builtin_amdgcn_sched_barrier(0);
      }
    }
    if (PASS == 3) {
      __syncthreads();
      u16* Y = (u16*)(p.ws + O_Y);
      const float* ng = p.in[8] + l_ * 64;
#pragma unroll
      for (int i = 0; i < 2; ++i) {
        const int tt = i * 8 + kq;
        float o = 0.f;
#pragma unroll
        for (int qq = 0; qq < 8; ++qq) o += sO[(tt * 8 + qq) * 64 + v];
        const float ss = wave_sum(o * o);
        const float rstd = 1.0f / sqrtf(ss * (1.f / 64.f) + EPS);
        const size_t tok = (size_t)bl * S + t0 + tt;
        Y[tok * YW + 768 + h * 64 + v] = f2bf(o * rstd * ng[v] * sG[tt * 64 + v]);
      }
    }
  }
  if (PASS == 1) {
#pragma unroll
    for (int e = 0; e < 8; ++e) {
      HGS[(size_t)item * 4096 + (kq * 8 + e) * 64 + v] = s[e];
      if (v == 0) HGF[(size_t)item * 64 + kq * 8 + e] = Fp[e];
    }
  }
}

DI void rwkv_prep_item(const Params& p, int l_, int item, char* smem) {
  const int tid = otid(), lane = tid & 63, wave = tid >> 6, c = tid & 255, half = tid >> 8;
  float* lin = (float*)smem;
  float* vv = lin + 4096;
  float* t1 = vv + 4096;
  float* sV1 = t1 + 512;
  const u16* SEGD = (const u16*)(p.ws + O_SEGD);
  const float* mu = p.in[9] + l_ * 1024;
  const size_t tokb = (size_t)item * 16 + half * 8;
  u16* VF = (u16*)(p.ws + O_VFIRST);
  float xr[8], xk[8];
  float vfv[8];
  __syncthreads();
  {
    const float mr = mu[c], mk = mu[256 + c], mv = mu[512 + c], ml = mu[768 + c];
    u16 raw[9][4];
    const bool first0 = ((tokb & (S - 1)) == 0);
#pragma unroll
    for (int rr = 0; rr < 9; ++rr) {
      const u16* row = SEGD + (tokb + rr - 1) * 1024;
      if (rr == 0 && first0) { raw[rr][0] = 0; raw[rr][1] = 0; raw[rr][2] = 0; raw[rr][3] = 0; }
      else { raw[rr][0] = row[c]; raw[rr][1] = row[256 + c]; raw[rr][2] = row[512 + c]; raw[rr][3] = row[768 + c]; }
    }
    if (l_ == 1) {
#pragma unroll
      for (int tk = 0; tk < 8; ++tk) vfv[tk] = bf2f(VF[(tokb + tk) * 256 + c]);
      const float4* v1 = (const float4*)p.in[21];
#pragma unroll
      for (int i = 0; i < 4; ++i) ((float4*)sV1)[tid + NTH * i] = v1[tid + NTH * i];
    }
#pragma unroll
    for (int tk = 0; tk < 8; ++tk) {
      float a, b;
      a = bf2f(raw[tk + 1][0]); b = bf2f(raw[tk][0]); xr[tk] = a + (b - a) * mr;
      a = bf2f(raw[tk + 1][1]); b = bf2f(raw[tk][1]); xk[tk] = a + (b - a) * mk;
      a = bf2f(raw[tk + 1][2]); b = bf2f(raw[tk][2]); const float xv_ = a + (b - a) * mv;
      a = bf2f(raw[tk + 1][3]); b = bf2f(raw[tk][3]);
      float x = a + (b - a) * ml;
      if (c < 64) x = 1.f - 2.f / (__expf(2.f * x) + 1.f);
      else if (c >= 128) x = sigm(x);
      lin[(half * 8 + tk) * 256 + c] = x;
      vv[(half * 8 + tk) * 256 + c] = xv_;
    }
  }
  __syncthreads();
  float lw[8], la[8], lgg[8];
#pragma unroll
  for (int tk = 0; tk < 8; ++tk) { lw[tk] = 0.f; la[tk] = 0.f; lgg[tk] = 0.f; }
  const float* w2 = p.in[11] + l_ * 64 * 256;
  const float* a2 = p.in[13] + l_ * 64 * 256;
  const float* g2 = p.in[14] + l_ * 128 * 256;
  float wn[16];
#pragma unroll
  for (int j = 0; j < 16; ++j) wn[j] = w2[j * 256 + c];
#pragma unroll 1
  for (int ch = 0; ch < 16; ++ch) {
    float wr[16];
#pragma unroll
    for (int j = 0; j < 16; ++j) wr[j] = wn[j];
    if (ch + 1 < 16) {
      const int cn = ch + 1;
      const float* wsrc = (cn < 4) ? (w2 + cn * 16 * 256) : (cn < 8 ? (a2 + (cn - 4) * 16 * 256) : (g2 + (cn - 8) * 16 * 256));
#pragma unroll
      for (int j = 0; j < 16; ++j) wn[j] = wsrc[j * 256 + c];
    }
#pragma unroll
    for (int tk = 0; tk < 8; ++tk) {
      float acc = 0.f;
#pragma unroll
      for (int j4 = 0; j4 < 4; ++j4) {
        const float4 x4 = *(const float4*)(lin + (half * 8 + tk) * 256 + ch * 16 + j4 * 4);
        acc += x4.x * wr[j4 * 4] + x4.y * wr[j4 * 4 + 1] + x4.z * wr[j4 * 4 + 2] + x4.w * wr[j4 * 4 + 3];
      }
      if (ch < 4) lw[tk] += acc; else if (ch < 8) la[tk] += acc; else lgg[tk] += acc;
    }
  }
  float vmixw[8];
  if (l_ == 1) {
    {
      const int tk = tid >> 5, j0 = tid & 31;
      float a0 = 0.f, a1 = 0.f;
#pragma unroll 8
      for (int cc = 0; cc < 256; cc += 2) { a0 += vv[tk * 256 + cc] * sV1[cc * 32 + j0]; a1 += vv[tk * 256 + cc + 1] * sV1[(cc + 1) * 32 + j0]; }
      t1[tk * 32 + j0] = a0 + a1;
    }
    const float* v2 = p.in[22];
    float wr[32];
#pragma unroll
    for (int j = 0; j < 32; ++j) wr[j] = v2[j * 256 + c];
    __syncthreads();
#pragma unroll
    for (int tk = 0; tk < 8; ++tk) {
      float acc = 0.f;
#pragma unroll
      for (int j4 = 0; j4 < 8; ++j4) {
        const float4 x4 = *(const float4*)(t1 + (half * 8 + tk) * 32 + j4 * 4);
        acc += x4.x * wr[j4 * 4] + x4.y * wr[j4 * 4 + 1] + x4.z * wr[j4 * 4 + 2] + x4.w * wr[j4 * 4 + 3];
      }
      vmixw[tk] = acc;
    }
  }
  const float w0 = p.in[10][l_ * 256 + c], a0 = p.in[12][l_ * 256 + c];
  const float k_k = p.in[15][l_ * 256 + c], k_a = p.in[16][l_ * 256 + c], r_k = p.in[17][l_ * 256 + c];
  const float v0 = (l_ == 1) ? p.in[20][c] : 0.f;
  u16* RWR = (u16*)(p.ws + O_RWR); u16* RWK = (u16*)(p.ws + O_RWK); u16* RWV = (u16*)(p.ws + O_RWV);
  u16* RWKK = (u16*)(p.ws + O_RWKK); u16* RWKKA = (u16*)(p.ws + O_RWKKA); u16* RWG = (u16*)(p.ws + O_RWG);
  float* RWW = (float*)(p.ws + O_RWW); float* RWRK = (float*)(p.ws + O_RWRK);
#pragma unroll
  for (int tk = 0; tk < 8; ++tk) {
    const size_t tok = tokb + tk;
    const float xv_ = vv[(half * 8 + tk) * 256 + c];
    const float u = w0 + lw[tk];
    const float z = -u;
    const float sp = fmaxf(z, 0.f) + __logf(1.f + __expf(-fabsf(z)));
    const float wv = -sp - 0.5f;
    const float decay = __expf(-__expf(wv));
    const float a = sigm(a0 + la[tk]);
    const float kkx = xk[tk] * k_k;
    const float nrm = sqrtf(wave_sum(kkx * kkx));
    const float kkn = kkx / fmaxf(nrm, 1e-12f);
    const float k2 = xk[tk] * (1.f + (a - 1.f) * k_a);
    float v2v = xv_;
    if (l_ == 0) VF[tok * 256 + c] = f2bf(v2v);
    else v2v = v2v + (vfv[tk] - v2v) * sigm(v0 + vmixw[tk]);
    const float rk = wave_sum(xr[tk] * k2 * r_k);
    RWR[tok * 256 + c] = f2bf(xr[tk]);
    RWK[tok * 256 + c] = f2bf(k2);
    RWV[tok * 256 + c] = f2bf(v2v);
    RWKK[tok * 256 + c] = f2bf(kkn);
    RWKKA[tok * 256 + c] = f2bf(kkn * a);
    RWG[tok * 256 + c] = f2bf(lgg[tk]);
    RWW[tok * 256 + c] = decay;
    if (lane == 0) RWRK[tok * 4 + (wave & 3)] = rk;
  }
}

DI void rwkv_scan_item(const Params& p, int item, char* smem) {
  const int rg = item & 1, h = (item >> 1) & 3, b = item >> 3;
  const int tid = otid(), lane = tid & 63, wave = tid >> 6, kap = lane & 15, rho = lane >> 4;
  const int rowh = rg * 32 + wave * 4 + rho;
  float* sW = (float*)smem;
  float* sKK = sW + 2048;
  float* sKA = sKK + 2048;
  float* sK = sKA + 2048;
  float* sR = sK + 2048;
  float* sV = sR + 2048;
  float* sY = sV + 2048;
  const float* RWW = (const float*)(p.ws + O_RWW);
  const u16* RWR = (const u16*)(p.ws + O_RWR); const u16* RWK = (const u16*)(p.ws + O_RWK); const u16* RWV = (const u16*)(p.ws + O_RWV);
  const u16* RWKK = (const u16*)(p.ws + O_RWKK); const u16* RWKKA = (const u16*)(p.ws + O_RWKKA);
  float* RWY = (float*)(p.ws + O_RWY);
  const size_t tokb = (size_t)b * S;
  u32x4 pw, pa, pb, pv;
  const int wtok = tid >> 4, wch = tid & 15;
  const int hsel = tid >> 8, btok = (tid & 255) >> 3, bch = tid & 7;
  const u16* arrA = hsel ? RWKKA : RWKK;
  const u16* arrB = hsel ? RWR : RWK;
  float* dstA = hsel ? sKA : sKK;
  float* dstB = hsel ? sR : sK;
  const float sgnA = hsel ? 1.f : -1.f;
  pv = u32x4{0u, 0u, 0u, 0u};
  float S0 = 0.f, S1 = 0.f, S2 = 0.f, S3 = 0.f;
  {
    pw = *(const u32x4*)(RWW + (tokb + wtok) * 256 + h * 64 + wch * 4);
    const size_t off = (tokb + btok) * 256 + h * 64 + bch * 8;
    pa = *(const u32x4*)(arrA + off); pb = *(const u32x4*)(arrB + off);
    if (hsel == 0) pv = *(const u32x4*)(RWV + off);
  }
#pragma unroll 1
  for (int c = 0; c < S / 32; ++c) {
    __syncthreads();
    *(u32x4*)(sW + wtok * 64 + wch * 4) = pw;
    {
      float* da = dstA + btok * 64 + bch * 8; float* db = dstB + btok * 64 + bch * 8;
      *(f32x4*)(da) = f32x4{bflo(pa[0]) * sgnA, bfhi(pa[0]) * sgnA, bflo(pa[1]) * sgnA, bfhi(pa[1]) * sgnA};
      *(f32x4*)(da + 4) = f32x4{bflo(pa[2]) * sgnA, bfhi(pa[2]) * sgnA, bflo(pa[3]) * sgnA, bfhi(pa[3]) * sgnA};
      *(f32x4*)(db) = f32x4{bflo(pb[0]), bfhi(pb[0]), bflo(pb[1]), bfhi(pb[1])};
      *(f32x4*)(db + 4) = f32x4{bflo(pb[2]), bfhi(pb[2]), bflo(pb[3]), bfhi(pb[3])};
      if (hsel == 0) {
        float* dv = sV + btok * 64 + bch * 8;
        *(f32x4*)(dv) = f32x4{bflo(pv[0]), bfhi(pv[0]), bflo(pv[1]), bfhi(pv[1])};
        *(f32x4*)(dv + 4) = f32x4{bflo(pv[2]), bfhi(pv[2]), bflo(pv[3]), bfhi(pv[3])};
      }
    }
    __syncthreads();
    if (c + 1 < S / 32) {
      const size_t t0 = tokb + (size_t)(c + 1) * 32;
      pw = *(const u32x4*)(RWW + (t0 + wtok) * 256 + h * 64 + wch * 4);
      const size_t off = (t0 + btok) * 256 + h * 64 + bch * 8;
      pa = *(const u32x4*)(arrA + off); pb = *(const u32x4*)(arrB + off);
      if (hsel == 0) pv = *(const u32x4*)(RWV + off);
    }
    f32x4 w4n = *(const f32x4*)(sW + kap * 4), nk4n = *(const f32x4*)(sKK + kap * 4), ka4n = *(const f32x4*)(sKA + kap * 4);
    f32x4 k4n = *(const f32x4*)(sK + kap * 4), r4n = *(const f32x4*)(sR + kap * 4);
    float vvn = sV[rowh];
    f32x4 rprev = f32x4{0.f, 0.f, 0.f, 0.f};
#pragma unroll 4
    for (int tt = 0; tt < 32; ++tt) {
      const f32x4 w4 = w4n, nk4 = nk4n, ka4 = ka4n, k4 = k4n, r4 = r4n;
      const float vv = vvn;
      {
        const int tn = (tt + 1) & 31;
        w4n = *(const f32x4*)(sW + tn * 64 + kap * 4); nk4n = *(const f32x4*)(sKK + tn * 64 + kap * 4); ka4n = *(const f32x4*)(sKA + tn * 64 + kap * 4);
        k4n = *(const f32x4*)(sK + tn * 64 + kap * 4); r4n = *(const f32x4*)(sR + tn * 64 + kap * 4);
        vvn = sV[tn * 64 + rowh];
      }
      __builtin_amdgcn_sched_barrier(0);
      float sa, y;
      float u0, u1, u2, u3;
      {
        float a1 = S0 * nk4[0], b1 = S0 * rprev[0];
        float a2 = S2 * nk4[2], b2 = S2 * rprev[2];
        a1 = fmaf(S1, nk4[1], a1); b1 = fmaf(S1, rprev[1], b1);
        a2 = fmaf(S3, nk4[3], a2); b2 = fmaf(S3, rprev[3], b2);
        sa = a1 + a2; y = b1 + b2;
        u0 = vv * k4[0]; u1 = vv * k4[1];
        sa += dpp_mov<0xB1>(sa);  y += dpp_mov<0xB1>(y);
        u2 = vv * k4[2]; u3 = vv * k4[3];
        sa += dpp_mov<0x4E>(sa);  y += dpp_mov<0x4E>(y);
        u0 = fmaf(S0, w4[0], u0); u1 = fmaf(S1, w4[1], u1);
        sa += dpp_mov<0x141>(sa); y += dpp_mov<0x141>(y);
        u2 = fmaf(S2, w4[2], u2); u3 = fmaf(S3, w4[3], u3);
        sa += dpp_mov<0x140>(sa); y += dpp_mov<0x140>(y);
      }
      if (tt > 0 && kap == 0) sY[(tt - 1) * 32 + wave * 4 + rho] = y;
      S0 = fmaf(sa, ka4[0], u0);
      S1 = fmaf(sa, ka4[1], u1);
      S2 = fmaf(sa, ka4[2], u2);
      S3 = fmaf(sa, ka4[3], u3);
      rprev = r4;
      __builtin_amdgcn_sched_barrier(0);
    }
    {
      float y = (S0 * rprev[0] + S1 * rprev[1]) + (S2 * rprev[2] + S3 * rprev[3]);
      y = red16(y);
      if (kap == 0) sY[31 * 32 + wave * 4 + rho] = y;
    }
    __syncthreads();
    {
      const size_t t0 = tokb + (size_t)c * 32;
#pragma unroll
      for (int i = 0; i < 2; ++i) {
        const int idx = tid + NTH * i, tt = idx >> 5, rr = idx & 31;
        RWY[(t0 + tt) * 256 + h * 64 + rg * 32 + rr] = sY[idx];
      }
    }
  }
}

DI void rwkv_post_item(const Params& p, int l_, int item) {
  const int tid = otid(), wave = tid >> 6, c = tid & 255, half = tid >> 8;
  const float* RWY = (const float*)(p.ws + O_RWY);
  const float* RWRK = (const float*)(p.ws + O_RWRK);
  const u16* RWV = (const u16*)(p.ws + O_RWV); const u16* RWG = (const u16*)(p.ws + O_RWG);
  u16* YD = (u16*)(p.ws + O_YD);
  const float lg = p.in[18][l_ * 256 + c], lb = p.in[19][l_ * 256 + c];
#pragma unroll 1
  for (int it = 0; it < 8; ++it) {
    float y[4], rk[4], vv[4], gg[4];
#pragma unroll
    for (int u = 0; u < 4; ++u) {
      const size_t tok = (size_t)item * 64 + (it * 4 + u) * 2 + half;
      y[u] = RWY[tok * 256 + c]; rk[u] = RWRK[tok * 4 + (wave & 3)];
      vv[u] = bf2f(RWV[tok * 256 + c]); gg[u] = bf2f(RWG[tok * 256 + c]);
    }
#pragma unroll
    for (int u = 0; u < 4; ++u) {
      const size_t tok = (size_t)item * 64 + (it * 4 + u) * 2 + half;
      const float mean = wave_sum(y[u]) * (1.f / 64.f);
      const float d = y[u] - mean;
      const float var = wave_sum(d * d) * (1.f / 64.f);
      const float yn = d / sqrtf(var + 64e-5f) * lg + lb;
      YD[tok * 256 + c] = f2bf((yn + rk[u] * vv[u]) * gg[u]);
    }
  }
}

DI void dil_combine_item(const Params& p, int item) {
  const int tid = otid(), ch = tid & 31, tl = tid >> 5, h = ch >> 3;
  const u16* OG = (const u16*)(p.ws + O_OG);
  const float* LSE = (const float*)(p.ws + O_LSE);
  u16* Y = (u16*)(p.ws + O_Y);
  u32x4 o0[4], o1[4], o2[4]; float l0[4], l1[4], l2[4];
#pragma unroll
  for (int ps = 0; ps < 4; ++ps) {
    const size_t tok = (size_t)item * 64 + ps * 16 + tl;
    o0[ps] = *(const u32x4*)(OG + tok * 768 + ch * 8);
    o1[ps] = *(const u32x4*)(OG + tok * 768 + 256 + ch * 8);
    o2[ps] = *(const u32x4*)(OG + tok * 768 + 512 + ch * 8);
    l0[ps] = LSE[tok * 12 + h]; l1[ps] = LSE[tok * 12 + 4 + h]; l2[ps] = LSE[tok * 12 + 8 + h];
  }
#pragma unroll
  for (int ps = 0; ps < 4; ++ps) {
    const size_t tok = (size_t)item * 64 + ps * 16 + tl;
    const float mx = fmaxf(l0[ps], fmaxf(l1[ps], l2[ps]));
    float e0 = __expf(l0[ps] - mx), e1 = __expf(l1[ps] - mx), e2 = __expf(l2[ps] - mx);
    const float inv = 1.f / (e0 + e1 + e2);
    e0 *= inv; e1 *= inv; e2 *= inv;
    u32x4 r;
#pragma unroll
    for (int q = 0; q < 4; ++q)
      r[q] = pack2(e0 * bflo(o0[ps][q]) + e1 * bflo(o1[ps][q]) + e2 * bflo(o2[ps][q]), e0 * bfhi(o0[ps][q]) + e1 * bfhi(o1[ps][q]) + e2 * bfhi(o2[ps][q]));
    *(u32x4*)(Y + tok * YW + ch * 8) = r;
  }
}

DI int next_item(int* counter, int* s_item) {
  __syncthreads();
  if (otid() == 0) *s_item = atomicAdd(counter, 1);
  __syncthreads();
  return *s_item;
}
constexpr int N_DIL = BG * 3 * 4 * 32, N_HG = BG * 4 * 32;
constexpr int N_SCAN = NB * 8, N_DIFF = BG * 4 * 32, N_COMB = TG / 64;

DI void phase_stage1(const Params& p, int l, int grp, char* smem, int* s_item) {
  int* counter = (int*)(p.ws + O_CNT) + (l * NGRP + grp) * 2;
  const int nscan = (grp == 0) ? N_SCAN : 0;
  for (;;) {
    int it = next_item(counter, s_item);
    if (it >= nscan + N_DIFF + N_DIL + N_HG) break;
    if (it < nscan) { rwkv_scan_item(p, it, smem); continue; }
    it -= nscan;
    if (it < N_DIFF) { diff_attn_item(p, l, it, smem); continue; }
    it -= N_DIFF;
    if (it < N_DIL) dil_attn_item(p, it, smem);
    else hgrn_item<1>(p, l, it - N_DIL, smem);
  }
}
DI void phase_stage2(const Params& p, int l, int grp, char* smem, int* s_item) {
  int* counter = (int*)(p.ws + O_CNT) + (l * NGRP + grp) * 2 + 1;
  for (;;) {
    int it = next_item(counter, s_item);
    if (it >= N_HG + N_COMB) break;
    if (it < N_HG) hgrn_item<3>(p, l, it, smem);
    else dil_combine_item(p, it - N_HG);
  }
}

DI void phase_merge(const Params& p, int l, int grp, char* smem) {
  const u16* Y = (const u16*)(p.ws + O_Y);
  const u16* YD = (const u16*)(p.ws + O_YD) + (size_t)grp * TG * 256;
  const u16* SEG = (const u16*)(p.ws + O_SEG);
  u16* MG = (u16*)(p.ws + O_MERGED);
  TileWalk<8> tw(TG / 128, 4);
  for (int mt, nt; tw.next(mt, nt);) {
    f32x4 accm[4][4]; zero_acc<4>(accm);
#pragma unroll 1
    for (int i = 0; i < 4; ++i) {
      f32x4 accp[4][4];
      zero_acc<4>(accp);
      const u16* Pi; const u16* Ai; int Ki, lda;
      if (i == 0) { Pi = (const u16*)(p.ws + O_PA) + (size_t)l * E_PA; Ki = 256; Ai = Y + (size_t)mt * 128 * YW; lda = YW; }
      else if (i == 1) { Pi = (const u16*)(p.ws + O_PB) + (size_t)l * E_PB; Ki = 512; Ai = Y + (size_t)mt * 128 * YW + 256; lda = YW; }
      else if (i == 2) { Pi = (const u16*)(p.ws + O_PC) + (size_t)l * E_PC; Ki = 256; Ai = Y + (size_t)mt * 128 * YW + 768; lda = YW; }
      else { Pi = (const u16*)(p.ws + O_PD) + (size_t)l * E_PD; Ki = 256; Ai = YD + (size_t)mt * 128 * 256; lda = 256; }
      gemm_main<4>(accp, Ai, lda, Pi + (size_t)(nt * 256) * Ki, Ki, Ki, smem);
      int mt2 = mt; asm volatile("" : "+s"(mt2));
      const u16* gb = SEG + (size_t)mt2 * 128 * NSG + GOFF + i * 1024 + nt * 256;
      epi_foreach<4>(accp, [&](int mi, int ni, int r, int c, f32x4& v) {
        const u32x2 g = *(const u32x2*)(gb + (unsigned)(r * NSG + c));
        accm[mi][ni][0] += bflo(g[0]) * v[0]; accm[mi][ni][1] += bfhi(g[0]) * v[1];
        accm[mi][ni][2] += bflo(g[1]) * v[2]; accm[mi][ni][3] += bfhi(g[1]) * v[3];
      });
    }
    u16* mgb = MG + (size_t)mt * 128 * 1024 + nt * 256;
    epi_foreach<4>(accm, [&](int mi, int ni, int r, int c, f32x4& v) { *(u32x2*)(mgb + (unsigned)(r * 1024 + c)) = pack4(v); });
  }
}

enum { EPI_RESID = 0, EPI_BF16 = 1 };
template <int KIND>
DI void phase_gemm(const u16* A, int lda, const u16* Wt, int K, int N, int rows, const float* xin, float* xout, u16* cb, int ldc, float scale, char* smem) {
  const int NT = N / 256;
  TileWalk<4> tw(rows / 256, NT);
  int mt = 0, nt = 0;
  bool have = tw.next(mt, nt);
  int rb = 0;
  if (have) { __syncthreads(); gemm_issue0<8>(A + (size_t)mt * 256 * lda, lda, Wt + (size_t)nt * 256 * K, K, smem, rb); }
  while (have) {
    f32x4 acc[8][4]; zero_acc<8>(acc);
    gemm_run<8>(acc, A + (size_t)mt * 256 * lda, lda, Wt + (size_t)nt * 256 * K, K, K, smem, true, rb);
    int mt2 = 0, nt2 = 0;
    const bool have2 = tw.next(mt2, nt2);
    if (have2) gemm_issue0<8>(A + (size_t)mt2 * 256 * lda, lda, Wt + (size_t)nt2 * 256 * K, K, smem, rb);
    if (KIND == EPI_RESID) {
      const float* xib = xin + (size_t)mt * 256 * 1024 + nt * 256;
      float* xob = xout + (size_t)mt * 256 * 1024 + nt * 256;
      epi_foreach<8>(acc, [&](int mi, int ni, int r, int c, f32x4& v) {
        const unsigned o = (unsigned)(r * 1024 + c);
        const f32x4 x = *(const f32x4*)(xib + o);
        *(f32x4*)(xob + o) = x + v;
      });
    } else {
      u16* cbb = cb + (size_t)mt * 256 * ldc + nt * 256;
      epi_foreach<8>(acc, [&](int mi, int ni, int r, int c, f32x4& v) { *(u32x2*)(cbb + (unsigned)(r * ldc + c)) = pack4(v * scale); });
    }
    mt = mt2; nt = nt2; have = have2;
  }
}

DI void phase_cross(const Params& p, int l, int grp, char* smem) {
  const u16* H = (const u16*)(p.ws + O_H);
  const u16* WQ = (const u16*)(p.ws + O_MQ) + (size_t)l * E_MQ;
  u16* Q = (u16*)(p.ws + O_Q);
  for (int it = blockIdx.x; it < BG * 4 * 32; it += gridDim.x) {
    const int qb = it & 31, hm = (it >> 5) & 3, bl = it >> 7;
    const size_t row0 = (size_t)bl * S + qb * 128;
    f32x4 acc[4][4]; zero_acc<4>(acc);
    gemm_main<4>(acc, H + row0 * 1024, 1024, WQ + (size_t)hm * 256 * 1024, 1024, 1024, smem);
    u16* qbase = Q + row0 * 1024 + hm * 256;
    epi_foreach<4>(acc, [&](int mi, int ni, int r, int c, f32x4& v) { *(u32x2*)(qbase + (unsigned)(r * 1024 + c)) = pack4(v * 0.0625f); });
    __threadfence_block();
    __syncthreads();
    cross_attn_item(p, l, grp, it, smem);
  }
}

DI void phase_convact(const Params& p, int l) {
  const u16* U = (const u16*)(p.ws + O_U);
  u16* ACT = (u16*)(p.ws + O_ACT);
  const float* cw = p.in[35] + (size_t)l * 3 * NFF2;
  const float* cbias = p.in[36] + (size_t)l * NFF2;
  constexpr int CH = DFF / 8;
  const int tid = otid();
#pragma unroll 1
  for (int idx = blockIdx.x * NTH + tid; idx < (TG / 8) * CH; idx += gridDim.x * NTH) {
    const int run = idx / CH, ch = idx - run * CH;
    const int tok0 = run * 8, s0 = tok0 & (S - 1);
    u32x4 ug[10], uv[10];
#pragma unroll
    for (int rr = 0; rr < 10; ++rr) {
      if (rr < 2 && s0 == 0) { ug[rr] = u32x4{0u, 0u, 0u, 0u}; uv[rr] = u32x4{0u, 0u, 0u, 0u}; }
      else {
        const u16* row = U + (size_t)(tok0 + rr - 2) * NFF2;
        ug[rr] = *(const u32x4*)(row + ch * 8); uv[rr] = *(const u32x4*)(row + DFF + ch * 8);
      }
    }
    float wg[3][8], wv[3][8], bg[8], bv[8];
#pragma unroll
    for (int jj = 0; jj < 3; ++jj)
#pragma unroll
      for (int e4 = 0; e4 < 2; ++e4) {
        const float4 a = *(const float4*)(cw + jj * NFF2 + ch * 8 + e4 * 4), b = *(const float4*)(cw + jj * NFF2 + DFF + ch * 8 + e4 * 4);
        wg[jj][e4 * 4] = a.x; wg[jj][e4 * 4 + 1] = a.y; wg[jj][e4 * 4 + 2] = a.z; wg[jj][e4 * 4 + 3] = a.w;
        wv[jj][e4 * 4] = b.x; wv[jj][e4 * 4 + 1] = b.y; wv[jj][e4 * 4 + 2] = b.z; wv[jj][e4 * 4 + 3] = b.w;
      }
#pragma unroll
    for (int e4 = 0; e4 < 2; ++e4) {
      const float4 a = *(const float4*)(cbias + ch * 8 + e4 * 4), b = *(const float4*)(cbias + DFF + ch * 8 + e4 * 4);
      bg[e4 * 4] = a.x; bg[e4 * 4 + 1] = a.y; bg[e4 * 4 + 2] = a.z; bg[e4 * 4 + 3] = a.w;
      bv[e4 * 4] = b.x; bv[e4 * 4 + 1] = b.y; bv[e4 * 4 + 2] = b.z; bv[e4 * 4 + 3] = b.w;
    }
#pragma unroll
    for (int t = 0; t < 8; ++t) {
      u32x4 o;
#pragma unroll
      for (int e2 = 0; e2 < 4; ++e2) {
        float g0 = bg[2 * e2], g1 = bg[2 * e2 + 1], v0 = bv[2 * e2], v1 = bv[2 * e2 + 1];
#pragma unroll
        for (int jj = 0; jj < 3; ++jj) {
          g0 += bflo(ug[t + jj][e2]) * wg[jj][2 * e2]; g1 += bfhi(ug[t + jj][e2]) * wg[jj][2 * e2 + 1];
          v0 += bflo(uv[t + jj][e2]) * wv[jj][2 * e2]; v1 += bfhi(uv[t + jj][e2]) * wv[jj][2 * e2 + 1];
        }
        o[e2] = pack2(silu(g0) * v0, silu(g1) * v1);
      }
      *(u32x4*)(ACT + (size_t)(tok0 + t) * DFF + ch * 8) = o;
    }
  }
}

__global__ void __launch_bounds__(NTH, 2) fwd_megakernel(Params p) {
  cg::grid_group grid = cg::this_grid();
  __shared__ __attribute__((aligned(1024))) char smem[SMEM_BYTES];
  int& s_item = *(int*)(smem + SMEM_BYTES - 64);
  XcdBarrier xb = xcd_barrier_post((unsigned*)(p.ws + O_XBAR));

  phase_prologue(p, smem);
  grid.sync();
  phase_kv_gemm(p, smem);

#pragma unroll 1
  for (int l = 0; l < NL; ++l) {
    xcd_barrier(xb);
    phase_norm((l == 0) ? p.in[0] : (const float*)p.out, p.in[3] + l * 1024, (u16*)(p.ws + O_HALL), T);
    xcd_barrier(xb);
    phase_gemm<EPI_BF16>((const u16*)(p.ws + O_HALL), 1024, (const u16*)(p.ws + O_WIN) + (size_t)l * E_WIN + (size_t)4864 * 1024, 1024, 1024, T,
                         nullptr, nullptr, (u16*)(p.ws + O_SEGD), 1024, 1.f, smem);
    xcd_barrier(xb);
    for (int it = blockIdx.x; it < T / 16; it += gridDim.x) rwkv_prep_item(p, l, it, smem);
#pragma unroll 1
    for (int grp = 0; grp < NGRP; ++grp) {
      const size_t xoff = (size_t)grp * TG * 1024;
      const float* xin = ((l == 0) ? p.in[0] : (const float*)p.out) + xoff;
      float* xout = p.out + xoff;
      u16* H = (u16*)(p.ws + O_H);
      xcd_barrier(xb);
      phase_norm(xin, p.in[3] + l * 1024, H, TG);
      xcd_barrier(xb);
      phase_gemm1(p, l, grp, smem);
      xcd_barrier(xb);
      phase_stage1(p, l, grp, smem, &s_item);
      xcd_barrier(xb);
      phase_stage2(p, l, grp, smem, &s_item);
      if (grp == 0) {
        xcd_barrier(xb);
        for (int it = blockIdx.x; it < T / 64; it += gridDim.x) rwkv_post_item(p, l, it);
      }
      xcd_barrier(xb);
      phase_merge(p, l, grp, smem);
      xcd_barrier(xb);
      phase_gemm<EPI_RESID>((const u16*)(p.ws + O_MERGED), 1024, (const u16*)(p.ws + O_MIX) + (size_t)l * E_MIX, 1024, 1024, TG, xin, xout, nullptr, 0, 1.f, smem);
      xcd_barrier(xb);
      phase_norm(xout, p.in[28] + l * 1024, H, TG);
      xcd_barrier(xb);
      phase_cross(p, l, grp, smem);
      xcd_barrier(xb);
      phase_gemm<EPI_RESID>((const u16*)(p.ws + O_O), 1024, (const u16*)(p.ws + O_MO) + (size_t)l * E_MO, 1024, 1024, TG, xout, xout, nullptr, 0, 1.f, smem);
      xcd_barrier(xb);
      phase_norm(xout, p.in[33] + l * 1024, H, TG);
      xcd_barrier(xb);
      phase_gemm<EPI_BF16>(H, 1024, (const u16*)(p.ws + O_FIN) + (size_t)l * E_FIN, 1024, NFF2, TG, nullptr, nullptr, (u16*)(p.ws + O_U), NFF2, 1.f, smem);
      xcd_barrier(xb);
      phase_convact(p, l);
      xcd_barrier(xb);
      phase_gemm<EPI_RESID>((const u16*)(p.ws + O_ACT), DFF, (const u16*)(p.ws + O_FOUT) + (size_t)l * E_FOUT, DFF, 1024, TG, xout, xout, nullptr, 0, 1.f, smem);
    }
  }
  xcd_barrier(xb);
  phase_final_norm(p.out, p.in[38]);
}

extern "C" void kernel_launch(void* const* d_in, const int* in_sizes, int n_in, void* d_out, int out_size, void* d_ws, size_t ws_size,
                              hipStream_t stream) {
  static int grid_blocks = 0;
  if (!grid_blocks) {
    int dev = 0, cus = 0, per_cu = 0;
    (void)hipGetDevice(&dev);
    (void)hipDeviceGetAttribute(&cus, hipDeviceAttributeMultiprocessorCount, dev);
    (void)hipOccupancyMaxActiveBlocksPerMultiprocessor(&per_cu, fwd_megakernel, NTH, 0);
    if (per_cu < 1) per_cu = 1;
    if (per_cu > 1) per_cu = 1;
    grid_blocks = cus * per_cu;
  }
  Params p{};
  for (int i = 0; i < 39; ++i) p.in[i] = (const float*)d_in[i];
  p.out = (float*)d_out;
  p.ws = (char*)d_ws;
  (void)hipMemsetAsync((char*)d_ws + O_XBAR, 0, XCD_BAR_WORDS * 4, stream);
  void* args[] = {&p};
  hipError_t e = hipLaunchCooperativeKernel((void*)fwd_megakernel, dim3(grid_blocks), dim3(NTH), args, 0, stream);
  if (e != hipSuccess) fprintf(stderr, "cooperative launch failed: %s (grid %d)\n", hipGetErrorString(e), grid_blocks);
}
```

```cpp
#include <hip/hip_runtime.h>
#include <hip/hip_cooperative_groups.h>
#include <stdint.h>
#include <stdio.h>
namespace cg = cooperative_groups;

#define DI __device__ __forceinline__
typedef unsigned short u16;
using bf16x8 = __attribute__((ext_vector_type(8))) short;
using s16x4  = __attribute__((ext_vector_type(4))) short;
using f32x4  = __attribute__((ext_vector_type(4))) float;
using u32x4  = __attribute__((ext_vector_type(4))) unsigned;
using u32x2  = __attribute__((ext_vector_type(2))) unsigned;

constexpr int NTH = 512;
constexpr int D = 1024, NB = 16, S = 4096, T = NB * S, NL = 2, MEM = 256;
constexpr int BG = 4, TG = BG * S, NGRP = NB / BG;
constexpr int NIN = 9984, DFF = 2816, NFF2 = 2 * DFF;
constexpr int NSG = 8960;
constexpr int GOFF = 4864;
constexpr int YW = 1024;
constexpr float EPS = 1e-5f;

constexpr size_t al(size_t x) { return (x + 255) & ~(size_t)255; }
constexpr size_t E_WIN = (size_t)NIN * D, E_PA = 1024 * 256, E_PB = 1024 * 512, E_PC = 1024 * 256, E_PD = 1024 * 256;
constexpr size_t E_MIX = 1024 * 1024, E_MQ = 1024 * 1024, E_MKV = 2048 * 1024, E_MO = 1024 * 1024;
constexpr size_t E_FIN = (size_t)NFF2 * D, E_FOUT = (size_t)D * DFF;
constexpr size_t O_WIN = 0;
constexpr size_t O_PA = O_WIN + al(NL * E_WIN * 2);
constexpr size_t O_PB = O_PA + al(NL * E_PA * 2);
constexpr size_t O_PC = O_PB + al(NL * E_PB * 2);
constexpr size_t O_PD = O_PC + al(NL * E_PC * 2);
constexpr size_t O_MIX = O_PD + al(NL * E_PD * 2);
constexpr size_t O_MQ = O_MIX + al(NL * E_MIX * 2);
constexpr size_t O_MKV = O_MQ + al(NL * E_MQ * 2);
constexpr size_t O_MO = O_MKV + al(NL * E_MKV * 2);
constexpr size_t O_FIN = O_MO + al(NL * E_MO * 2);
constexpr size_t O_FOUT = O_FIN + al(NL * E_FIN * 2);
constexpr size_t O_ROPE = O_FOUT + al(NL * E_FOUT * 2);
constexpr size_t O_MEMN = O_ROPE + al((size_t)T * 16 * 4);
constexpr size_t O_KV = O_MEMN + al((size_t)NL * 4096 * 1024 * 2);
constexpr size_t O_VFIRST = O_KV + al((size_t)NL * 4096 * 2048 * 2);
constexpr size_t O_SCAL = O_VFIRST + al((size_t)T * 256 * 2);
constexpr size_t O_BAR = O_SCAL + 128;
constexpr size_t O_CNT = O_SCAL + 256;
constexpr size_t SZ_RW = al((size_t)T * 256 * 2);
constexpr size_t O_XBAR = O_CNT + 2048;
constexpr size_t O_RWR = O_XBAR + 16384;
constexpr size_t O_RWK = O_RWR + SZ_RW, O_RWV = O_RWK + SZ_RW, O_RWKK = O_RWV + SZ_RW, O_RWKKA = O_RWKK + SZ_RW, O_RWG = O_RWKKA + SZ_RW;
constexpr size_t O_YD = O_RWG + SZ_RW;
constexpr size_t O_RWW = O_YD + SZ_RW;
constexpr size_t O_RWY = O_RWW + al((size_t)T * 256 * 4);
constexpr size_t O_RWRK = O_RWY + al((size_t)T * 256 * 4);
constexpr size_t O_TR = O_RWRK + al((size_t)T * 4 * 4);
constexpr size_t O_H = O_TR;
constexpr size_t O_SEG = O_H + al((size_t)TG * 1024 * 2);
constexpr size_t O_HGS = O_SEG + al((size_t)TG * NSG * 2);
constexpr size_t O_HGF = O_HGS + al((size_t)BG * 4 * 32 * 4096 * 4);
constexpr size_t O_OG = O_HGF + al((size_t)BG * 4 * 32 * 64 * 4);
constexpr size_t O_LSE = O_OG + al((size_t)TG * 768 * 2);
constexpr size_t O_Y = O_LSE + al((size_t)TG * 12 * 4);
constexpr size_t O_MERGED = O_Y + al((size_t)TG * YW * 2);
constexpr size_t WS_TOTAL = O_MERGED + al((size_t)TG * 1024 * 2);
constexpr size_t O_HALL = O_TR;
constexpr size_t O_SEGD = O_TR + al((size_t)T * 1024 * 2);
constexpr size_t O_Q = O_SEG;
constexpr size_t O_O = O_SEG + al((size_t)TG * 1024 * 2);
constexpr size_t O_U = O_SEG;
constexpr size_t O_ACT = O_SEG + al((size_t)TG * NFF2 * 2);
static_assert(O_ACT + (size_t)TG * DFF * 2 <= O_HGS, "U + ACT fit in SEG");
static_assert(O_SEGD + (size_t)T * 1024 * 2 <= WS_TOTAL, "front buffers fit in the transient region");
static_assert(WS_TOTAL <= ((size_t)1 << 30), "workspace fits 1 GiB");

constexpr int SMEM_BYTES = 163840;

struct Params {
  const float* in[39];
  float* out;
  char* ws;
};

DI int otid() { int t = threadIdx.x; asm volatile("" : "+v"(t)); return t; }
typedef __bf16 bf16x2_t __attribute__((ext_vector_type(2)));
typedef float f32x2_t __attribute__((ext_vector_type(2)));
DI unsigned pack2(float a, float b) { f32x2_t f = {a, b}; bf16x2_t r = __builtin_convertvector(f, bf16x2_t); return __builtin_bit_cast(unsigned, r); }
DI u16 f2bf(float x) { return (u16)(pack2(x, 0.f) & 0xffffu); }
DI float bf2f(u16 b) { return __uint_as_float(((unsigned)b) << 16); }
DI float bflo(unsigned u) { return __uint_as_float(u << 16); }
DI float bfhi(unsigned u) { return __uint_as_float(u & 0xffff0000u); }
DI float sigm(float x) { return __builtin_amdgcn_rcpf(1.f + __expf(-x)); }
DI float silu(float x) { return x * __builtin_amdgcn_rcpf(1.f + __expf(-x)); }
DI float wave_sum_slow(float v) {
#pragma unroll
  for (int o = 32; o > 0; o >>= 1) v += __shfl_xor(v, o);
  return v;
}
DI f32x4 mfma16(bf16x8 a, bf16x8 b, f32x4 c) { return __builtin_amdgcn_mfma_f32_16x16x32_bf16(a, b, c, 0, 0, 0); }
template <int CTRL> DI float dpp_mov(float x) {
  return __int_as_float(__builtin_amdgcn_update_dpp(0, __float_as_int(x), CTRL, 0xF, 0xF, true));
}
DI float red16(float x) {
  x += dpp_mov<0xB1>(x);
  x += dpp_mov<0x4E>(x);
  x += dpp_mov<0x141>(x);
  x += dpp_mov<0x140>(x);
  return x;
}
DI float wave_sum(float v) { v = red16(v); v += __shfl_xor(v, 16); v += __shfl_xor(v, 32); return v; }
DI void red16_2(float& a, float& b) {
  a += dpp_mov<0xB1>(a);  b += dpp_mov<0xB1>(b);
  a += dpp_mov<0x4E>(a);  b += dpp_mov<0x4E>(b);
  a += dpp_mov<0x141>(a); b += dpp_mov<0x141>(b);
  a += dpp_mov<0x140>(a); b += dpp_mov<0x140>(b);
}

#define XB_TMO      128
#define XB_XCNT(j)  (256  + 64 * (j))
#define XB_XSUB(j)  (1280 + 64 * (j))
#define XB_XGEN(j)  (2304 + 64 * (j))
#define XB_TOP      3328
#define XB_TOPGEN   3392
#define XCD_BAR_WORDS 3456
#define XB_SPIN_CAP (1u << 18)
#define LAS __attribute__((address_space(3)))
DI unsigned xb_ld(unsigned* p)              { return __hip_atomic_load(p, __ATOMIC_RELAXED, __HIP_MEMORY_SCOPE_AGENT); }
DI unsigned xb_add(unsigned* p, unsigned v) { return __hip_atomic_fetch_add(p, v, __ATOMIC_RELAXED, __HIP_MEMORY_SCOPE_AGENT); }
DI unsigned xb_xcc_id() { return (unsigned)__builtin_amdgcn_s_getreg((3 << 11) | 20) & 0xFu; }
#define XB_SPIN(cond, bar) do { unsigned _sp = 0; while (cond) { __builtin_amdgcn_s_sleep(1); \
    if ((++_sp & 255u) == 0u) { if (xb_ld(&(bar)[XB_TMO])) break; if (_sp > XB_SPIN_CAP) { atomicAdd(&(bar)[XB_TMO], 1u); break; } } } } while (0)
struct XcdBarrier { unsigned* bar; unsigned x; unsigned nloc, nx; };
DI XcdBarrier xcd_barrier_post(unsigned* bar) {
  XcdBarrier b; b.bar = bar; b.x = xb_xcc_id(); b.nloc = 0u; b.nx = 0u;
  if (threadIdx.x == 0) (void)xb_add(&bar[XB_XCNT(b.x)], 1u);
  return b;
}
DI void xcd_barrier_complete(unsigned* bar, unsigned x, unsigned& nloc, unsigned& nx) {
  const unsigned G = gridDim.x * gridDim.y * gridDim.z;
  unsigned sum, cnt, mine, sp = 0u;
  for (;;) {
    sum = 0u; cnt = 0u; mine = 0u;
#pragma unroll
    for (unsigned j = 0; j < 16; ++j) { const unsigned c = xb_ld(&bar[XB_XCNT(j)]); sum += c; cnt += (c > 0u) ? 1u : 0u; mine = (j == x) ? c : mine; }
    if (sum == G) break;
    __builtin_amdgcn_s_sleep(1);
    if ((++sp & 255u) == 0u) { if (xb_ld(&bar[XB_TMO])) break; if (sp > XB_SPIN_CAP) { atomicAdd(&bar[XB_TMO], 1u); break; } }
  }
  nloc = mine > 0u ? mine : 1u; nx = cnt > 0u ? cnt : 1u;
}
DI void xcd_barrier(XcdBarrier& b) {
  asm volatile("s_waitcnt vmcnt(0)" ::: "memory");
  __syncthreads();
  if (threadIdx.x == 0) {
    unsigned* bar = b.bar;
    __builtin_amdgcn_s_waitcnt(0);
    unsigned nloc = b.nloc, nx = b.nx;
    if (nloc == 0u) { xcd_barrier_complete(bar, b.x, nloc, nx); b.nloc = nloc; b.nx = nx; }
    const unsigned old = xb_add(&bar[XB_XSUB(b.x)], 1u);
    const unsigned gen = old / nloc;
    if (old + 1u == (gen + 1u) * nloc) {
      __builtin_amdgcn_fence(__ATOMIC_RELEASE, "agent");
      asm volatile("s_waitcnt vmcnt(0)" ::: "memory");
      const unsigned og = xb_add(&bar[XB_TOP], 1u);
      const unsigned tg = og / nx;
      if (og + 1u == (tg + 1u) * nx) xb_add(&bar[XB_TOPGEN], 1u);
      else XB_SPIN(xb_ld(&bar[XB_TOPGEN]) == tg, bar);
      __builtin_amdgcn_fence(__ATOMIC_ACQUIRE, "agent");
      xb_add(&bar[XB_XGEN(b.x)], 1u);
      asm volatile("s_waitcnt vmcnt(0)" ::: "memory");
    } else {
      XB_SPIN(xb_ld(&bar[XB_XGEN(b.x)]) == gen, bar);
      __builtin_amdgcn_fence(__ATOMIC_ACQUIRE, "agent");
      asm volatile("s_waitcnt vmcnt(0)" ::: "memory");
    }
  }
  __syncthreads();
}

DI int lds_byte2(int r, int c) {
  const int st = (r >> 4) * 2 + (c >> 5), ob = (r & 15) * 64 + (c & 31) * 2;
  return st * 1024 + (ob ^ (((ob >> 9) & 1) << 5));
}
typedef __attribute__((address_space(3))) unsigned* lds_u32_ptr;
template <int MI> struct GemmStage {
  static constexpr int AROWS = MI * 32, LA = AROWS / 128;
  static constexpr int A_BYTES = AROWS * 64, STAGE = A_BYTES + 256 * 64;
  static constexpr int LPS = LA + 2;
  unsigned aoff[LA], boff[2]; int wid;
  DI void init(long lda, long ldb) {
    const int tid = otid(), lane = tid & 63;
    wid = tid >> 6;
    const int sb = lane * 16, swz = sb ^ (((sb >> 9) & 1) << 5);
    const int rr = swz >> 6, cc = (swz & 63) >> 1;
#pragma unroll
    for (int i = 0; i < LA; ++i) aoff[i] = (unsigned)(((wid + 8 * i) * 16 + rr) * (int)lda + cc);
#pragma unroll
    for (int i = 0; i < 2; ++i) boff[i] = (unsigned)(((wid + 8 * i) * 16 + rr) * (int)ldb + cc);
  }
  DI void issue(const u16* __restrict__ A, const u16* __restrict__ Bt, int k0, char* buf) const {
#pragma unroll
    for (int i = 0; i < LA; ++i) __builtin_amdgcn_global_load_lds((const unsigned*)(A + aoff[i] + k0), (lds_u32_ptr)(buf + (wid + 8 * i) * 1024), 16, 0, 0);
#pragma unroll
    for (int i = 0; i < 2; ++i) __builtin_amdgcn_global_load_lds((const unsigned*)(Bt + boff[i] + k0), (lds_u32_ptr)(buf + A_BYTES + (wid + 8 * i) * 1024), 16, 0, 0);
  }
};
constexpr int NSTG = 5;
DI int ring_next(int b) { return (b + 1 == NSTG) ? 0 : b + 1; }
DI int ring_add(int b, int s) { int r = b + s; return (r >= NSTG) ? r - NSTG : r; }
template <int MI>
DI void gemm_issue0(const u16* __restrict__ A, long lda, const u16* __restrict__ Bt, long ldb, char* smem, int rb) {
  GemmStage<MI> gs; gs.init(lda, ldb);
#pragma unroll
  for (int s = 0; s < 4; ++s) gs.issue(A, Bt, s * 32, smem + ring_add(rb, s) * GemmStage<MI>::STAGE);
}
template <int MI>
DI void gemm_run(f32x4 (&acc)[MI][4], const u16* __restrict__ A, long lda, const u16* __restrict__ Bt, long ldb, int K, char* smem, bool preissued, int& rb) {
  constexpr int A_BYTES = GemmStage<MI>::A_BYTES, STAGE = GemmStage<MI>::STAGE, LPS = GemmStage<MI>::LPS;
  GemmStage<MI> gs; gs.init(lda, ldb);
  const int tid = otid(), lane = tid & 63, wid = tid >> 6, wr = wid >> 2, wc = wid & 3;
  const int li = lane & 15, lg = lane >> 4;
  const int fo = (li * 64 + lg * 16) ^ ((li >> 3) << 5);
  const int nk = K >> 5;
  if (!preissued) {
    __syncthreads();
#pragma unroll
    for (int s = 0; s < 4; ++s) gs.issue(A, Bt, s * 32, smem + ring_add(rb, s) * STAGE);
  }
  int cb = rb;
  for (int kk = 0; kk < nk; ++kk) {
    const int newer = nk - 1 - kk;
    if (newer == 0) asm volatile("s_waitcnt vmcnt(0)" ::: "memory");
    else if (newer == 1) asm volatile("s_waitcnt vmcnt(%0)" :: "n"(LPS) : "memory");
    else if (newer == 2) asm volatile("s_waitcnt vmcnt(%0)" :: "n"(2 * LPS) : "memory");
    else asm volatile("s_waitcnt vmcnt(%0)" :: "n"(3 * LPS) : "memory");
    asm volatile("s_waitcnt lgkmcnt(0)" ::: "memory");
    __builtin_amdgcn_s_barrier();
    asm volatile("" ::: "memory");
    char* cur = smem + cb * STAGE;
    {
      constexpr int NP = MI / 2;
      bf16x8 bq[4], ap[2][2];
      const char* aB = cur + (wr * MI) * 1024 + fo;
      const char* bB = cur + A_BYTES + (wc * 4) * 1024 + fo;
#pragma unroll
      for (int ni = 0; ni < 4; ++ni) bq[ni] = *(const bf16x8*)(bB + ni * 1024);
#pragma unroll
      for (int i = 0; i < 2; ++i) ap[0][i] = *(const bf16x8*)(aB + i * 1024);
      __builtin_amdgcn_sched_barrier(0);
      if (kk + 4 < nk) gs.issue(A, Bt, (kk + 4) << 5, smem + ring_add(cb, 4) * STAGE);
      __builtin_amdgcn_sched_barrier(0);
#pragma unroll
      for (int pp = 0; pp < NP; ++pp) {
        if (pp + 1 < NP) {
#pragma unroll
          for (int i = 0; i < 2; ++i) ap[(pp + 1) & 1][i] = *(const bf16x8*)(aB + (2 * (pp + 1) + i) * 1024);
        }
#pragma unroll
        for (int i = 0; i < 2; ++i)
#pragma unroll
          for (int ni = 0; ni < 4; ++ni) acc[2 * pp + i][ni] = mfma16(bq[ni], ap[pp & 1][i], acc[2 * pp + i][ni]);
        __builtin_amdgcn_sched_group_barrier(0x008, 1, 0);
        if (pp + 1 < NP) __builtin_amdgcn_sched_group_barrier(0x100, 2, 0);
        __builtin_amdgcn_sched_group_barrier(0x008, 7, 0);
        __builtin_amdgcn_sched_barrier(0);
      }
    }
    cb = ring_next(cb);
  }
  rb = cb;
}
template <int MI>
DI void gemm_main(f32x4 (&acc)[MI][4], const u16* __restrict__ A, long lda, const u16* __restrict__ Bt, long ldb, int K, char* smem) {
  int rb = 0;
  gemm_run<MI>(acc, A, lda, Bt, ldb, K, smem, false, rb);
}
template <int BH> struct TileWalk {
  int x, j, per, r, NT, total; bool plain;
  DI TileWalk(int MT, int NT_) : NT(NT_), total(MT * NT_) {
    plain = (gridDim.x & 7) != 0 || (MT % BH) != 0;
    x = blockIdx.x & 7; j = blockIdx.x >> 3; per = gridDim.x >> 3; r = 0;
  }
  DI bool next(int& mt, int& nt) {
    int tp;
    if (plain) tp = blockIdx.x + r * gridDim.x; else tp = (r * 8 + x) * per + j;
    ++r;
    if (tp >= total) return false;
    if (plain) { mt = tp / NT; nt = tp % NT; }
    else { const int band = tp / (BH * NT), idx = tp % (BH * NT); mt = band * BH + (idx % BH); nt = idx / BH; }
    return true;
  }
};
template <int MI> DI void zero_acc(f32x4 (&acc)[MI][4]) {
#pragma unroll
  for (int mi = 0; mi < MI; ++mi)
#pragma unroll
    for (int ni = 0; ni < 4; ++ni) acc[mi][ni] = f32x4{0.f, 0.f, 0.f, 0.f};
}
template <int MI, typename F> DI void epi_foreach(f32x4 (&acc)[MI][4], F&& f) {
  const int tid_ = otid(), lane_ = tid_ & 63, wid_ = tid_ >> 6, wr_ = wid_ >> 2, wc_ = wid_ & 3, li_ = lane_ & 15, lg_ = lane_ >> 4;
#pragma unroll
  for (int mi = 0; mi < MI; ++mi) {
    asm volatile("" ::: "memory");
#pragma unroll
    for (int ni = 0; ni < 4; ++ni) f(mi, ni, wr_ * (MI * 16) + mi * 16 + li_, wc_ * 64 + ni * 16 + lg_ * 4, acc[mi][ni]);
  }
}
DI u32x2 pack4(f32x4 v) { u32x2 o; o[0] = pack2(v[0], v[1]); o[1] = pack2(v[2], v[3]); return o; }

struct TrJob { const float* src; u16* dst; int K, N; };
DI TrJob tr_job(const Params& p, int j) {
  const int l = j / 11, w = j % 11;
  TrJob r;
  switch (w) {
    case 0: r = {p.in[4] + (size_t)l * E_WIN, (u16*)(p.ws + O_WIN) + (size_t)l * E_WIN, 1024, NIN}; break;
    case 1: r = {p.in[23] + (size_t)l * E_PA, (u16*)(p.ws + O_PA) + (size_t)l * E_PA, 256, 1024}; break;
    case 2: r = {p.in[24] + (size_t)l * E_PB, (u16*)(p.ws + O_PB) + (size_t)l * E_PB, 512, 1024}; break;
    case 3: r = {p.in[25] + (size_t)l * E_PC, (u16*)(p.ws + O_PC) + (size_t)l * E_PC, 256, 1024}; break;
    case 4: r = {p.in[26] + (size_t)l * E_PD, (u16*)(p.ws + O_PD) + (size_t)l * E_PD, 256, 1024}; break;
    case 5: r = {p.in[27] + (size_t)l * E_MIX, (u16*)(p.ws + O_MIX) + (size_t)l * E_MIX, 1024, 1024}; break;
    case 6: r = {p.in[30] + (size_t)l * E_MQ, (u16*)(p.ws + O_MQ) + (size_t)l * E_MQ, 1024, 1024}; break;
    case 7: r = {p.in[31] + (size_t)l * E_MKV, (u16*)(p.ws + O_MKV) + (size_t)l * E_MKV, 1024, 2048}; break;
    case 8: r = {p.in[32] + (size_t)l * E_MO, (u16*)(p.ws + O_MO) + (size_t)l * E_MO, 1024, 1024}; break;
    case 9: r = {p.in[34] + (size_t)l * E_FIN, (u16*)(p.ws + O_FIN) + (size_t)l * E_FIN, 1024, NFF2}; break;
    default: r = {p.in[37] + (size_t)l * E_FOUT, (u16*)(p.ws + O_FOUT) + (size_t)l * E_FOUT, DFF, 1024}; break;
  }
  return r;
}
DI int tr_tiles(int w) {
  switch (w) {
    case 0: return 16 * 156; case 1: return 4 * 16; case 2: return 8 * 16; case 3: return 4 * 16; case 4: return 4 * 16;
    case 5: return 256; case 6: return 256; case 7: return 16 * 32; case 8: return 256; case 9: return 16 * 88; default: return 44 * 16;
  }
}
constexpr int TR_TILES_L = 16 * 156 + 64 + 128 + 64 + 64 + 256 * 3 + 512 + 16 * 88 + 44 * 16;

DI void transpose_tile(const TrJob& jb, int tile, char* smem) {
  float* ts = (float*)smem;
  const int ntn = jb.N >> 6;
  const int k0 = (tile / ntn) << 6, n0 = (tile % ntn) << 6;
  const int tid = otid(), a = tid >> 6, b = tid & 63;
  __syncthreads();
#pragma unroll
  for (int i = 0; i < 8; ++i) { int k = i * 8 + a; ts[k * 65 + b] = jb.src[(size_t)(k0 + k) * jb.N + n0 + b]; }
  __syncthreads();
#pragma unroll
  for (int i = 0; i < 8; ++i) { int n = i * 8 + a; jb.dst[(size_t)(n0 + n) * jb.K + k0 + b] = f2bf(ts[b * 65 + n]); }
}

DI void sincos_acc(float ang, float& c, float& s) {
  double a = (double)ang;
  const double TWO_PI = 6.283185307179586476925;
  double n = rint(a / TWO_PI);
  double r = a - n * TWO_PI;
  double r2 = r * r;
  double sn = 0.0, cs = 0.0;
  double ts = r, tc = 1.0;
#pragma unroll
  for (int k = 0; k < 13; ++k) {
    cs += tc; sn += ts;
    tc = -tc * r2 / (double)((2 * k + 1) * (2 * k + 2));
    ts = -ts * r2 / (double)((2 * k + 2) * (2 * k + 3));
  }
  c = (float)cs; s = (float)sn;
}

DI void norm_row_bf16(const float* __restrict__ xr, const float* __restrict__ g, u16* __restrict__ outr, int lane) {
  float4 v[4]; float ss = 0.f;
#pragma unroll
  for (int i = 0; i < 4; ++i) { v[i] = ((const float4*)xr)[i * 64 + lane]; ss += v[i].x * v[i].x + v[i].y * v[i].y + v[i].z * v[i].z + v[i].w * v[i].w; }
  ss = wave_sum(ss);
  const float rstd = 1.0f / sqrtf(ss * (1.f / 1024.f) + EPS);
#pragma unroll
  for (int i = 0; i < 4; ++i) {
    float4 gg = ((const float4*)g)[i * 64 + lane];
    u32x2 o; o[0] = pack2(v[i].x * rstd * gg.x, v[i].y * rstd * gg.y); o[1] = pack2(v[i].z * rstd * gg.z, v[i].w * rstd * gg.w);
    *(u32x2*)(outr + (i * 64 + lane) * 4) = o;
  }
}

DI void phase_prologue(const Params& p, char* smem) {
  const int tid = otid(), lane = tid & 63, wave = tid >> 6;
  if (blockIdx.x == 0) {
    ((int*)(p.ws + O_CNT))[tid] = 0;
    if (tid < NL) {
      const float* lv = p.in[5] + tid * 256;
      float s1 = 0.f, s2 = 0.f;
      for (int i = 0; i < 64; ++i) { s1 += lv[i] * lv[64 + i]; s2 += lv[128 + i] * lv[192 + i]; }
      const float lam_init = (tid == 0) ? 0.2f : 0.355509067591f;
      ((float*)(p.ws + O_SCAL))[tid] = expf(s1) - expf(s2) + lam_init;
    }
  }
  for (int t = blockIdx.x; t < NL * TR_TILES_L; t += gridDim.x) {
    int l = t / TR_TILES_L, r = t % TR_TILES_L, w = 0;
    for (; w < 10; ++w) { int n = tr_tiles(w); if (r < n) break; r -= n; }
    TrJob jb = tr_job(p, l * 11 + w);
    transpose_tile(jb, r, smem);
  }
  {
    const int* pos = (const int*)p.in[2];
    float* tab = (float*)(p.ws + O_ROPE);
    for (int idx = blockIdx.x * NTH + tid; idx < T * 8; idx += gridDim.x * NTH) {
      const int t = idx >> 3, i = idx & 7;
      float invf;
      switch (i) {
        case 0: invf = 1.0f; break; case 1: invf = 0.1939227432012558f; break; case 2: invf = 0.03760603070259094f; break;
        case 3: invf = 0.007292664609849453f; break; case 4: invf = 0.0014142135623842478f; break; case 5: invf = 0.00027424818836152554f; break;
        case 6: invf = 5.3182957344688475e-05f; break; default: invf = 1.0313385246263351e-05f; break;
      }
      const float ang = (float)pos[t] * invf;
      float c, s; sincos_acc(ang, c, s);
      tab[t * 16 + i] = c; tab[t * 16 + 8 + i] = s;
    }
  }
  for (int row = blockIdx.x * 8 + wave; row < NL * 4096; row += gridDim.x * 8) {
    const int l = row >> 12, r = row & 4095;
    norm_row_bf16(p.in[1] + (size_t)r * 1024, p.in[29] + l * 1024, (u16*)(p.ws + O_MEMN) + (size_t)row * 1024, lane);
  }
}

DI void phase_kv_gemm(const Params& p, char* smem) {
  for (int t = blockIdx.x; t < NL * 16 * 8; t += gridDim.x) {
    const int l = t >> 7, r = t & 127, mt = r >> 3, nt = r & 7;
    f32x4 acc[8][4]; zero_acc<8>(acc);
    const u16* A = (const u16*)(p.ws + O_MEMN) + (size_t)l * 4096 * 1024 + (size_t)mt * 256 * 1024;
    const u16* B = (const u16*)(p.ws + O_MKV) + (size_t)l * E_MKV + (size_t)nt * 256 * 1024;
    gemm_main<8>(acc, A, 1024, B, 1024, 1024, smem);
    u16* C = (u16*)(p.ws + O_KV) + (size_t)l * 4096 * 2048 + (size_t)mt * 256 * 2048 + nt * 256;
    epi_foreach<8>(acc, [&](int mi, int ni, int r, int c, f32x4& v) { *(u32x2*)(C + (unsigned)(r * 2048 + c)) = pack4(v); });
  }
}

DI void phase_norm(const float* __restrict__ X, const float* __restrict__ g, u16* __restrict__ H, int rows) {
  const int tid = otid(), lane = tid & 63, wave = tid >> 6;
  for (int row = blockIdx.x * 8 + wave; row < rows; row += gridDim.x * 8)
    norm_row_bf16(X + (size_t)row * 1024, g, H + (size_t)row * 1024, lane);
}

DI void phase_final_norm(float* X, const float* __restrict__ g) {
  const int tid = otid(), lane = tid & 63, wave = tid >> 6;
  for (int row = blockIdx.x * 8 + wave; row < T; row += gridDim.x * 8) {
    float* xr = X + (size_t)row * 1024;
    float4 v[4]; float ss = 0.f;
#pragma unroll
    for (int i = 0; i < 4; ++i) { v[i] = ((const float4*)xr)[i * 64 + lane]; ss += v[i].x * v[i].x + v[i].y * v[i].y + v[i].z * v[i].z + v[i].w * v[i].w; }
    ss = wave_sum(ss);
    const float rstd = 1.0f / sqrtf(ss * (1.f / 1024.f) + EPS);
#pragma unroll
    for (int i = 0; i < 4; ++i) {
      float4 gg = ((const float4*)g)[i * 64 + lane];
      float4 o; o.x = v[i].x * rstd * gg.x; o.y = v[i].y * rstd * gg.y; o.z = v[i].z * rstd * gg.z; o.w = v[i].w * rstd * gg.w;
      ((float4*)xr)[i * 64 + lane] = o;
    }
  }
}

DI void phase_gemm1(const Params& p, int l, int grp, char* smem) {
  const u16* H = (const u16*)(p.ws + O_H);
  const u16* W = (const u16*)(p.ws + O_WIN) + (size_t)l * E_WIN;
  u16* SEG = (u16*)(p.ws + O_SEG);
  const float* tab = (const float*)(p.ws + O_ROPE) + (size_t)grp * TG * 16;
  constexpr int NT = NSG / 256;
  TileWalk<4> tw(TG / 256, NT);
  int mt = 0, nt = 0;
  bool have = tw.next(mt, nt);
  int rb = 0;
  if (have) { __syncthreads(); gemm_issue0<8>(H + (size_t)mt * 256 * 1024, 1024, W + (size_t)((nt < 19) ? nt * 256 : (nt + 4) * 256) * 1024, 1024, smem, rb); }
  while (have) {
    const int wrow = (nt < 19) ? nt * 256 : (nt + 4) * 256;
    f32x4 acc[8][4]; zero_acc<8>(acc);
    gemm_run<8>(acc, H + (size_t)mt * 256 * 1024, 1024, W + (size_t)wrow * 1024, 1024, 1024, smem, true, rb);
    int mt2 = 0, nt2 = 0;
    const bool have2 = tw.next(mt2, nt2);
    if (have2) gemm_issue0<8>(H + (size_t)mt2 * 256 * 1024, 1024, W + (size_t)((nt2 < 19) ? nt2 * 256 : (nt2 + 4) * 256) * 1024, 1024, smem, rb);
    u16* segb = SEG + (size_t)mt * 256 * NSG + nt * 256;
    const float* tabb = tab + (size_t)mt * 256 * 16;
    {
      const int tid_ = otid(), lane_ = tid_ & 63, wid_ = __builtin_amdgcn_readfirstlane(tid_ >> 6), wr_ = wid_ >> 2, wc_ = wid_ & 3;
      const int li_ = lane_ & 15, lg_ = lane_ >> 4;
#pragma unroll
      for (int ni = 0; ni < 4; ++ni) {
        const int cb = nt * 256 + wc_ * 64 + ni * 16;
        bool rot = false; float scale = 1.f;
        if (cb < 2304) { const int jj = (cb % 768) >> 8; rot = (jj < 2); if (jj == 0) scale = 0.125f; }
        else if (cb < 3840) { const int c2 = cb - 2304; rot = (c2 < 1024); if (c2 < 512) scale = 0.125f; }
        rot = rot && (ni == 0);
        const bool gate = (cb >= GOFF);
        const int c = wc_ * 64 + ni * 16 + lg_ * 4;
#pragma unroll
        for (int mi = 0; mi < 8; ++mi) {
          if ((mi & 1) == 0) asm volatile("" ::: "memory");
          const int r = wr_ * 128 + mi * 16 + li_;
          f32x4 o = acc[mi][ni];
          if (rot) {
            f32x4 other;
            other[0] = __shfl_xor(o[0], 32); other[1] = __shfl_xor(o[1], 32); other[2] = __shfl_xor(o[2], 32); other[3] = __shfl_xor(o[3], 32);
            const f32x4 cs = *(const f32x4*)(tabb + (unsigned)(r * 16 + (lg_ & 1) * 4));
            const f32x4 sn = *(const f32x4*)(tabb + (unsigned)(r * 16 + 8 + (lg_ & 1) * 4));
            o = (lg_ < 2) ? (o * cs - other * sn) : (o * cs + other * sn);
          }
          if (gate) { o[0] = sigm(o[0]); o[1] = sigm(o[1]); o[2] = sigm(o[2]); o[3] = sigm(o[3]); }
          *(u32x2*)(segb + (unsigned)(r * NSG + c)) = pack4(o * scale);
        }
      }
    }
    mt = mt2; nt = nt2; have = have2;
  }
}

template <int DK> struct TileRegs {
  static constexpr int CPR = DK / 8, NCH = (64 * CPR) / NTH;
  u32x4 r[NCH];
  DI void load(const u16* __restrict__ src, long row_stride, int tid) {
#pragma unroll
    for (int i = 0; i < NCH; ++i) { const int c = tid + NTH * i, row = c / CPR, kc = c % CPR; r[i] = *(const u32x4*)(src + (long)row * row_stride + kc * 8); }
  }
  DI void store(char* dst, int pad, int tid) const {
    const int rs = DK * 2 + pad;
#pragma unroll
    for (int i = 0; i < NCH; ++i) { const int c = tid + NTH * i, row = c / CPR, kc = c % CPR; *(u32x4*)(dst + row * rs + kc * 16) = r[i]; }
  }
};
template <int DK>
DI void attn_scores(f32x4 (&Sa)[4], const bf16x8 (&Qf)[DK / 32], const char* Ks, int li, int lg) {
  constexpr int RS = DK * 2 + 16, NKS = DK / 32;
  const char* kb = Ks + li * RS + lg * 16;
  if (DK == 64) {
    bf16x8 kf[4][NKS];
#pragma unroll
    for (int ksub = 0; ksub < 4; ++ksub)
#pragma unroll
      for (int ks = 0; ks < NKS; ++ks) kf[ksub][ks] = *(const bf16x8*)(kb + ksub * 16 * RS + ks * 64);
#pragma unroll
    for (int ks = 0; ks < NKS; ++ks)
#pragma unroll
      for (int ksub = 0; ksub < 4; ++ksub) Sa[ksub] = mfma16(kf[ksub][ks], Qf[ks], Sa[ksub]);
    __builtin_amdgcn_sched_group_barrier(0x100, 4 * NKS, 0);
    __builtin_amdgcn_sched_group_barrier(0x008, 4 * NKS, 0);
    __builtin_amdgcn_sched_barrier(0);
  } else {
    constexpr int HK = NKS / 2;
    bf16x8 kf[2][HK];
#pragma unroll
    for (int ks = 0; ks < HK; ++ks) kf[0][ks] = *(const bf16x8*)(kb + ks * 64);
#pragma unroll
    for (int g = 0; g < 8; ++g) {
      const int ksub = g >> 1, hf = g & 1;
      if (g + 1 < 8) {
        const int ks2 = (g + 1) >> 1, hf2 = (g + 1) & 1;
#pragma unroll
        for (int ks = 0; ks < HK; ++ks) kf[(g + 1) & 1][ks] = *(const bf16x8*)(kb + ks2 * 16 * RS + (hf2 * HK + ks) * 64);
      }
#pragma unroll
      for (int ks = 0; ks < HK; ++ks) Sa[ksub] = mfma16(kf[g & 1][ks], Qf[hf * HK + ks], Sa[ksub]);
      __builtin_amdgcn_sched_group_barrier(0x008, 1, 0);
      if (g + 1 < 8) __builtin_amdgcn_sched_group_barrier(0x100, HK, 0);
      __builtin_amdgcn_sched_group_barrier(0x008, HK - 1, 0);
      __builtin_amdgcn_sched_barrier(0);
    }
  }
}
DI void softmax_step(f32x4 (&Sa)[4], float& m, float& l, float& alpha, bf16x8 (&P)[2]) {
  float mx = -INFINITY;
#pragma unroll
  for (int ksub = 0; ksub < 4; ++ksub)
#pragma unroll
    for (int j = 0; j < 4; ++j) mx = fmaxf(mx, Sa[ksub][j]);
  mx = fmaxf(mx, __shfl_xor(mx, 16));
  mx = fmaxf(mx, __shfl_xor(mx, 32));
  const float mn = fmaxf(m, mx);
  const float ms = (mn == -INFINITY) ? 0.f : mn;
  alpha = __expf(m - ms);
  float ps = 0.f;
#pragma unroll
  for (int ksub = 0; ksub < 4; ++ksub)
#pragma unroll
    for (int j = 0; j < 4; ++j) { const float e = __expf(Sa[ksub][j] - ms); ps += e; Sa[ksub][j] = e; }
  l = l * alpha + ps;
  m = mn;
#pragma unroll
  for (int kp = 0; kp < 2; ++kp) {
    u32x4 u;
    u[0] = pack2(Sa[2 * kp][0], Sa[2 * kp][1]); u[1] = pack2(Sa[2 * kp][2], Sa[2 * kp][3]);
    u[2] = pack2(Sa[2 * kp + 1][0], Sa[2 * kp + 1][1]); u[3] = pack2(Sa[2 * kp + 1][2], Sa[2 * kp + 1][3]);
    P[kp] = __builtin_bit_cast(bf16x8, u);
  }
}
typedef __attribute__((address_space(3))) s16x4* lds_s16x4_ptr;
template <int DV, int NMAP>
DI void attn_pv_pipe(f32x4 (&O1)[DV / 16], f32x4 (&O2)[DV / 16], const bf16x8 (&P1)[2], const bf16x8 (&P2)[2], float a1, float a2,
                     const char* Vs, int li, int lg) {
  constexpr int RS = DV * 2 + 32, NB = DV / 16, NC = NB / 2;
#pragma unroll
  for (int dt = 0; dt < NB; ++dt) { O1[dt] *= a1; if (NMAP == 2) O2[dt] *= a2; }
  const char* b0 = Vs + (lg * 4 + (li >> 2)) * RS + (li & 3) * 8;
  s16x4 vlo[2][2][2], vhi[2][2][2];
#pragma unroll
  for (int dtl = 0; dtl < 2; ++dtl)
#pragma unroll
    for (int kp = 0; kp < 2; ++kp) {
      const char* b = b0 + kp * 32 * RS + dtl * 32;
      vlo[0][dtl][kp] = __builtin_amdgcn_ds_read_tr16_b64_v4i16((lds_s16x4_ptr)(b));
      vhi[0][dtl][kp] = __builtin_amdgcn_ds_read_tr16_b64_v4i16((lds_s16x4_ptr)(b + 16 * RS));
    }
#pragma unroll
  for (int c = 0; c < NC; ++c) {
    if (c + 1 < NC) {
#pragma unroll
      for (int dtl = 0; dtl < 2; ++dtl)
#pragma unroll
        for (int kp = 0; kp < 2; ++kp) {
          const char* b = b0 + kp * 32 * RS + (2 * (c + 1) + dtl) * 32;
          vlo[(c + 1) & 1][dtl][kp] = __builtin_amdgcn_ds_read_tr16_b64_v4i16((lds_s16x4_ptr)(b));
          vhi[(c + 1) & 1][dtl][kp] = __builtin_amdgcn_ds_read_tr16_b64_v4i16((lds_s16x4_ptr)(b + 16 * RS));
        }
    }
#pragma unroll
    for (int dtl = 0; dtl < 2; ++dtl)
#pragma unroll
      for (int kp = 0; kp < 2; ++kp) {
        const bf16x8 vf = __builtin_shufflevector(vlo[c & 1][dtl][kp], vhi[c & 1][dtl][kp], 0, 1, 2, 3, 4, 5, 6, 7);
        O1[2 * c + dtl] = mfma16(vf, P1[kp], O1[2 * c + dtl]);
        if (NMAP == 2) O2[2 * c + dtl] = mfma16(vf, P2[kp], O2[2 * c + dtl]);
      }
    __builtin_amdgcn_sched_group_barrier(0x008, 1, 0);
    if (c + 1 < NC) __builtin_amdgcn_sched_group_barrier(0x100, 8, 0);
    __builtin_amdgcn_sched_group_barrier(0x008, 4 * NMAP - 1, 0);
    __builtin_amdgcn_sched_barrier(0);
  }
}
template <int DV>
DI void attn_pv(f32x4 (&O)[DV / 16], const bf16x8 (&P)[2], float alpha, const char* Vs, int li, int lg) {
  attn_pv_pipe<DV, 1>(O, O, P, P, alpha, alpha, Vs, li, lg);
}

DI void dil_attn_item(const Params& p, int item, char* smem) {
  const int blk = item & 31, h = (item >> 5) & 3, gb = item >> 7, g = gb % 3, bl = gb / 3;
  const int dil = (g == 0) ? 1 : (g == 1 ? 4 : 16);
  const int nb = 32 / dil, r = blk / nb, n = blk % nb;
  const int tid = otid(), lane = tid & 63, wave = tid >> 6, li = lane & 15, lg = lane >> 4;
  const u16* SEG = (const u16*)(p.ws + O_SEG);
  const long tok0 = (long)bl * S;
  const int qcol = g * 768 + h * 64, kcol = qcol + 256, vcol = qcol + 512;
  const int qi = wave * 16 + li;
  const long qtok = tok0 + (long)(n * 128 + qi) * dil + r;
  bf16x8 Qf[2];
#pragma unroll
  for (int ks = 0; ks < 2; ++ks) Qf[ks] = *(const bf16x8*)(SEG + qtok * NSG + qcol + ks * 32 + lg * 8);
  f32x4 O[4];
  float m = -INFINITY, l = 0.f, alpha;
#pragma unroll
  for (int dt = 0; dt < 4; ++dt) O[dt] = f32x4{0.f, 0.f, 0.f, 0.f};
  char* Ks = smem; char* Vs = smem + 64 * 144;
  const int kt0 = (n == 0) ? 2 : 0;
  TileRegs<64> rk, rv;
  {
    const long s0 = (long)((n - 1) * 128 + kt0 * 64) * dil + r;
    rk.load(SEG + (tok0 + s0) * NSG + kcol, (long)dil * NSG, tid);
    rv.load(SEG + (tok0 + s0) * NSG + vcol, (long)dil * NSG, tid);
  }
  for (int kt = kt0; kt < 4; ++kt) {
    __syncthreads();
    rk.store(Ks, 16, tid); rv.store(Vs, 32, tid);
    __syncthreads();
    if (kt + 1 < 4) {
      const long s0 = (long)((n - 1) * 128 + (kt + 1) * 64) * dil + r;
      rk.load(SEG + (tok0 + s0) * NSG + kcol, (long)dil * NSG, tid);
      rv.load(SEG + (tok0 + s0) * NSG + vcol, (long)dil * NSG, tid);
    }
    const int qlo = wave * 16, klo = kt * 64;
    if (klo + 63 >= qlo && klo <= qlo + 15 + 128) {
      f32x4 Sa[4];
#pragma unroll
      for (int ks = 0; ks < 4; ++ks) Sa[ks] = f32x4{0.f, 0.f, 0.f, 0.f};
      attn_scores<64>(Sa, Qf, Ks, li, lg);
#pragma unroll
      for (int ksub = 0; ksub < 4; ++ksub)
#pragma unroll
        for (int j = 0; j < 4; ++j) {
          const int kj = klo + ksub * 16 + lg * 4 + j;
          const int dist = qi + 128 - kj;
          if (dist < 0 || dist > 128) Sa[ksub][j] = -INFINITY;
        }
      bf16x8 P[2];
      softmax_step(Sa, m, l, alpha, P);
      attn_pv<64>(O, P, alpha, Vs, li, lg);
    }
  }
  u16* OG = (u16*)(p.ws + O_OG);
  float* LSE = (float*)(p.ws + O_LSE);
  float lt = l; lt += __shfl_xor(lt, 16); lt += __shfl_xor(lt, 32);
  const float inv = 1.f / lt;
#pragma unroll
  for (int dt = 0; dt < 4; ++dt) {
    u32x2 o; o[0] = pack2(O[dt][0] * inv, O[dt][1] * inv); o[1] = pack2(O[dt][2] * inv, O[dt][3] * inv);
    *(u32x2*)(OG + qtok * 768 + g * 256 + h * 64 + dt * 16 + lg * 4) = o;
  }
  if (lg == 0) LSE[qtok * 12 + g * 4 + h] = m + __logf(lt);
}

DI void diff_attn_item(const Params& p, int l_, int item, char* smem) {
  const int n = 31 - (item & 31), h = (item >> 5) & 3, bl = item >> 7;
  const int tid = otid(), lane = tid & 63, wave = tid >> 6, li = lane & 15, lg = lane >> 4;
  const u16* SEG = (const u16*)(p.ws + O_SEG);
  const long tok0 = (long)bl * S;
  const int qcol = 2304 + h * 128, kcol = 2304 + 512 + h * 128, vcol = 2304 + 1024 + h * 128;
  const int qlo = n * 128 + wave * 16;
  const int q = qlo + li;
  bf16x8 Q1[2], Q2[2];
#pragma unroll
  for (int ks = 0; ks < 2; ++ks) {
    Q1[ks] = *(const bf16x8*)(SEG + (tok0 + q) * NSG + qcol + ks * 32 + lg * 8);
    Q2[ks] = *(const bf16x8*)(SEG + (tok0 + q) * NSG + qcol + 64 + ks * 32 + lg * 8);
  }
  f32x4 O1[8], O2[8];
  float m1 = -INFINITY, l1 = 0.f, m2 = -INFINITY, l2 = 0.f, alpha;
#pragma unroll
  for (int dt = 0; dt < 8; ++dt) { O1[dt] = f32x4{0.f, 0.f, 0.f, 0.f}; O2[dt] = f32x4{0.f, 0.f, 0.f, 0.f}; }
  char* K1s = smem; char* K2s = smem + 9216; char* Vs = smem + 18432;
  TileRegs<64> rk1, rk2; TileRegs<128> rv;
  rk1.load(SEG + tok0 * NSG + kcol, NSG, tid);
  rk2.load(SEG + tok0 * NSG + kcol + 64, NSG, tid);
  rv.load(SEG + tok0 * NSG + vcol, NSG, tid);
  const int nt = 2 * n + 2;
  for (int kt = 0; kt < nt; ++kt) {
    __syncthreads();
    rk1.store(K1s, 16, tid); rk2.store(K2s, 16, tid); rv.store(Vs, 32, tid);
    __syncthreads();
    if (kt + 1 < nt) {
      const long kr = tok0 + (kt + 1) * 64;
      rk1.load(SEG + kr * NSG + kcol, NSG, tid);
      rk2.load(SEG + kr * NSG + kcol + 64, NSG, tid);
      rv.load(SEG + kr * NSG + vcol, NSG, tid);
    }
    const int klo = kt * 64;
    if (klo <= qlo + 15) {
      const bool need_mask = (klo + 63 > qlo);
      bf16x8 P[2], Pb[2];
      float alpha2;
      f32x4 Sa[4], Sb[4];
#pragma unroll
      for (int ks = 0; ks < 4; ++ks) { Sa[ks] = f32x4{0.f, 0.f, 0.f, 0.f}; Sb[ks] = f32x4{0.f, 0.f, 0.f, 0.f}; }
      attn_scores<64>(Sa, Q1, K1s, li, lg);
      attn_scores<64>(Sb, Q2, K2s, li, lg);
      if (need_mask) {
#pragma unroll
        for (int ksub = 0; ksub < 4; ++ksub)
#pragma unroll
          for (int j = 0; j < 4; ++j) if (klo + ksub * 16 + lg * 4 + j > q) { Sa[ksub][j] = -INFINITY; Sb[ksub][j] = -INFINITY; }
      }
      softmax_step(Sa, m1, l1, alpha, P);
      softmax_step(Sb, m2, l2, alpha2, Pb);
      attn_pv_pipe<128, 2>(O1, O2, P, Pb, alpha, alpha2, Vs, li, lg);
    }
  }
  float lt1 = l1; lt1 += __shfl_xor(lt1, 16); lt1 += __shfl_xor(lt1, 32);
  float lt2 = l2; lt2 += __shfl_xor(lt2, 16); lt2 += __shfl_xor(lt2, 32);
  const float lam = ((const float*)(p.ws + O_SCAL))[l_];
  const float lam_init = (l_ == 0) ? 0.2f : 0.355509067591f;
  const float i1 = 1.f / lt1, i2 = lam / lt2;
  float ss = 0.f;
#pragma unroll
  for (int dt = 0; dt < 8; ++dt)
#pragma unroll
    for (int j = 0; j < 4; ++j) { const float o = O1[dt][j] * i1 - O2[dt][j] * i2; O1[dt][j] = o; ss += o * o; }
  ss += __shfl_xor(ss, 16); ss += __shfl_xor(ss, 32);
  const float rstd = (1.f - lam_init) / sqrtf(ss * (1.f / 128.f) + EPS);
  const float* ng = p.in[6] + l_ * 128;
  u16* Y = (u16*)(p.ws + O_Y);
#pragma unroll
  for (int dt = 0; dt < 8; ++dt) {
    const int dv = dt * 16 + lg * 4;
    const float4 gg = *(const float4*)(ng + dv);
    u32x2 o; o[0] = pack2(O1[dt][0] * rstd * gg.x, O1[dt][1] * rstd * gg.y); o[1] = pack2(O1[dt][2] * rstd * gg.z, O1[dt][3] * rstd * gg.w);
    *(u32x2*)(Y + (tok0 + q) * YW + 256 + h * 128 + dv) = o;
  }
}

DI void cross_attn_item(const Params& p, int l_, int grp, int item, char* smem) {
  const int qb = item & 31, hm = (item >> 5) & 3, bl = item >> 7;
  const int tid = otid(), lane = tid & 63, wave = tid >> 6, li = lane & 15, lg = lane >> 4;
  const u16* Q = (const u16*)(p.ws + O_Q);
  const u16* KV = (const u16*)(p.ws + O_KV) + (size_t)l_ * 4096 * 2048 + (size_t)(grp * BG + bl) * 256 * 2048;
  const long tok = (long)bl * S + qb * 128 + wave * 16 + li;
  bf16x8 Qf[8];
#pragma unroll
  for (int ks = 0; ks < 8; ++ks) Qf[ks] = *(const bf16x8*)(Q + tok * 1024 + hm * 256 + ks * 32 + lg * 8);
  f32x4 O[16];
#pragma unroll
  for (int dt = 0; dt < 16; ++dt) O[dt] = f32x4{0.f, 0.f, 0.f, 0.f};
  float m = -INFINITY, l = 0.f, alpha;
  char* Ks = smem; char* Vs = smem + 64 * 528;
  TileRegs<256> rk, rv;
  rk.load(KV + hm * 256, 2048, tid);
  rv.load(KV + 1024 + hm * 256, 2048, tid);
  for (int kt = 0; kt < 4; ++kt) {
    __syncthreads();
    rk.store(Ks, 16, tid); rv.store(Vs, 32, tid);
    __syncthreads();
    if (kt + 1 < 4) {
      rk.load(KV + (size_t)((kt + 1) * 64) * 2048 + hm * 256, 2048, tid);
      rv.load(KV + (size_t)((kt + 1) * 64) * 2048 + 1024 + hm * 256, 2048, tid);
    }
    f32x4 Sa[4];
#pragma unroll
    for (int ks = 0; ks < 4; ++ks) Sa[ks] = f32x4{0.f, 0.f, 0.f, 0.f};
    attn_scores<256>(Sa, Qf, Ks, li, lg);
    bf16x8 P[2];
    softmax_step(Sa, m, l, alpha, P);
    attn_pv<256>(O, P, alpha, Vs, li, lg);
  }
  float lt = l; lt += __shfl_xor(lt, 16); lt += __shfl_xor(lt, 32);
  const float inv = 1.f / lt;
  u16* OB = (u16*)(p.ws + O_O);
#pragma unroll
  for (int dt = 0; dt < 16; ++dt) {
    u32x2 o; o[0] = pack2(O[dt][0] * inv, O[dt][1] * inv); o[1] = pack2(O[dt][2] * inv, O[dt][3] * inv);
    *(u32x2*)(OB + tok * 1024 + hm * 256 + dt * 16 + lg * 4) = o;
  }
}

template <int PASS>
DI void hgrn_item(const Params& p, int l_, int item, char* smem) {
  const int c = item & 31, h = (item >> 5) & 3, bl = item >> 7;
  const int tid = otid(), v = tid & 63, kq = tid >> 6;
  float* sF = (float*)smem;
  float* sK = sF + 1024;
  float* sQ = sK + 1024;
  float* sI = sQ + 1024;
  float* sG = sI + 1024;
  float* sO = sG + 1024;
  const u16* SEG = (const u16*)(p.ws + O_SEG);
  float* HGS = (float*)(p.ws + O_HGS);
  float* HGF = (float*)(p.ws + O_HGF);
  const int arr = tid >> 7, stok = (tid >> 3) & 15, sch = tid & 7;
  const bool ld_on = (PASS == 3) || (arr == 1) || (arr == 2);
  const u16* sbase = SEG + ((size_t)bl * S + c * 128 + stok) * NSG + 3840 + arr * 256 + h * 64 + sch * 8;
  float lbv[8];
#pragma unroll
  for (int e = 0; e < 8; ++e) {
    lbv[e] = 0.f;
    if (l_ == 1) { const float* lg0 = p.in[7]; const int k = h * 64 + sch * 8 + e; lbv[e] = 1.f / (1.f + __expf(lg0[k] - lg0[256 + k])); }
  }
  u32x4 pre = u32x4{0u, 0u, 0u, 0u};
  if (ld_on) pre = *(const u32x4*)sbase;
  float s[8], Fp[8];
#pragma unroll
  for (int e = 0; e < 8; ++e) { s[e] = 0.f; Fp[e] = 1.f; }
  if (PASS == 3) {
#pragma unroll 4
    for (int cc = 0; cc < c; ++cc) {
      const size_t it = (size_t)((bl * 4 + h) * 32 + cc);
      const float* st = HGS + it * 4096;
      const float* ff = HGF + it * 64;
#pragma unroll
      for (int e = 0; e < 8; ++e) { const int k = kq * 8 + e; s[e] = ff[k] * s[e] + st[k * 64 + v]; }
    }
  }
#pragma unroll 1
  for (int sub = 0; sub < 8; ++sub) {
    const int t0 = c * 128 + sub * 16;
    __syncthreads();
    if (ld_on) {
      float x[8];
      x[0] = bflo(pre[0]); x[1] = bfhi(pre[0]); x[2] = bflo(pre[1]); x[3] = bfhi(pre[1]);
      x[4] = bflo(pre[2]); x[5] = bfhi(pre[2]); x[6] = bflo(pre[3]); x[7] = bfhi(pre[3]);
      const int o = stok * 64 + sch * 8;
      if (arr == 1) {
#pragma unroll
        for (int e = 0; e < 8; ++e) { sF[o + e] = lbv[e] + (1.f - lbv[e]) * sigm(x[e]); sK[o + e] = (1.f - lbv[e]) * sigm(-x[e]); }
      } else if (arr == 2) {
#pragma unroll
        for (int e = 0; e < 8; ++e) sI[o + e] = x[e];
      } else if (arr == 0) {
#pragma unroll
        for (int e = 0; e < 8; ++e) sQ[o + e] = silu(x[e]);
      } else {
#pragma unroll
        for (int e = 0; e < 8; ++e) sG[o + e] = silu(x[e]);
      }
    }
    __syncthreads();
    if (ld_on && sub + 1 < 8) pre = *(const u32x4*)(sbase + (size_t)(sub + 1) * 16 * NSG);
    {
      float ivn = sI[v];
      float4 fn[2], kn[2], qn[2];
#pragma unroll
      for (int e4 = 0; e4 < 2; ++e4) {
        fn[e4] = *(const float4*)(sF + kq * 8 + e4 * 4); kn[e4] = *(const float4*)(sK + kq * 8 + e4 * 4);
        if (PASS == 3) qn[e4] = *(const float4*)(sQ + kq * 8 + e4 * 4);
      }
#pragma unroll 4
      for (int tt = 0; tt < 16; ++tt) {
        const float iv = ivn;
        float4 fc[2], kc[2], qc[2];
#pragma unroll
        for (int e4 = 0; e4 < 2; ++e4) { fc[e4] = fn[e4]; kc[e4] = kn[e4]; if (PASS == 3) qc[e4] = qn[e4]; }
        {
          const int tn = (tt + 1) & 15;
          ivn = sI[tn * 64 + v];
#pragma unroll
          for (int e4 = 0; e4 < 2; ++e4) {
            fn[e4] = *(const float4*)(sF + tn * 64 + kq * 8 + e4 * 4); kn[e4] = *(const float4*)(sK + tn * 64 + kq * 8 + e4 * 4);
            if (PASS == 3) qn[e4] = *(const float4*)(sQ + tn * 64 + kq * 8 + e4 * 4);
          }
        }
        __builtin_amdgcn_sched_barrier(0);
        float o = 0.f;
#pragma unroll
        for (int e4 = 0; e4 < 2; ++e4) {
          const float4 f4 = fc[e4], k4 = kc[e4];
          s[e4 * 4 + 0] = f4.x * s[e4 * 4 + 0] + k4.x * iv;
          s[e4 * 4 + 1] = f4.y * s[e4 * 4 + 1] + k4.y * iv;
          s[e4 * 4 + 2] = f4.z * s[e4 * 4 + 2] + k4.z * iv;
          s[e4 * 4 + 3] = f4.w * s[e4 * 4 + 3] + k4.w * iv;
          if (PASS == 1) { Fp[e4 * 4 + 0] *= f4.x; Fp[e4 * 4 + 1] *= f4.y; Fp[e4 * 4 + 2] *= f4.z; Fp[e4 * 4 + 3] *= f4.w; }
          if (PASS == 3) {
            const float4 q4 = qc[e4];
            o += s[e4 * 4 + 0] * q4.x + s[e4 * 4 + 1] * q4.y + s[e4 * 4 + 2] * q4.z + s[e4 * 4 + 3] * q4.w;
          }
        }
        if (PASS == 3) sO[(tt * 8 + kq) * 64 + v] = o;
        __builtin_amdgcn_sched_barrier(0);
      }
    }
    if (PASS == 3) {
      __syncthreads();
      u16* Y = (u16*)(p.ws + O_Y);
      const float* ng = p.in[8] + l_ * 64;
#pragma unroll
      for (int i = 0; i < 2; ++i) {
        const int tt = i * 8 + kq;
        float o = 0.f;
#pragma unroll
        for (int qq = 0; qq < 8; ++qq) o += sO[(tt * 8 + qq) * 64 + v];
        const float ss = wave_sum(o * o);
        const float rstd = 1.0f / sqrtf(ss * (1.f / 64.f) + EPS);
        const size_t tok = (size_t)bl * S + t0 + tt;
        Y[tok * YW + 768 + h * 64 + v] = f2bf(o * rstd * ng[v] * sG[tt * 64 + v]);
      }
    }
  }
  if (PASS == 1) {
#pragma unroll
    for (int e = 0; e < 8; ++e) {
      HGS[(size_t)item * 4096 + (kq * 8 + e) * 64 + v] = s[e];
      if (v == 0) HGF[(size_t)item * 64 + kq * 8 + e] = Fp[e];
    }
  }
}

DI void rwkv_prep_item(const Params& p, int l_, int item, char* smem) {
  const int tid = otid(), lane = tid & 63, wave = tid >> 6, c = tid & 255, half = tid >> 8;
  float* lin = (float*)smem;
  float* vv = lin + 4096;
  float* t1 = vv + 4096;
  float* sV1 = t1 + 512;
  const u16* SEGD = (const u16*)(p.ws + O_SEGD);
  const float* mu = p.in[9] + l_ * 1024;
  const size_t tokb = (size_t)item * 16 + half * 8;
  u16* VF = (u16*)(p.ws + O_VFIRST);
  float xr[8], xk[8];
  float vfv[8];
  __syncthreads();
  {
    const float mr = mu[c], mk = mu[256 + c], mv = mu[512 + c], ml = mu[768 + c];
    u16 raw[9][4];
    const bool first0 = ((tokb & (S - 1)) == 0);
#pragma unroll
    for (int rr = 0; rr < 9; ++rr) {
      const u16* row = SEGD + (tokb + rr - 1) * 1024;
      if (rr == 0 && first0) { raw[rr][0] = 0; raw[rr][1] = 0; raw[rr][2] = 0; raw[rr][3] = 0; }
      else { raw[rr][0] = row[c]; raw[rr][1] = row[256 + c]; raw[rr][2] = row[512 + c]; raw[rr][3] = row[768 + c]; }
    }
    if (l_ == 1) {
#pragma unroll
      for (int tk = 0; tk < 8; ++tk) vfv[tk] = bf2f(VF[(tokb + tk) * 256 + c]);
      const float4* v1 = (const float4*)p.in[21];
#pragma unroll
      for (int i = 0; i < 4; ++i) ((float4*)sV1)[tid + NTH * i] = v1[tid + NTH * i];
    }
#pragma unroll
    for (int tk = 0; tk < 8; ++tk) {
      float a, b;
      a = bf2f(raw[tk + 1][0]); b = bf2f(raw[tk][0]); xr[tk] = a + (b - a) * mr;
      a = bf2f(raw[tk + 1][1]); b = bf2f(raw[tk][1]); xk[tk] = a + (b - a) * mk;
      a = bf2f(raw[tk + 1][2]); b = bf2f(raw[tk][2]); const float xv_ = a + (b - a) * mv;
      a = bf2f(raw[tk + 1][3]); b = bf2f(raw[tk][3]);
      float x = a + (b - a) * ml;
      if (c < 64) x = 1.f - 2.f / (__expf(2.f * x) + 1.f);
      else if (c >= 128) x = sigm(x);
      lin[(half * 8 + tk) * 256 + c] = x;
      vv[(half * 8 + tk) * 256 + c] = xv_;
    }
  }
  __syncthreads();
  float lw[8], la[8], lgg[8];
#pragma unroll
  for (int tk = 0; tk < 8; ++tk) { lw[tk] = 0.f; la[tk] = 0.f; lgg[tk] = 0.f; }
  const float* w2 = p.in[11] + l_ * 64 * 256;
  const float* a2 = p.in[13] + l_ * 64 * 256;
  const float* g2 = p.in[14] + l_ * 128 * 256;
  float wn[16];
#pragma unroll
  for (int j = 0; j < 16; ++j) wn[j] = w2[j * 256 + c];
#pragma unroll 1
  for (int ch = 0; ch < 16; ++ch) {
    float wr[16];
#pragma unroll
    for (int j = 0; j < 16; ++j) wr[j] = wn[j];
    if (ch + 1 < 16) {
      const int cn = ch + 1;
      const float* wsrc = (cn < 4) ? (w2 + cn * 16 * 256) : (cn < 8 ? (a2 + (cn - 4) * 16 * 256) : (g2 + (cn - 8) * 16 * 256));
#pragma unroll
      for (int j = 0; j < 16; ++j) wn[j] = wsrc[j * 256 + c];
    }
#pragma unroll
    for (int tk = 0; tk < 8; ++tk) {
      float acc = 0.f;
#pragma unroll
      for (int j4 = 0; j4 < 4; ++j4) {
        const float4 x4 = *(const float4*)(lin + (half * 8 + tk) * 256 + ch * 16 + j4 * 4);
        acc += x4.x * wr[j4 * 4] + x4.y * wr[j4 * 4 + 1] + x4.z * wr[j4 * 4 + 2] + x4.w * wr[j4 * 4 + 3];
      }
      if (ch < 4) lw[tk] += acc; else if (ch < 8) la[tk] += acc; else lgg[tk] += acc;
    }
  }
  float vmixw[8];
  if (l_ == 1) {
    {
      const int tk = tid >> 5, j0 = tid & 31;
      float a0 = 0.f, a1 = 0.f;
#pragma unroll 8
      for (int cc = 0; cc < 256; cc += 2) { a0 += vv[tk * 256 + cc] * sV1[cc * 32 + j0]; a1 += vv[tk * 256 + cc + 1] * sV1[(cc + 1) * 32 + j0]; }
      t1[tk * 32 + j0] = a0 + a1;
    }
    const float* v2 = p.in[22];
    float wr[32];
#pragma unroll
    for (int j = 0; j < 32; ++j) wr[j] = v2[j * 256 + c];
    __syncthreads();
#pragma unroll
    for (int tk = 0; tk < 8; ++tk) {
      float acc = 0.f;
#pragma unroll
      for (int j4 = 0; j4 < 8; ++j4) {
        const float4 x4 = *(const float4*)(t1 + (half * 8 + tk) * 32 + j4 * 4);
        acc += x4.x * wr[j4 * 4] + x4.y * wr[j4 * 4 + 1] + x4.z * wr[j4 * 4 + 2] + x4.w * wr[j4 * 4 + 3];
      }
      vmixw[tk] = acc;
    }
  }
  const float w0 = p.in[10][l_ * 256 + c], a0 = p.in[12][l_ * 256 + c];
  const float k_k = p.in[15][l_ * 256 + c], k_a = p.in[16][l_ * 256 + c], r_k = p.in[17][l_ * 256 + c];
  const float v0 = (l_ == 1) ? p.in[20][c] : 0.f;
  u16* RWR = (u16*)(p.ws + O_RWR); u16* RWK = (u16*)(p.ws + O_RWK); u16* RWV = (u16*)(p.ws + O_RWV);
  u16* RWKK = (u16*)(p.ws + O_RWKK); u16* RWKKA = (u16*)(p.ws + O_RWKKA); u16* RWG = (u16*)(p.ws + O_RWG);
  float* RWW = (float*)(p.ws + O_RWW); float* RWRK = (float*)(p.ws + O_RWRK);
#pragma unroll
  for (int tk = 0; tk < 8; ++tk) {
    const size_t tok = tokb + tk;
    const float xv_ = vv[(half * 8 + tk) * 256 + c];
    const float u = w0 + lw[tk];
    const float z = -u;
    const float sp = fmaxf(z, 0.f) + __logf(1.f + __expf(-fabsf(z)));
    const float wv = -sp - 0.5f;
    const float decay = __expf(-__expf(wv));
    const float a = sigm(a0 + la[tk]);
    const float kkx = xk[tk] * k_k;
    const float nrm = sqrtf(wave_sum(kkx * kkx));
    const float kkn = kkx / fmaxf(nrm, 1e-12f);
    const float k2 = xk[tk] * (1.f + (a - 1.f) * k_a);
    float v2v = xv_;
    if (l_ == 0) VF[tok * 256 + c] = f2bf(v2v);
    else v2v = v2v + (vfv[tk] - v2v) * sigm(v0 + vmixw[tk]);
    const float rk = wave_sum(xr[tk] * k2 * r_k);
    RWR[tok * 256 + c] = f2bf(xr[tk]);
    RWK[tok * 256 + c] = f2bf(k2);
    RWV[tok * 256 + c] = f2bf(v2v);
    RWKK[tok * 256 + c] = f2bf(kkn);
    RWKKA[tok * 256 + c] = f2bf(kkn * a);
    RWG[tok * 256 + c] = f2bf(lgg[tk]);
    RWW[tok * 256 + c] = decay;
    if (lane == 0) RWRK[tok * 4 + (wave & 3)] = rk;
  }
}

DI void rwkv_scan_item(const Params& p, int item, char* smem) {
  const int rg = item & 1, h = (item >> 1) & 3, b = item >> 3;
  const int tid = otid(), lane = tid & 63, wave = tid >> 6, kap = lane & 15, rho = lane >> 4;
  const int rowh = rg * 32 + wave * 4 + rho;
  float* sW = (float*)smem;
  float* sKK = sW + 2048;
  float* sKA = sKK + 2048;
  float* sK = sKA + 2048;
  float* sR = sK + 2048;
  float* sV = sR + 2048;
  float* sY = sV + 2048;
  const float* RWW = (const float*)(p.ws + O_RWW);
  const u16* RWR = (const u16*)(p.ws + O_RWR); const u16* RWK = (const u16*)(p.ws + O_RWK); const u16* RWV = (const u16*)(p.ws + O_RWV);
  const u16* RWKK = (const u16*)(p.ws + O_RWKK); const u16* RWKKA = (const u16*)(p.ws + O_RWKKA);
  float* RWY = (float*)(p.ws + O_RWY);
  const size_t tokb = (size_t)b * S;
  u32x4 pw, pa, pb, pv;
  const int wtok = tid >> 4, wch = tid & 15;
  const int hsel = tid >> 8, btok = (tid & 255) >> 3, bch = tid & 7;
  const u16* arrA = hsel ? RWKKA : RWKK;
  const u16* arrB = hsel ? RWR : RWK;
  float* dstA = hsel ? sKA : sKK;
  float* dstB = hsel ? sR : sK;
  const float sgnA = hsel ? 1.f : -1.f;
  pv = u32x4{0u, 0u, 0u, 0u};
  float S0 = 0.f, S1 = 0.f, S2 = 0.f, S3 = 0.f;
  {
    pw = *(const u32x4*)(RWW + (tokb + wtok) * 256 + h * 64 + wch * 4);
    const size_t off = (tokb + btok) * 256 + h * 64 + bch * 8;
    pa = *(const u32x4*)(arrA + off); pb = *(const u32x4*)(arrB + off);
    if (hsel == 0) pv = *(const u32x4*)(RWV + off);
  }
#pragma unroll 1
  for (int c = 0; c < S / 32; ++c) {
    __syncthreads();
    *(u32x4*)(sW + wtok * 64 + wch * 4) = pw;
    {
      float* da = dstA + btok * 64 + bch * 8; float* db = dstB + btok * 64 + bch * 8;
      *(f32x4*)(da) = f32x4{bflo(pa[0]) * sgnA, bfhi(pa[0]) * sgnA, bflo(pa[1]) * sgnA, bfhi(pa[1]) * sgnA};
      *(f32x4*)(da + 4) = f32x4{bflo(pa[2]) * sgnA, bfhi(pa[2]) * sgnA, bflo(pa[3]) * sgnA, bfhi(pa[3]) * sgnA};
      *(f32x4*)(db) = f32x4{bflo(pb[0]), bfhi(pb[0]), bflo(pb[1]), bfhi(pb[1])};
      *(f32x4*)(db + 4) = f32x4{bflo(pb[2]), bfhi(pb[2]), bflo(pb[3]), bfhi(pb[3])};
      if (hsel == 0) {
        float* dv = sV + btok * 64 + bch * 8;
        *(f32x4*)(dv) = f32x4{bflo(pv[0]), bfhi(pv[0]), bflo(pv[1]), bfhi(pv[1])};
        *(f32x4*)(dv + 4) = f32x4{bflo(pv[2]), bfhi(pv[2]), bflo(pv[3]), bfhi(pv[3])};
      }
    }
    __syncthreads();
    if (c + 1 < S / 32) {
      const size_t t0 = tokb + (size_t)(c + 1) * 32;
      pw = *(const u32x4*)(RWW + (t0 + wtok) * 256 + h * 64 + wch * 4);
      const size_t off = (t0 + btok) * 256 + h * 64 + bch * 8;
      pa = *(const u32x4*)(arrA + off); pb = *(const u32x4*)(arrB + off);
      if (hsel == 0) pv = *(const u32x4*)(RWV + off);
    }
    f32x4 w4n = *(const f32x4*)(sW + kap * 4), nk4n = *(const f32x4*)(sKK + kap * 4), ka4n = *(const f32x4*)(sKA + kap * 4);
    f32x4 k4n = *(const f32x4*)(sK + kap * 4), r4n = *(const f32x4*)(sR + kap * 4);
    float vvn = sV[rowh];
    f32x4 rprev = f32x4{0.f, 0.f, 0.f, 0.f};
#pragma unroll 4
    for (int tt = 0; tt < 32; ++tt) {
      const f32x4 w4 = w4n, nk4 = nk4n, ka4 = ka4n, k4 = k4n, r4 = r4n;
      const float vv = vvn;
      {
        const int tn = (tt + 1) & 31;
        w4n = *(const f32x4*)(sW + tn * 64 + kap * 4); nk4n = *(const f32x4*)(sKK + tn * 64 + kap * 4); ka4n = *(const f32x4*)(sKA + tn * 64 + kap * 4);
        k4n = *(const f32x4*)(sK + tn * 64 + kap * 4); r4n = *(const f32x4*)(sR + tn * 64 + kap * 4);
        vvn = sV[tn * 64 + rowh];
      }
      __builtin_amdgcn_sched_barrier(0);
      float sa, y;
      float u0, u1, u2, u3;
      {
        float a1 = S0 * nk4[0], b1 = S0 * rprev[0];
        float a2 = S2 * nk4[2], b2 = S2 * rprev[2];
        a1 = fmaf(S1, nk4[1], a1); b1 = fmaf(S1, rprev[1], b1);
        a2 = fmaf(S3, nk4[3], a2); b2 = fmaf(S3, rprev[3], b2);
        sa = a1 + a2; y = b1 + b2;
        u0 = vv * k4[0]; u1 = vv * k4[1];
        sa += dpp_mov<0xB1>(sa);  y += dpp_mov<0xB1>(y);
        u2 = vv * k4[2]; u3 = vv * k4[3];
        sa += dpp_mov<0x4E>(sa);  y += dpp_mov<0x4E>(y);
        u0 = fmaf(S0, w4[0], u0); u1 = fmaf(S1, w4[1], u1);
        sa += dpp_mov<0x141>(sa); y += dpp_mov<0x141>(y);
        u2 = fmaf(S2, w4[2], u2); u3 = fmaf(S3, w4[3], u3);
        sa += dpp_mov<0x140>(sa); y += dpp_mov<0x140>(y);
      }
      if (tt > 0 && kap == 0) sY[(tt - 1) * 32 + wave * 4 + rho] = y;
      S0 = fmaf(sa, ka4[0], u0);
      S1 = fmaf(sa, ka4[1], u1);
      S2 = fmaf(sa, ka4[2], u2);
      S3 = fmaf(sa, ka4[3], u3);
      rprev = r4;
      __builtin_amdgcn_sched_barrier(0);
    }
    {
      float y = (S0 * rprev[0] + S1 * rprev[1]) + (S2 * rprev[2] + S3 * rprev[3]);
      y = red16(y);
      if (kap == 0) sY[31 * 32 + wave * 4 + rho] = y;
    }
    __syncthreads();
    {
      const size_t t0 = tokb + (size_t)c * 32;
#pragma unroll
      for (int i = 0; i < 2; ++i) {
        const int idx = tid + NTH * i, tt = idx >> 5, rr = idx & 31;
        RWY[(t0 + tt) * 256 + h * 64 + rg * 32 + rr] = sY[idx];
      }
    }
  }
}

DI void rwkv_post_item(const Params& p, int l_, int item) {
  const int tid = otid(), lane = tid & 63, wave = tid >> 6, hd = lane >> 4, c = hd * 64 + (lane & 15) * 4;
  const float* RWY = (const float*)(p.ws + O_RWY);
  const float* RWRK = (const float*)(p.ws + O_RWRK);
  const u16* RWV = (const u16*)(p.ws + O_RWV); const u16* RWG = (const u16*)(p.ws + O_RWG);
  u16* YD = (u16*)(p.ws + O_YD);
  const f32x4 lg = *(const f32x4*)(p.in[18] + l_ * 256 + c), lb = *(const f32x4*)(p.in[19] + l_ * 256 + c);
#pragma unroll 1
  for (int ps = 0; ps < 2; ++ps) {
    f32x4 y[4]; u32x2 v2[4], g2[4]; float rk[4];
#pragma unroll
    for (int u = 0; u < 4; ++u) {
      const size_t tok = (size_t)item * 64 + (ps * 4 + u) * 8 + wave;
      y[u] = *(const f32x4*)(RWY + tok * 256 + c);
      v2[u] = *(const u32x2*)(RWV + tok * 256 + c); g2[u] = *(const u32x2*)(RWG + tok * 256 + c);
      rk[u] = RWRK[tok * 4 + hd];
    }
#pragma unroll
    for (int u = 0; u < 4; ++u) {
      const size_t tok = (size_t)item * 64 + (ps * 4 + u) * 8 + wave;
      const float mean = red16((y[u][0] + y[u][1]) + (y[u][2] + y[u][3])) * (1.f / 64.f);
      const f32x4 d = y[u] - mean;
      const float var = red16((d[0] * d[0] + d[1] * d[1]) + (d[2] * d[2] + d[3] * d[3])) * (1.f / 64.f);
      const float rs = 1.0f / sqrtf(var + 64e-5f);
      f32x4 o;
      o[0] = (d[0] * rs * lg[0] + lb[0] + rk[u] * bflo(v2[u][0])) * bflo(g2[u][0]);
      o[1] = (d[1] * rs * lg[1] + lb[1] + rk[u] * bfhi(v2[u][0])) * bfhi(g2[u][0]);
      o[2] = (d[2] * rs * lg[2] + lb[2] + rk[u] * bflo(v2[u][1])) * bflo(g2[u][1]);
      o[3] = (d[3] * rs * lg[3] + lb[3] + rk[u] * bfhi(v2[u][1])) * bfhi(g2[u][1]);
      *(u32x2*)(YD + tok * 256 + c) = pack4(o);
    }
  }
}

DI void dil_combine_item(const Params& p, int item) {
  const int tid = otid(), ch = tid & 31, tl = tid >> 5, h = ch >> 3;
  const u16* OG = (const u16*)(p.ws + O_OG);
  const float* LSE = (const float*)(p.ws + O_LSE);
  u16* Y = (u16*)(p.ws + O_Y);
  u32x4 o0[4], o1[4], o2[4]; float l0[4], l1[4], l2[4];
#pragma unroll
  for (int ps = 0; ps < 4; ++ps) {
    const size_t tok = (size_t)item * 64 + ps * 16 + tl;
    o0[ps] = *(const u32x4*)(OG + tok * 768 + ch * 8);
    o1[ps] = *(const u32x4*)(OG + tok * 768 + 256 + ch * 8);
    o2[ps] = *(const u32x4*)(OG + tok * 768 + 512 + ch * 8);
    l0[ps] = LSE[tok * 12 + h]; l1[ps] = LSE[tok * 12 + 4 + h]; l2[ps] = LSE[tok * 12 + 8 + h];
  }
#pragma unroll
  for (int ps = 0; ps < 4; ++ps) {
    const size_t tok = (size_t)item * 64 + ps * 16 + tl;
    const float mx = fmaxf(l0[ps], fmaxf(l1[ps], l2[ps]));
    float e0 = __expf(l0[ps] - mx), e1 = __expf(l1[ps] - mx), e2 = __expf(l2[ps] - mx);
    const float inv = 1.f / (e0 + e1 + e2);
    e0 *= inv; e1 *= inv; e2 *= inv;
    u32x4 r;
#pragma unroll
    for (int q = 0; q < 4; ++q)
      r[q] = pack2(e0 * bflo(o0[ps][q]) + e1 * bflo(o1[ps][q]) + e2 * bflo(o2[ps][q]), e0 * bfhi(o0[ps][q]) + e1 * bfhi(o1[ps][q]) + e2 * bfhi(o2[ps][q]));
    *(u32x4*)(Y + tok * YW + ch * 8) = r;
  }
}

DI int next_item(int* counter, int* s_item) {
  __syncthreads();
  if (otid() == 0) *s_item = atomicAdd(counter, 1);
  __syncthreads();
  return *s_item;
}
constexpr int N_DIL = BG * 3 * 4 * 32, N_HG = BG * 4 * 32;
constexpr int N_SCAN = NB * 8, N_DIFF = BG * 4 * 32, N_COMB = TG / 64;

DI void phase_stage1(const Params& p, int l, int grp, char* smem, int* s_item) {
  int* counter = (int*)(p.ws + O_CNT) + (l * NGRP + grp) * 2;
  const int nscan = (grp == 0) ? N_SCAN : 0;
  for (;;) {
    int it = next_item(counter, s_item);
    if (it >= nscan + N_DIFF + N_DIL + N_HG) break;
    if (it < nscan) { rwkv_scan_item(p, it, smem); continue; }
    it -= nscan;
    if (it < N_DIFF) { diff_attn_item(p, l, it, smem); continue; }
    it -= N_DIFF;
    if (it < N_DIL) dil_attn_item(p, it, smem);
    else hgrn_item<1>(p, l, it - N_DIL, smem);
  }
}
DI void phase_stage2(const Params& p, int l, int grp, char* smem, int* s_item) {
  int* counter = (int*)(p.ws + O_CNT) + (l * NGRP + grp) * 2 + 1;
  for (;;) {
    int it = next_item(counter, s_item);
    if (it >= N_HG + N_COMB) break;
    if (it < N_HG) hgrn_item<3>(p, l, it, smem);
    else dil_combine_item(p, it - N_HG);
  }
}

DI void phase_merge(const Params& p, int l, int grp, char* smem) {
  const u16* Y = (const u16*)(p.ws + O_Y);
  const u16* YD = (const u16*)(p.ws + O_YD) + (size_t)grp * TG * 256;
  const u16* SEG = (const u16*)(p.ws + O_SEG);
  u16* MG = (u16*)(p.ws + O_MERGED);
  TileWalk<8> tw(TG / 128, 4);
  for (int mt, nt; tw.next(mt, nt);) {
    f32x4 accm[4][4]; zero_acc<4>(accm);
#pragma unroll 1
    for (int i = 0; i < 4; ++i) {
      f32x4 accp[4][4];
      zero_acc<4>(accp);
      const u16* Pi; const u16* Ai; int Ki, lda;
      if (i == 0) { Pi = (const u16*)(p.ws + O_PA) + (size_t)l * E_PA; Ki = 256; Ai = Y + (size_t)mt * 128 * YW; lda = YW; }
      else if (i == 1) { Pi = (const u16*)(p.ws + O_PB) + (size_t)l * E_PB; Ki = 512; Ai = Y + (size_t)mt * 128 * YW + 256; lda = YW; }
      else if (i == 2) { Pi = (const u16*)(p.ws + O_PC) + (size_t)l * E_PC; Ki = 256; Ai = Y + (size_t)mt * 128 * YW + 768; lda = YW; }
      else { Pi = (const u16*)(p.ws + O_PD) + (size_t)l * E_PD; Ki = 256; Ai = YD + (size_t)mt * 128 * 256; lda = 256; }
      gemm_main<4>(accp, Ai, lda, Pi + (size_t)(nt * 256) * Ki, Ki, Ki, smem);
      int mt2 = mt; asm volatile("" : "+s"(mt2));
      const u16* gb = SEG + (size_t)mt2 * 128 * NSG + GOFF + i * 1024 + nt * 256;
      epi_foreach<4>(accp, [&](int mi, int ni, int r, int c, f32x4& v) {
        const u32x2 g = *(const u32x2*)(gb + (unsigned)(r * NSG + c));
        accm[mi][ni][0] += bflo(g[0]) * v[0]; accm[mi][ni][1] += bfhi(g[0]) * v[1];
        accm[mi][ni][2] += bflo(g[1]) * v[2]; accm[mi][ni][3] += bfhi(g[1]) * v[3];
      });
    }
    u16* mgb = MG + (size_t)mt * 128 * 1024 + nt * 256;
    epi_foreach<4>(accm, [&](int mi, int ni, int r, int c, f32x4& v) { *(u32x2*)(mgb + (unsigned)(r * 1024 + c)) = pack4(v); });
  }
}

enum { EPI_RESID = 0, EPI_BF16 = 1 };
template <int KIND>
DI void phase_gemm(const u16* A, int lda, const u16* Wt, int K, int N, int rows, const float* xin, float* xout, u16* cb, int ldc, float scale, char* smem) {
  const int NT = N / 256;
  TileWalk<4> tw(rows / 256, NT);
  int mt = 0, nt = 0;
  bool have = tw.next(mt, nt);
  int rb = 0;
  if (have) { __syncthreads(); gemm_issue0<8>(A + (size_t)mt * 256 * lda, lda, Wt + (size_t)nt * 256 * K, K, smem, rb); }
  while (have) {
    f32x4 acc[8][4]; zero_acc<8>(acc);
    gemm_run<8>(acc, A + (size_t)mt * 256 * lda, lda, Wt + (size_t)nt * 256 * K, K, K, smem, true, rb);
    int mt2 = 0, nt2 = 0;
    const bool have2 = tw.next(mt2, nt2);
    if (have2) gemm_issue0<8>(A + (size_t)mt2 * 256 * lda, lda, Wt + (size_t)nt2 * 256 * K, K, smem, rb);
    if (KIND == EPI_RESID) {
      const float* xib = xin + (size_t)mt * 256 * 1024 + nt * 256;
      float* xob = xout + (size_t)mt * 256 * 1024 + nt * 256;
      epi_foreach<8>(acc, [&](int mi, int ni, int r, int c, f32x4& v) {
        const unsigned o = (unsigned)(r * 1024 + c);
        const f32x4 x = *(const f32x4*)(xib + o);
        *(f32x4*)(xob + o) = x + v;
      });
    } else {
      u16* cbb = cb + (size_t)mt * 256 * ldc + nt * 256;
      epi_foreach<8>(acc, [&](int mi, int ni, int r, int c, f32x4& v) { *(u32x2*)(cbb + (unsigned)(r * ldc + c)) = pack4(v * scale); });
    }
    mt = mt2; nt = nt2; have = have2;
  }
}

DI void phase_cross(const Params& p, int l, int grp, char* smem) {
  const u16* H = (const u16*)(p.ws + O_H);
  const u16* WQ = (const u16*)(p.ws + O_MQ) + (size_t)l * E_MQ;
  u16* Q = (u16*)(p.ws + O_Q);
  for (int it = blockIdx.x; it < BG * 4 * 32; it += gridDim.x) {
    const int qb = it & 31, hm = (it >> 5) & 3, bl = it >> 7;
    const size_t row0 = (size_t)bl * S + qb * 128;
    f32x4 acc[4][4]; zero_acc<4>(acc);
    gemm_main<4>(acc, H + row0 * 1024, 1024, WQ + (size_t)hm * 256 * 1024, 1024, 1024, smem);
    u16* qbase = Q + row0 * 1024 + hm * 256;
    epi_foreach<4>(acc, [&](int mi, int ni, int r, int c, f32x4& v) { *(u32x2*)(qbase + (unsigned)(r * 1024 + c)) = pack4(v * 0.0625f); });
    __threadfence_block();
    __syncthreads();
    cross_attn_item(p, l, grp, it, smem);
  }
}

DI void phase_convact(const Params& p, int l) {
  const u16* U = (const u16*)(p.ws + O_U);
  u16* ACT = (u16*)(p.ws + O_ACT);
  const float* cw = p.in[35] + (size_t)l * 3 * NFF2;
  const float* cbias = p.in[36] + (size_t)l * NFF2;
  constexpr int CH = DFF / 8;
  const int tid = otid();
#pragma unroll 1
  for (int idx = blockIdx.x * NTH + tid; idx < (TG / 8) * CH; idx += gridDim.x * NTH) {
    const int run = idx / CH, ch = idx - run * CH;
    const int tok0 = run * 8, s0 = tok0 & (S - 1);
    u32x4 ug[10], uv[10];
#pragma unroll
    for (int rr = 0; rr < 10; ++rr) {
      if (rr < 2 && s0 == 0) { ug[rr] = u32x4{0u, 0u, 0u, 0u}; uv[rr] = u32x4{0u, 0u, 0u, 0u}; }
      else {
        const u16* row = U + (size_t)(tok0 + rr - 2) * NFF2;
        ug[rr] = *(const u32x4*)(row + ch * 8); uv[rr] = *(const u32x4*)(row + DFF + ch * 8);
      }
    }
    float wg[3][8], wv[3][8], bg[8], bv[8];
#pragma unroll
    for (int jj = 0; jj < 3; ++jj)
#pragma unroll
      for (int e4 = 0; e4 < 2; ++e4) {
        const float4 a = *(const float4*)(cw + jj * NFF2 + ch * 8 + e4 * 4), b = *(const float4*)(cw + jj * NFF2 + DFF + ch * 8 + e4 * 4);
        wg[jj][e4 * 4] = a.x; wg[jj][e4 * 4 + 1] = a.y; wg[jj][e4 * 4 + 2] = a.z; wg[jj][e4 * 4 + 3] = a.w;
        wv[jj][e4 * 4] = b.x; wv[jj][e4 * 4 + 1] = b.y; wv[jj][e4 * 4 + 2] = b.z; wv[jj][e4 * 4 + 3] = b.w;
      }
#pragma unroll
    for (int e4 = 0; e4 < 2; ++e4) {
      const float4 a = *(const float4*)(cbias + ch * 8 + e4 * 4), b = *(const float4*)(cbias + DFF + ch * 8 + e4 * 4);
      bg[e4 * 4] = a.x; bg[e4 * 4 + 1] = a.y; bg[e4 * 4 + 2] = a.z; bg[e4 * 4 + 3] = a.w;
      bv[e4 * 4] = b.x; bv[e4 * 4 + 1] = b.y; bv[e4 * 4 + 2] = b.z; bv[e4 * 4 + 3] = b.w;
    }
#pragma unroll
    for (int t = 0; t < 8; ++t) {
      u32x4 o;
#pragma unroll
      for (int e2 = 0; e2 < 4; ++e2) {
        float g0 = bg[2 * e2], g1 = bg[2 * e2 + 1], v0 = bv[2 * e2], v1 = bv[2 * e2 + 1];
#pragma unroll
        for (int jj = 0; jj < 3; ++jj) {
          g0 += bflo(ug[t + jj][e2]) * wg[jj][2 * e2]; g1 += bfhi(ug[t + jj][e2]) * wg[jj][2 * e2 + 1];
          v0 += bflo(uv[t + jj][e2]) * wv[jj][2 * e2]; v1 += bfhi(uv[t + jj][e2]) * wv[jj][2 * e2 + 1];
        }
        o[e2] = pack2(silu(g0) * v0, silu(g1) * v1);
      }
      *(u32x4*)(ACT + (size_t)(tok0 + t) * DFF + ch * 8) = o;
    }
  }
}

__global__ void __launch_bounds__(NTH, 2) fwd_megakernel(Params p) {
  cg::grid_group grid = cg::this_grid();
  __shared__ __attribute__((aligned(1024))) char smem[SMEM_BYTES];
  int& s_item = *(int*)(smem + SMEM_BYTES - 64);
  XcdBarrier xb = xcd_barrier_post((unsigned*)(p.ws + O_XBAR));

  phase_prologue(p, smem);
  grid.sync();
  phase_kv_gemm(p, smem);

#pragma unroll 1
  for (int l = 0; l < NL; ++l) {
    xcd_barrier(xb);
    phase_norm((l == 0) ? p.in[0] : (const float*)p.out, p.in[3] + l * 1024, (u16*)(p.ws + O_HALL), T);
    xcd_barrier(xb);
    phase_gemm<EPI_BF16>((const u16*)(p.ws + O_HALL), 1024, (const u16*)(p.ws + O_WIN) + (size_t)l * E_WIN + (size_t)4864 * 1024, 1024, 1024, T,
                         nullptr, nullptr, (u16*)(p.ws + O_SEGD), 1024, 1.f, smem);
    xcd_barrier(xb);
    for (int it = blockIdx.x; it < T / 16; it += gridDim.x) rwkv_prep_item(p, l, it, smem);
#pragma unroll 1
    for (int grp = 0; grp < NGRP; ++grp) {
      const size_t xoff = (size_t)grp * TG * 1024;
      const float* xin = ((l == 0) ? p.in[0] : (const float*)p.out) + xoff;
      float* xout = p.out + xoff;
      u16* H = (u16*)(p.ws + O_H);
      xcd_barrier(xb);
      phase_norm(xin, p.in[3] + l * 1024, H, TG);
      xcd_barrier(xb);
      phase_gemm1(p, l, grp, smem);
      xcd_barrier(xb);
      phase_stage1(p, l, grp, smem, &s_item);
      xcd_barrier(xb);
      phase_stage2(p, l, grp, smem, &s_item);
      if (grp == 0) {
        xcd_barrier(xb);
        for (int it = blockIdx.x; it < T / 64; it += gridDim.x) rwkv_post_item(p, l, it);
      }
      xcd_barrier(xb);
      phase_merge(p, l, grp, smem);
      xcd_barrier(xb);
      phase_gemm<EPI_RESID>((const u16*)(p.ws + O_MERGED), 1024, (const u16*)(p.ws + O_MIX) + (size_t)l * E_MIX, 1024, 1024, TG, xin, xout, nullptr, 0, 1.f, smem);
      xcd_barrier(xb);
      phase_norm(xout, p.in[28] + l * 1024, H, TG);
      xcd_barrier(xb);
      phase_cross(p, l, grp, smem);
      xcd_barrier(xb);
      phase_gemm<EPI_RESID>((const u16*)(p.ws + O_O), 1024, (const u16*)(p.ws + O_MO) + (size_t)l * E_MO, 1024, 1024, TG, xout, xout, nullptr, 0, 1.f, smem);
      xcd_barrier(xb);
      phase_norm(xout, p.in[33] + l * 1024, H, TG);
      xcd_barrier(xb);
      phase_gemm<EPI_BF16>(H, 1024, (const u16*)(p.ws + O_FIN) + (size_t)l * E_FIN, 1024, NFF2, TG, nullptr, nullptr, (u16*)(p.ws + O_U), NFF2, 1.f, smem);
      xcd_barrier(xb);
      phase_convact(p, l);
      xcd_barrier(xb);
      phase_gemm<EPI_RESID>((const u16*)(p.ws + O_ACT), DFF, (const u16*)(p.ws + O_FOUT) + (size_t)l * E_FOUT, DFF, 1024, TG, xout, xout, nullptr, 0, 1.f, smem);
    }
  }
  xcd_barrier(xb);
  phase_final_norm(p.out, p.in[38]);
}

extern "C" void kernel_launch(void* const* d_in, const int* in_sizes, int n_in, void* d_out, int out_size, void* d_ws, size_t ws_size,
                              hipStream_t stream) {
  static int grid_blocks = 0;
  if (!grid_blocks) {
    int dev = 0, cus = 0, per_cu = 0;
    (void)hipGetDevice(&dev);
    (void)hipDeviceGetAttribute(&cus, hipDeviceAttributeMultiprocessorCount, dev);
    (void)hipOccupancyMaxActiveBlocksPerMultiprocessor(&per_cu, fwd_megakernel, NTH, 0);
    if (per_cu < 1) per_cu = 1;
    if (per_cu > 1) per_cu = 1;
    grid_blocks = cus * per_cu;
  }
  Params p{};
  for (int i = 0; i < 39; ++i) p.in[i] = (const float*)d_in[i];
  p.out = (float*)d_out;
  p.ws = (char*)d_ws;
  (void)hipMemsetAsync((char*)d_ws + O_XBAR, 0, XCD_BAR_WORDS * 4, stream);
  void* args[] = {&p};
  hipError_t e = hipLaunchCooperativeKernel((void*)fwd_megakernel, dim3(grid_blocks), dim3(NTH), args, 0, stream);
  if (e != hipSuccess) fprintf(stderr, "cooperative launch failed: %s (grid %d)\n", hipGetErrorString(e), grid_blocks);
}
```

```cpp
#include <hip/hip_runtime.h>
#include <hip/hip_cooperative_groups.h>
#include <stdint.h>
#include <stdio.h>
namespace cg = cooperative_groups;

#define DI __device__ __forceinline__
typedef unsigned short u16;
using bf16x8 = __attribute__((ext_vector_type(8))) short;
using s16x4  = __attribute__((ext_vector_type(4))) short;
using f32x4  = __attribute__((ext_vector_type(4))) float;
using u32x4  = __attribute__((ext_vector_type(4))) unsigned;
using u32x2  = __attribute__((ext_vector_type(2))) unsigned;

constexpr int NTH = 512;
constexpr int D = 1024, NB = 16, S = 4096, T = NB * S, NL = 2, MEM = 256;
constexpr int BG = 4, TG = BG * S, NGRP = NB / BG;
constexpr int NIN = 9984, DFF = 2816, NFF2 = 2 * DFF;
constexpr int NSG = 8960;
constexpr int GOFF = 4864;
constexpr int YW = 1024;
constexpr float EPS = 1e-5f;

constexpr size_t al(size_t x) { return (x + 255) & ~(size_t)255; }
constexpr size_t E_WIN = (size_t)NIN * D, E_PA = 1024 * 256, E_PB = 1024 * 512, E_PC = 1024 * 256, E_PD = 1024 * 256;
constexpr size_t E_MIX = 1024 * 1024, E_MQ = 1024 * 1024, E_MKV = 2048 * 1024, E_MO = 1024 * 1024;
constexpr size_t E_FIN = (size_t)NFF2 * D, E_FOUT = (size_t)D * DFF;
constexpr size_t O_WIN = 0;
constexpr size_t O_PA = O_WIN + al(NL * E_WIN * 2);
constexpr size_t O_PB = O_PA + al(NL * E_PA * 2);
constexpr size_t O_PC = O_PB + al(NL * E_PB * 2);
constexpr size_t O_PD = O_PC + al(NL * E_PC * 2);
constexpr size_t O_MIX = O_PD + al(NL * E_PD * 2);
constexpr size_t O_MQ = O_MIX + al(NL * E_MIX * 2);
constexpr size_t O_MKV = O_MQ + al(NL * E_MQ * 2);
constexpr size_t O_MO = O_MKV + al(NL * E_MKV * 2);
constexpr size_t O_FIN = O_MO + al(NL * E_MO * 2);
constexpr size_t O_FOUT = O_FIN + al(NL * E_FIN * 2);
constexpr size_t O_ROPE = O_FOUT + al(NL * E_FOUT * 2);
constexpr size_t O_MEMN = O_ROPE + al((size_t)T * 16 * 4);
constexpr size_t O_KV = O_MEMN + al((size_t)NL * 4096 * 1024 * 2);
constexpr size_t O_VFIRST = O_KV + al((size_t)NL * 4096 * 2048 * 2);
constexpr size_t O_SCAL = O_VFIRST + al((size_t)T * 256 * 2);
constexpr size_t O_BAR = O_SCAL + 128;
constexpr size_t O_CNT = O_SCAL + 256;
constexpr size_t SZ_RW = al((size_t)T * 256 * 2);
constexpr size_t O_XBAR = O_CNT + 2048;
constexpr size_t O_RWR = O_XBAR + 16384;
constexpr size_t O_RWK = O_RWR + SZ_RW, O_RWV = O_RWK + SZ_RW, O_RWKK = O_RWV + SZ_RW, O_RWKKA = O_RWKK + SZ_RW, O_RWG = O_RWKKA + SZ_RW;
constexpr size_t O_YD = O_RWG + SZ_RW;
constexpr size_t O_RWW = O_YD + SZ_RW;
constexpr size_t O_RWY = O_RWW + al((size_t)T * 256 * 4);
constexpr size_t O_RWRK = O_RWY + al((size_t)T * 256 * 4);
constexpr size_t O_TR = O_RWRK + al((size_t)T * 4 * 4);
constexpr size_t O_H = O_TR;
constexpr size_t O_SEG = O_H + al((size_t)TG * 1024 * 2);
constexpr size_t O_HGS = O_SEG + al((size_t)TG * NSG * 2);
constexpr size_t O_HGF = O_HGS + al((size_t)BG * 4 * 32 * 4096 * 4);
constexpr size_t O_OG = O_HGF + al((size_t)BG * 4 * 32 * 64 * 4);
constexpr size_t O_LSE = O_OG + al((size_t)TG * 768 * 2);
constexpr size_t O_Y = O_LSE + al((size_t)TG * 12 * 4);
constexpr size_t O_MERGED = O_Y + al((size_t)TG * YW * 2);
constexpr size_t WS_TOTAL = O_MERGED + al((size_t)TG * 1024 * 2);
constexpr size_t O_HALL = O_TR;
constexpr size_t O_SEGD = O_TR + al((size_t)T * 1024 * 2);
constexpr size_t O_Q = O_SEG;
constexpr size_t O_O = O_SEG + al((size_t)TG * 1024 * 2);
constexpr size_t O_U = O_SEG;
constexpr size_t O_ACT = O_SEG + al((size_t)TG * NFF2 * 2);
static_assert(O_ACT + (size_t)TG * DFF * 2 <= O_HGS, "U + ACT fit in SEG");
static_assert(O_SEGD + (size_t)T * 1024 * 2 <= WS_TOTAL, "front buffers fit in the transient region");
static_assert(WS_TOTAL <= ((size_t)1 << 30), "workspace fits 1 GiB");

constexpr int SMEM_BYTES = 163840;

struct Params {
  const float* in[39];
  float* out;
  char* ws;
};

DI int otid() { int t = threadIdx.x; asm volatile("" : "+v"(t)); return t; }
typedef __bf16 bf16x2_t __attribute__((ext_vector_type(2)));
typedef float f32x2_t __attribute__((ext_vector_type(2)));
DI unsigned pack2(float a, float b) { f32x2_t f = {a, b}; bf16x2_t r = __builtin_convertvector(f, bf16x2_t); return __builtin_bit_cast(unsigned, r); }
DI u16 f2bf(float x) { return (u16)(pack2(x, 0.f) & 0xffffu); }
DI float bf2f(u16 b) { return __uint_as_float(((unsigned)b) << 16); }
DI float bflo(unsigned u) { return __uint_as_float(u << 16); }
DI float bfhi(unsigned u) { return __uint_as_float(u & 0xffff0000u); }
DI float sigm(float x) { return __builtin_amdgcn_rcpf(1.f + __expf(-x)); }
DI float silu(float x) { return x * __builtin_amdgcn_rcpf(1.f + __expf(-x)); }
DI float wave_sum_slow(float v) {
#pragma unroll
  for (int o = 32; o > 0; o >>= 1) v += __shfl_xor(v, o);
  return v;
}
DI f32x4 mfma16(bf16x8 a, bf16x8 b, f32x4 c) { return __builtin_amdgcn_mfma_f32_16x16x32_bf16(a, b, c, 0, 0, 0); }
template <int CTRL> DI float dpp_mov(float x) {
  return __int_as_float(__builtin_amdgcn_update_dpp(0, __float_as_int(x), CTRL, 0xF, 0xF, true));
}
DI float red16(float x) {
  x += dpp_mov<0xB1>(x);
  x += dpp_mov<0x4E>(x);
  x += dpp_mov<0x141>(x);
  x += dpp_mov<0x140>(x);
  return x;
}
DI float wave_sum(float v) { v = red16(v); v += __shfl_xor(v, 16); v += __shfl_xor(v, 32); return v; }
DI void red16_2(float& a, float& b) {
  a += dpp_mov<0xB1>(a);  b += dpp_mov<0xB1>(b);
  a += dpp_mov<0x4E>(a);  b += dpp_mov<0x4E>(b);
  a += dpp_mov<0x141>(a); b += dpp_mov<0x141>(b);
  a += dpp_mov<0x140>(a); b += dpp_mov<0x140>(b);
}

#define XB_TMO      128
#define XB_XCNT(j)  (256  + 64 * (j))
#define XB_XSUB(j)  (1280 + 64 * (j))
#define XB_XGEN(j)  (2304 + 64 * (j))
#define XB_TOP      3328
#define XB_TOPGEN   3392
#define XCD_BAR_WORDS 3456
#define XB_SPIN_CAP (1u << 18)
#define LAS __attribute__((address_space(3)))
DI unsigned xb_ld(unsigned* p)              { return __hip_atomic_load(p, __ATOMIC_RELAXED, __HIP_MEMORY_SCOPE_AGENT); }
DI unsigned xb_add(unsigned* p, unsigned v) { return __hip_atomic_fetch_add(p, v, __ATOMIC_RELAXED, __HIP_MEMORY_SCOPE_AGENT); }
DI unsigned xb_xcc_id() { return (unsigned)__builtin_amdgcn_s_getreg((3 << 11) | 20) & 0xFu; }
#define XB_SPIN(cond, bar) do { unsigned _sp = 0; while (cond) { __builtin_amdgcn_s_sleep(1); \
    if ((++_sp & 255u) == 0u) { if (xb_ld(&(bar)[XB_TMO])) break; if (_sp > XB_SPIN_CAP) { atomicAdd(&(bar)[XB_TMO], 1u); break; } } } } while (0)
struct XcdBarrier { unsigned* bar; unsigned x; unsigned nloc, nx; };
DI XcdBarrier xcd_barrier_post(unsigned* bar) {
  XcdBarrier b; b.bar = bar; b.x = xb_xcc_id(); b.nloc = 0u; b.nx = 0u;
  if (threadIdx.x == 0) (void)xb_add(&bar[XB_XCNT(b.x)], 1u);
  return b;
}
DI void xcd_barrier_complete(unsigned* bar, unsigned x, unsigned& nloc, unsigned& nx) {
  const unsigned G = gridDim.x * gridDim.y * gridDim.z;
  unsigned sum, cnt, mine, sp = 0u;
  for (;;) {
    sum = 0u; cnt = 0u; mine = 0u;
#pragma unroll
    for (unsigned j = 0; j < 16; ++j) { const unsigned c = xb_ld(&bar[XB_XCNT(j)]); sum += c; cnt += (c > 0u) ? 1u : 0u; mine = (j == x) ? c : mine; }
    if (sum == G) break;
    __builtin_amdgcn_s_sleep(1);
    if ((++sp & 255u) == 0u) { if (xb_ld(&bar[XB_TMO])) break; if (sp > XB_SPIN_CAP) { atomicAdd(&bar[XB_TMO], 1u); break; } }
  }
  nloc = mine > 0u ? mine : 1u; nx = cnt > 0u ? cnt : 1u;
}
DI void xcd_barrier(XcdBarrier& b) {
  asm volatile("s_waitcnt vmcnt(0)" ::: "memory");
  __syncthreads();
  if (threadIdx.x == 0) {
    unsigned* bar = b.bar;
    __builtin_amdgcn_s_waitcnt(0);
    unsigned nloc = b.nloc, nx = b.nx;
    if (nloc == 0u) { xcd_barrier_complete(bar, b.x, nloc, nx); b.nloc = nloc; b.nx = nx; }
    const unsigned old = xb_add(&bar[XB_XSUB(b.x)], 1u);
    const unsigned gen = old / nloc;
    if (old + 1u == (gen + 1u) * nloc) {
      __builtin_amdgcn_fence(__ATOMIC_RELEASE, "agent");
      asm volatile("s_waitcnt vmcnt(0)" ::: "memory");
      const unsigned og = xb_add(&bar[XB_TOP], 1u);
      const unsigned tg = og / nx;
      if (og + 1u == (tg + 1u) * nx) xb_add(&bar[XB_TOPGEN], 1u);
      else XB_SPIN(xb_ld(&bar[XB_TOPGEN]) == tg, bar);
      __builtin_amdgcn_fence(__ATOMIC_ACQUIRE, "agent");
      xb_add(&bar[XB_XGEN(b.x)], 1u);
      asm volatile("s_waitcnt vmcnt(0)" ::: "memory");
    } else {
      XB_SPIN(xb_ld(&bar[XB_XGEN(b.x)]) == gen, bar);
      __builtin_amdgcn_fence(__ATOMIC_ACQUIRE, "agent");
      asm volatile("s_waitcnt vmcnt(0)" ::: "memory");
    }
  }
  __syncthreads();
}

DI int lds_byte2(int r, int c) {
  const int st = (r >> 4) * 2 + (c >> 5), ob = (r & 15) * 64 + (c & 31) * 2;
  return st * 1024 + (ob ^ (((ob >> 9) & 1) << 5));
}
typedef __attribute__((address_space(3))) unsigned* lds_u32_ptr;
template <int MI> struct GemmStage {
  static constexpr int AROWS = MI * 32, LA = AROWS / 128;
  static constexpr int A_BYTES = AROWS * 64, STAGE = A_BYTES + 256 * 64;
  static constexpr int LPS = LA + 2;
  unsigned aoff[LA], boff[2]; int wid;
  DI void init(long lda, long ldb) {
    const int tid = otid(), lane = tid & 63;
    wid = tid >> 6;
    const int sb = lane * 16, swz = sb ^ (((sb >> 9) & 1) << 5);
    const int rr = swz >> 6, cc = (swz & 63) >> 1;
#pragma unroll
    for (int i = 0; i < LA; ++i) aoff[i] = (unsigned)(((wid + 8 * i) * 16 + rr) * (int)lda + cc);
#pragma unroll
    for (int i = 0; i < 2; ++i) boff[i] = (unsigned)(((wid + 8 * i) * 16 + rr) * (int)ldb + cc);
  }
  DI void issue(const u16* __restrict__ A, const u16* __restrict__ Bt, int k0, char* buf) const {
#pragma unroll
    for (int i = 0; i < LA; ++i) __builtin_amdgcn_global_load_lds((const unsigned*)(A + aoff[i] + k0), (lds_u32_ptr)(buf + (wid + 8 * i) * 1024), 16, 0, 0);
#pragma unroll
    for (int i = 0; i < 2; ++i) __builtin_amdgcn_global_load_lds((const unsigned*)(Bt + boff[i] + k0), (lds_u32_ptr)(buf + A_BYTES + (wid + 8 * i) * 1024), 16, 0, 0);
  }
};
constexpr int NSTG = 5;
DI int ring_next(int b) { return (b + 1 == NSTG) ? 0 : b + 1; }
DI int ring_add(int b, int s) { int r = b + s; return (r >= NSTG) ? r - NSTG : r; }
template <int MI>
DI void gemm_issue0(const u16* __restrict__ A, long lda, const u16* __restrict__ Bt, long ldb, char* smem, int rb) {
  GemmStage<MI> gs; gs.init(lda, ldb);
#pragma unroll
  for (int s = 0; s < 4; ++s) gs.issue(A, Bt, s * 32, smem + ring_add(rb, s) * GemmStage<MI>::STAGE);
}
template <int MI>
DI void gemm_run(f32x4 (&acc)[MI][4], const u16* __restrict__ A, long lda, const u16* __restrict__ Bt, long ldb, int K, char* smem, bool preissued, int& rb) {
  constexpr int A_BYTES = GemmStage<MI>::A_BYTES, STAGE = GemmStage<MI>::STAGE, LPS = GemmStage<MI>::LPS;
  GemmStage<MI> gs; gs.init(lda, ldb);
  const int tid = otid(), lane = tid & 63, wid = tid >> 6, wr = wid >> 2, wc = wid & 3;
  const int li = lane & 15, lg = lane >> 4;
  const int fo = (li * 64 + lg * 16) ^ ((li >> 3) << 5);
  const int nk = K >> 5;
  if (!preissued) {
    __syncthreads();
#pragma unroll
    for (int s = 0; s < 4; ++s) gs.issue(A, Bt, s * 32, smem + ring_add(rb, s) * STAGE);
  }
  int cb = rb;
  for (int kk = 0; kk < nk; ++kk) {
    const int newer = nk - 1 - kk;
    if (newer == 0) asm volatile("s_waitcnt vmcnt(0)" ::: "memory");
    else if (newer == 1) asm volatile("s_waitcnt vmcnt(%0)" :: "n"(LPS) : "memory");
    else if (newer == 2) asm volatile("s_waitcnt vmcnt(%0)" :: "n"(2 * LPS) : "memory");
    else asm volatile("s_waitcnt vmcnt(%0)" :: "n"(3 * LPS) : "memory");
    asm volatile("s_waitcnt lgkmcnt(0)" ::: "memory");
    __builtin_amdgcn_s_barrier();
    asm volatile("" ::: "memory");
    char* cur = smem + cb * STAGE;
    {
      constexpr int NP = MI / 2;
      bf16x8 bq[4], ap[2][2];
      const char* aB = cur + (wr * MI) * 1024 + fo;
      const char* bB = cur + A_BYTES + (wc * 4) * 1024 + fo;
#pragma unroll
      for (int ni = 0; ni < 4; ++ni) bq[ni] = *(const bf16x8*)(bB + ni * 1024);
#pragma unroll
      for (int i = 0; i < 2; ++i) ap[0][i] = *(const bf16x8*)(aB + i * 1024);
      __builtin_amdgcn_sched_barrier(0);
      if (kk + 4 < nk) gs.issue(A, Bt, (kk + 4) << 5, smem + ring_add(cb, 4) * STAGE);
      __builtin_amdgcn_sched_barrier(0);
#pragma unroll
      for (int pp = 0; pp < NP; ++pp) {
        if (pp + 1 < NP) {
#pragma unroll
          for (int i = 0; i < 2; ++i) ap[(pp + 1) & 1][i] = *(const bf16x8*)(aB + (2 * (pp + 1) + i) * 1024);
        }
#pragma unroll
        for (int i = 0; i < 2; ++i)
#pragma unroll
          for (int ni = 0; ni < 4; ++ni) acc[2 * pp + i][ni] = mfma16(bq[ni], ap[pp & 1][i], acc[2 * pp + i][ni]);
        __builtin_amdgcn_sched_group_barrier(0x008, 1, 0);
        if (pp + 1 < NP) __builtin_amdgcn_sched_group_barrier(0x100, 2, 0);
        __builtin_amdgcn_sched_group_barrier(0x008, 7, 0);
        __builtin_amdgcn_sched_barrier(0);
      }
    }
    cb = ring_next(cb);
  }
  rb = cb;
}
template <int MI>
DI void gemm_main(f32x4 (&acc)[MI][4], const u16* __restrict__ A, long lda, const u16* __restrict__ Bt, long ldb, int K, char* smem) {
  int rb = 0;
  gemm_run<MI>(acc, A, lda, Bt, ldb, K, smem, false, rb);
}
template <int BH> struct TileWalk {
  int x, j, per, r, NT, total; bool plain;
  DI TileWalk(int MT, int NT_) : NT(NT_), total(MT * NT_) {
    plain = (gridDim.x & 7) != 0 || (MT % BH) != 0;
    x = blockIdx.x & 7; j = blockIdx.x >> 3; per = gridDim.x >> 3; r = 0;
  }
  DI bool next(int& mt, int& nt) {
    int tp;
    if (plain) tp = blockIdx.x + r * gridDim.x; else tp = (r * 8 + x) * per + j;
    ++r;
    if (tp >= total) return false;
    if (plain) { mt = tp / NT; nt = tp % NT; }
    else { const int band = tp / (BH * NT), idx = tp % (BH * NT); mt = band * BH + (idx % BH); nt = idx / BH; }
    return true;
  }
};
template <int MI> DI void zero_acc(f32x4 (&acc)[MI][4]) {
#pragma unroll
  for (int mi = 0; mi < MI; ++mi)
#pragma unroll
    for (int ni = 0; ni < 4; ++ni) acc[mi][ni] = f32x4{0.f, 0.f, 0.f, 0.f};
}
template <int MI, typename F> DI void epi_foreach(f32x4 (&acc)[MI][4], F&& f) {
  const int tid_ = otid(), lane_ = tid_ & 63, wid_ = tid_ >> 6, wr_ = wid_ >> 2, wc_ = wid_ & 3, li_ = lane_ & 15, lg_ = lane_ >> 4;
#pragma unroll
  for (int mi = 0; mi < MI; ++mi) {
    asm volatile("" ::: "memory");
#pragma unroll
    for (int ni = 0; ni < 4; ++ni) f(mi, ni, wr_ * (MI * 16) + mi * 16 + li_, wc_ * 64 + ni * 16 + lg_ * 4, acc[mi][ni]);
  }
}
DI u32x2 pack4(f32x4 v) { u32x2 o; o[0] = pack2(v[0], v[1]); o[1] = pack2(v[2], v[3]); return o; }

struct TrJob { const float* src; u16* dst; int K, N; };
DI TrJob tr_job(const Params& p, int j) {
  const int l = j / 11, w = j % 11;
  TrJob r;
  switch (w) {
    case 0: r = {p.in[4] + (size_t)l * E_WIN, (u16*)(p.ws + O_WIN) + (size_t)l * E_WIN, 1024, NIN}; break;
    case 1: r = {p.in[23] + (size_t)l * E_PA, (u16*)(p.ws + O_PA) + (size_t)l * E_PA, 256, 1024}; break;
    case 2: r = {p.in[24] + (size_t)l * E_PB, (u16*)(p.ws + O_PB) + (size_t)l * E_PB, 512, 1024}; break;
    case 3: r = {p.in[25] + (size_t)l * E_PC, (u16*)(p.ws + O_PC) + (size_t)l * E_PC, 256, 1024}; break;
    case 4: r = {p.in[26] + (size_t)l * E_PD, (u16*)(p.ws + O_PD) + (size_t)l * E_PD, 256, 1024}; break;
    case 5: r = {p.in[27] + (size_t)l * E_MIX, (u16*)(p.ws + O_MIX) + (size_t)l * E_MIX, 1024, 1024}; break;
    case 6: r = {p.in[30] + (size_t)l * E_MQ, (u16*)(p.ws + O_MQ) + (size_t)l * E_MQ, 1024, 1024}; break;
    case 7: r = {p.in[31] + (size_t)l * E_MKV, (u16*)(p.ws + O_MKV) + (size_t)l * E_MKV, 1024, 2048}; break;
    case 8: r = {p.in[32] + (size_t)l * E_MO, (u16*)(p.ws + O_MO) + (size_t)l * E_MO, 1024, 1024}; break;
    case 9: r = {p.in[34] + (size_t)l * E_FIN, (u16*)(p.ws + O_FIN) + (size_t)l * E_FIN, 1024, NFF2}; break;
    default: r = {p.in[37] + (size_t)l * E_FOUT, (u16*)(p.ws + O_FOUT) + (size_t)l * E_FOUT, DFF, 1024}; break;
  }
  return r;
}
DI int tr_tiles(int w) {
  switch (w) {
    case 0: return 16 * 156; case 1: return 4 * 16; case 2: return 8 * 16; case 3: return 4 * 16; case 4: return 4 * 16;
    case 5: return 256; case 6: return 256; case 7: return 16 * 32; case 8: return 256; case 9: return 16 * 88; default: return 44 * 16;
  }
}
constexpr int TR_TILES_L = 16 * 156 + 64 + 128 + 64 + 64 + 256 * 3 + 512 + 16 * 88 + 44 * 16;

DI void transpose_tile(const TrJob& jb, int tile, char* smem) {
  float* ts = (float*)smem;
  const int ntn = jb.N >> 6;
  const int k0 = (tile / ntn) << 6, n0 = (tile % ntn) << 6;
  const int tid = otid(), a = tid >> 6, b = tid & 63;
  __syncthreads();
#pragma unroll
  for (int i = 0; i < 8; ++i) { int k = i * 8 + a; ts[k * 65 + b] = jb.src[(size_t)(k0 + k) * jb.N + n0 + b]; }
  __syncthreads();
#pragma unroll
  for (int i = 0; i < 8; ++i) { int n = i * 8 + a; jb.dst[(size_t)(n0 + n) * jb.K + k0 + b] = f2bf(ts[b * 65 + n]); }
}

DI void sincos_acc(float ang, float& c, float& s) {
  double a = (double)ang;
  const double TWO_PI = 6.283185307179586476925;
  double n = rint(a / TWO_PI);
  double r = a - n * TWO_PI;
  double r2 = r * r;
  double sn = 0.0, cs = 0.0;
  double ts = r, tc = 1.0;
#pragma unroll
  for (int k = 0; k < 13; ++k) {
    cs += tc; sn += ts;
    tc = -tc * r2 / (double)((2 * k + 1) * (2 * k + 2));
    ts = -ts * r2 / (double)((2 * k + 2) * (2 * k + 3));
  }
  c = (float)cs; s = (float)sn;
}

DI void norm_row_bf16(const float* __restrict__ xr, const float* __restrict__ g, u16* __restrict__ outr, int lane) {
  float4 v[4]; float ss = 0.f;
#pragma unroll
  for (int i = 0; i < 4; ++i) { v[i] = ((const float4*)xr)[i * 64 + lane]; ss += v[i].x * v[i].x + v[i].y * v[i].y + v[i].z * v[i].z + v[i].w * v[i].w; }
  ss = wave_sum(ss);
  const float rstd = 1.0f / sqrtf(ss * (1.f / 1024.f) + EPS);
#pragma unroll
  for (int i = 0; i < 4; ++i) {
    float4 gg = ((const float4*)g)[i * 64 + lane];
    u32x2 o; o[0] = pack2(v[i].x * rstd * gg.x, v[i].y * rstd * gg.y); o[1] = pack2(v[i].z * rstd * gg.z, v[i].w * rstd * gg.w);
    *(u32x2*)(outr + (i * 64 + lane) * 4) = o;
  }
}

DI void phase_prologue(const Params& p, char* smem) {
  const int tid = otid(), lane = tid & 63, wave = tid >> 6;
  if (blockIdx.x == 0) {
    ((int*)(p.ws + O_CNT))[tid] = 0;
    if (tid < NL) {
      const float* lv = p.in[5] + tid * 256;
      float s1 = 0.f, s2 = 0.f;
      for (int i = 0; i < 64; ++i) { s1 += lv[i] * lv[64 + i]; s2 += lv[128 + i] * lv[192 + i]; }
      const float lam_init = (tid == 0) ? 0.2f : 0.355509067591f;
      ((float*)(p.ws + O_SCAL))[tid] = expf(s1) - expf(s2) + lam_init;
    }
  }
  for (int t = blockIdx.x; t < NL * TR_TILES_L; t += gridDim.x) {
    int l = t / TR_TILES_L, r = t % TR_TILES_L, w = 0;
    for (; w < 10; ++w) { int n = tr_tiles(w); if (r < n) break; r -= n; }
    TrJob jb = tr_job(p, l * 11 + w);
    transpose_tile(jb, r, smem);
  }
  {
    const int* pos = (const int*)p.in[2];
    float* tab = (float*)(p.ws + O_ROPE);
    for (int idx = blockIdx.x * NTH + tid; idx < T * 8; idx += gridDim.x * NTH) {
      const int t = idx >> 3, i = idx & 7;
      float invf;
      switch (i) {
        case 0: invf = 1.0f; break; case 1: invf = 0.1939227432012558f; break; case 2: invf = 0.03760603070259094f; break;
        case 3: invf = 0.007292664609849453f; break; case 4: invf = 0.0014142135623842478f; break; case 5: invf = 0.00027424818836152554f; break;
        case 6: invf = 5.3182957344688475e-05f; break; default: invf = 1.0313385246263351e-05f; break;
      }
      const float ang = (float)pos[t] * invf;
      float c, s; sincos_acc(ang, c, s);
      tab[t * 16 + i] = c; tab[t * 16 + 8 + i] = s;
    }
  }
  for (int row = blockIdx.x * 8 + wave; row < NL * 4096; row += gridDim.x * 8) {
    const int l = row >> 12, r = row & 4095;
    norm_row_bf16(p.in[1] + (size_t)r * 1024, p.in[29] + l * 1024, (u16*)(p.ws + O_MEMN) + (size_t)row * 1024, lane);
  }
}

DI void phase_kv_gemm(const Params& p, char* smem) {
  for (int t = blockIdx.x; t < NL * 16 * 8; t += gridDim.x) {
    const int l = t >> 7, r = t & 127, mt = r >> 3, nt = r & 7;
    f32x4 acc[8][4]; zero_acc<8>(acc);
    const u16* A = (const u16*)(p.ws + O_MEMN) + (size_t)l * 4096 * 1024 + (size_t)mt * 256 * 1024;
    const u16* B = (const u16*)(p.ws + O_MKV) + (size_t)l * E_MKV + (size_t)nt * 256 * 1024;
    gemm_main<8>(acc, A, 1024, B, 1024, 1024, smem);
    u16* C = (u16*)(p.ws + O_KV) + (size_t)l * 4096 * 2048 + (size_t)mt * 256 * 2048 + nt * 256;
    epi_foreach<8>(acc, [&](int mi, int ni, int r, int c, f32x4& v) { *(u32x2*)(C + (unsigned)(r * 2048 + c)) = pack4(v); });
  }
}

DI void phase_norm(const float* __restrict__ X, const float* __restrict__ g, u16* __restrict__ H, int rows) {
  const int tid = otid(), lane = tid & 63, wave = tid >> 6;
  for (int row = blockIdx.x * 8 + wave; row < rows; row += gridDim.x * 8)
    norm_row_bf16(X + (size_t)row * 1024, g, H + (size_t)row * 1024, lane);
}

DI void phase_final_norm(float* X, const float* __restrict__ g) {
  const int tid = otid(), lane = tid & 63, wave = tid >> 6;
  for (int row = blockIdx.x * 8 + wave; row < T; row += gridDim.x * 8) {
    float* xr = X + (size_t)row * 1024;
    float4 v[4]; float ss = 0.f;
#pragma unroll
    for (int i = 0; i < 4; ++i) { v[i] = ((const float4*)xr)[i * 64 + lane]; ss += v[i].x * v[i].x + v[i].y * v[i].y + v[i].z * v[i].z + v[i].w * v[i].w; }
    ss = wave_sum(ss);
    const float rstd = 1.0f / sqrtf(ss * (1.f / 1024.f) + EPS);
#pragma unroll
    for (int i = 0; i < 4; ++i) {
      float4 gg = ((const float4*)g)[i * 64 + lane];
      float4 o; o.x = v[i].x * rstd * gg.x; o.y = v[i].y * rstd * gg.y; o.z = v[i].z * rstd * gg.z; o.w = v[i].w * rstd * gg.w;
      ((float4*)xr)[i * 64 + lane] = o;
    }
  }
}

DI void phase_gemm1(const Params& p, int l, int grp, char* smem) {
  const u16* H = (const u16*)(p.ws + O_H);
  const u16* W = (const u16*)(p.ws + O_WIN) + (size_t)l * E_WIN;
  u16* SEG = (u16*)(p.ws + O_SEG);
  const float* tab = (const float*)(p.ws + O_ROPE) + (size_t)grp * TG * 16;
  constexpr int NT = NSG / 256;
  TileWalk<4> tw(TG / 256, NT);
  int mt = 0, nt = 0;
  bool have = tw.next(mt, nt);
  int rb = 0;
  if (have) { __syncthreads(); gemm_issue0<8>(H + (size_t)mt * 256 * 1024, 1024, W + (size_t)((nt < 19) ? nt * 256 : (nt + 4) * 256) * 1024, 1024, smem, rb); }
  while (have) {
    const int wrow = (nt < 19) ? nt * 256 : (nt + 4) * 256;
    f32x4 acc[8][4]; zero_acc<8>(acc);
    gemm_run<8>(acc, H + (size_t)mt * 256 * 1024, 1024, W + (size_t)wrow * 1024, 1024, 1024, smem, true, rb);
    int mt2 = 0, nt2 = 0;
    const bool have2 = tw.next(mt2, nt2);
    if (have2) gemm_issue0<8>(H + (size_t)mt2 * 256 * 1024, 1024, W + (size_t)((nt2 < 19) ? nt2 * 256 : (nt2 + 4) * 256) * 1024, 1024, smem, rb);
    u16* segb = SEG + (size_t)mt * 256 * NSG + nt * 256;
    const float* tabb = tab + (size_t)mt * 256 * 16;
    {
      const int tid_ = otid(), lane_ = tid_ & 63, wid_ = __builtin_amdgcn_readfirstlane(tid_ >> 6), wr_ = wid_ >> 2, wc_ = wid_ & 3;
      const int li_ = lane_ & 15, lg_ = lane_ >> 4;
#pragma unroll
      for (int ni = 0; ni < 4; ++ni) {
        const int cb = nt * 256 + wc_ * 64 + ni * 16;
        bool rot = false; float scale = 1.f;
        if (cb < 2304) { const int jj = (cb % 768) >> 8; rot = (jj < 2); if (jj == 0) scale = 0.125f; }
        else if (cb < 3840) { const int c2 = cb - 2304; rot = (c2 < 1024); if (c2 < 512) scale = 0.125f; }
        rot = rot && (ni == 0);
        const bool gate = (cb >= GOFF);
        const int c = wc_ * 64 + ni * 16 + lg_ * 4;
#pragma unroll
        for (int mi = 0; mi < 8; ++mi) {
          if ((mi & 1) == 0) asm volatile("" ::: "memory");
          const int r = wr_ * 128 + mi * 16 + li_;
          f32x4 o = acc[mi][ni];
          if (rot) {
            f32x4 other;
            other[0] = __shfl_xor(o[0], 32); other[1] = __shfl_xor(o[1], 32); other[2] = __shfl_xor(o[2], 32); other[3] = __shfl_xor(o[3], 32);
            const f32x4 cs = *(const f32x4*)(tabb + (unsigned)(r * 16 + (lg_ & 1) * 4));
            const f32x4 sn = *(const f32x4*)(tabb + (unsigned)(r * 16 + 8 + (lg_ & 1) * 4));
            o = (lg_ < 2) ? (o * cs - other * sn) : (o * cs + other * sn);
          }
          if (gate) { o[0] = sigm(o[0]); o[1] = sigm(o[1]); o[2] = sigm(o[2]); o[3] = sigm(o[3]); }
          *(u32x2*)(segb + (unsigned)(r * NSG + c)) = pack4(o * scale);
        }
      }
    }
    mt = mt2; nt = nt2; have = have2;
  }
}

template <int DK> struct TileRegs {
  static constexpr int CPR = DK / 8, NCH = (64 * CPR) / NTH;
  u32x4 r[NCH];
  DI void load(const u16* __restrict__ src, long row_stride, int tid) {
#pragma unroll
    for (int i = 0; i < NCH; ++i) { const int c = tid + NTH * i, row = c / CPR, kc = c % CPR; r[i] = *(const u32x4*)(src + (long)row * row_stride + kc * 8); }
  }
  DI void store(char* dst, int pad, int tid) const {
    const int rs = DK * 2 + pad;
#pragma unroll
    for (int i = 0; i < NCH; ++i) { const int c = tid + NTH * i, row = c / CPR, kc = c % CPR; *(u32x4*)(dst + row * rs + kc * 16) = r[i]; }
  }
};
template <int DK>
DI void attn_scores(f32x4 (&Sa)[4], const bf16x8 (&Qf)[DK / 32], const char* Ks, int li, int lg) {
  constexpr int RS = DK * 2 + 16, NKS = DK / 32;
  const char* kb = Ks + li * RS + lg * 16;
  if (DK == 64) {
    bf16x8 kf[4][NKS];
#pragma unroll
    for (int ksub = 0; ksub < 4; ++ksub)
#pragma unroll
      for (int ks = 0; ks < NKS; ++ks) kf[ksub][ks] = *(const bf16x8*)(kb + ksub * 16 * RS + ks * 64);
#pragma unroll
    for (int ks = 0; ks < NKS; ++ks)
#pragma unroll
      for (int ksub = 0; ksub < 4; ++ksub) Sa[ksub] = mfma16(kf[ksub][ks], Qf[ks], Sa[ksub]);
    __builtin_amdgcn_sched_group_barrier(0x100, 4 * NKS, 0);
    __builtin_amdgcn_sched_group_barrier(0x008, 4 * NKS, 0);
    __builtin_amdgcn_sched_barrier(0);
  } else {
    constexpr int HK = NKS / 2;
    bf16x8 kf[2][HK];
#pragma unroll
    for (int ks = 0; ks < HK; ++ks) kf[0][ks] = *(const bf16x8*)(kb + ks * 64);
#pragma unroll
    for (int g = 0; g < 8; ++g) {
      const int ksub = g >> 1, hf = g & 1;
      if (g + 1 < 8) {
        const int ks2 = (g + 1) >> 1, hf2 = (g + 1) & 1;
#pragma unroll
        for (int ks = 0; ks < HK; ++ks) kf[(g + 1) & 1][ks] = *(const bf16x8*)(kb + ks2 * 16 * RS + (hf2 * HK + ks) * 64);
      }
#pragma unroll
      for (int ks = 0; ks < HK; ++ks) Sa[ksub] = mfma16(kf[g & 1][ks], Qf[hf * HK + ks], Sa[ksub]);
      __builtin_amdgcn_sched_group_barrier(0x008, 1, 0);
      if (g + 1 < 8) __builtin_amdgcn_sched_group_barrier(0x100, HK, 0);
      __builtin_amdgcn_sched_group_barrier(0x008, HK - 1, 0);
      __builtin_amdgcn_sched_barrier(0);
    }
  }
}
DI void softmax_step(f32x4 (&Sa)[4], float& m, float& l, float& alpha, bf16x8 (&P)[2]) {
  float mx = -INFINITY;
#pragma unroll
  for (int ksub = 0; ksub < 4; ++ksub)
#pragma unroll
    for (int j = 0; j < 4; ++j) mx = fmaxf(mx, Sa[ksub][j]);
  mx = fmaxf(mx, __shfl_xor(mx, 16));
  mx = fmaxf(mx, __shfl_xor(mx, 32));
  const float mn = fmaxf(m, mx);
  const float ms = (mn == -INFINITY) ? 0.f : mn;
  alpha = __expf(m - ms);
  float ps = 0.f;
#pragma unroll
  for (int ksub = 0; ksub < 4; ++ksub)
#pragma unroll
    for (int j = 0; j < 4; ++j) { const float e = __expf(Sa[ksub][j] - ms); ps += e; Sa[ksub][j] = e; }
  l = l * alpha + ps;
  m = mn;
#pragma unroll
  for (int kp = 0; kp < 2; ++kp) {
    u32x4 u;
    u[0] = pack2(Sa[2 * kp][0], Sa[2 * kp][1]); u[1] = pack2(Sa[2 * kp][2], Sa[2 * kp][3]);
    u[2] = pack2(Sa[2 * kp + 1][0], Sa[2 * kp + 1][1]); u[3] = pack2(Sa[2 * kp + 1][2], Sa[2 * kp + 1][3]);
    P[kp] = __builtin_bit_cast(bf16x8, u);
  }
}
typedef __attribute__((address_space(3))) s16x4* lds_s16x4_ptr;
template <int DV, int NMAP>
DI void attn_pv_pipe(f32x4 (&O1)[DV / 16], f32x4 (&O2)[DV / 16], const bf16x8 (&P1)[2], const bf16x8 (&P2)[2], float a1, float a2,
                     const char* Vs, int li, int lg) {
  constexpr int RS = DV * 2 + 32, NB = DV / 16, NC = NB / 2;
#pragma unroll
  for (int dt = 0; dt < NB; ++dt) { O1[dt] *= a1; if (NMAP == 2) O2[dt] *= a2; }
  const char* b0 = Vs + (lg * 4 + (li >> 2)) * RS + (li & 3) * 8;
  s16x4 vlo[2][2][2], vhi[2][2][2];
#pragma unroll
  for (int dtl = 0; dtl < 2; ++dtl)
#pragma unroll
    for (int kp = 0; kp < 2; ++kp) {
      const char* b = b0 + kp * 32 * RS + dtl * 32;
      vlo[0][dtl][kp] = __builtin_amdgcn_ds_read_tr16_b64_v4i16((lds_s16x4_ptr)(b));
      vhi[0][dtl][kp] = __builtin_amdgcn_ds_read_tr16_b64_v4i16((lds_s16x4_ptr)(b + 16 * RS));
    }
#pragma unroll
  for (int c = 0; c < NC; ++c) {
    if (c + 1 < NC) {
#pragma unroll
      for (int dtl = 0; dtl < 2; ++dtl)
#pragma unroll
        for (int kp = 0; kp < 2; ++kp) {
          const char* b = b0 + kp * 32 * RS + (2 * (c + 1) + dtl) * 32;
          vlo[(c + 1) & 1][dtl][kp] = __builtin_amdgcn_ds_read_tr16_b64_v4i16((lds_s16x4_ptr)(b));
          vhi[(c + 1) & 1][dtl][kp] = __builtin_amdgcn_ds_read_tr16_b64_v4i16((lds_s16x4_ptr)(b + 16 * RS));
        }
    }
#pragma unroll
    for (int dtl = 0; dtl < 2; ++dtl)
#pragma unroll
      for (int kp = 0; kp < 2; ++kp) {
        const bf16x8 vf = __builtin_shufflevector(vlo[c & 1][dtl][kp], vhi[c & 1][dtl][kp], 0, 1, 2, 3, 4, 5, 6, 7);
        O1[2 * c + dtl] = mfma16(vf, P1[kp], O1[2 * c + dtl]);
        if (NMAP == 2) O2[2 * c + dtl] = mfma16(vf, P2[kp], O2[2 * c + dtl]);
      }
    __builtin_amdgcn_sched_group_barrier(0x008, 1, 0);
    if (c + 1 < NC) __builtin_amdgcn_sched_group_barrier(0x100, 8, 0);
    __builtin_amdgcn_sched_group_barrier(0x008, 4 * NMAP - 1, 0);
    __builtin_amdgcn_sched_barrier(0);
  }
}
template <int DV>
DI void attn_pv(f32x4 (&O)[DV / 16], const bf16x8 (&P)[2], float alpha, const char* Vs, int li, int lg) {
  attn_pv_pipe<DV, 1>(O, O, P, P, alpha, alpha, Vs, li, lg);
}

DI void dil_attn_item(const Params& p, int item, char* smem) {
  const int blk = item & 31, h = (item >> 5) & 3, gb = item >> 7, g = gb % 3, bl = gb / 3;
  const int dil = (g == 0) ? 1 : (g == 1 ? 4 : 16);
  const int nb = 32 / dil, r = blk / nb, n = blk % nb;
  const int tid = otid(), lane = tid & 63, wave = tid >> 6, li = lane & 15, lg = lane >> 4;
  const u16* SEG = (const u16*)(p.ws + O_SEG);
  const long tok0 = (long)bl * S;
  const int qcol = g * 768 + h * 64, kcol = qcol + 256, vcol = qcol + 512;
  const int qi = wave * 16 + li;
  const long qtok = tok0 + (long)(n * 128 + qi) * dil + r;
  bf16x8 Qf[2];
#pragma unroll
  for (int ks = 0; ks < 2; ++ks) Qf[ks] = *(const bf16x8*)(SEG + qtok * NSG + qcol + ks * 32 + lg * 8);
  f32x4 O[4];
  float m = -INFINITY, l = 0.f, alpha;
#pragma unroll
  for (int dt = 0; dt < 4; ++dt) O[dt] = f32x4{0.f, 0.f, 0.f, 0.f};
  char* Ks = smem; char* Vs = smem + 64 * 144;
  const int kt0 = (n == 0) ? 2 : 0;
  TileRegs<64> rk, rv;
  {
    const long s0 = (long)((n - 1) * 128 + kt0 * 64) * dil + r;
    rk.load(SEG + (tok0 + s0) * NSG + kcol, (long)dil * NSG, tid);
    rv.load(SEG + (tok0 + s0) * NSG + vcol, (long)dil * NSG, tid);
  }
  for (int kt = kt0; kt < 4; ++kt) {
    __syncthreads();
    rk.store(Ks, 16, tid); rv.store(Vs, 32, tid);
    __syncthreads();
    if (kt + 1 < 4) {
      const long s0 = (long)((n - 1) * 128 + (kt + 1) * 64) * dil + r;
      rk.load(SEG + (tok0 + s0) * NSG + kcol, (long)dil * NSG, tid);
      rv.load(SEG + (tok0 + s0) * NSG + vcol, (long)dil * NSG, tid);
    }
    const int qlo = wave * 16, klo = kt * 64;
    if (klo + 63 >= qlo && klo <= qlo + 15 + 128) {
      f32x4 Sa[4];
#pragma unroll
      for (int ks = 0; ks < 4; ++ks) Sa[ks] = f32x4{0.f, 0.f, 0.f, 0.f};
      attn_scores<64>(Sa, Qf, Ks, li, lg);
#pragma unroll
      for (int ksub = 0; ksub < 4; ++ksub)
#pragma unroll
        for (int j = 0; j < 4; ++j) {
          const int kj = klo + ksub * 16 + lg * 4 + j;
          const int dist = qi + 128 - kj;
          if (dist < 0 || dist > 128) Sa[ksub][j] = -INFINITY;
        }
      bf16x8 P[2];
      softmax_step(Sa, m, l, alpha, P);
      attn_pv<64>(O, P, alpha, Vs, li, lg);
    }
  }
  u16* OG = (u16*)(p.ws + O_OG);
  float* LSE = (float*)(p.ws + O_LSE);
  float lt = l; lt += __shfl_xor(lt, 16); lt += __shfl_xor(lt, 32);
  const float inv = 1.f / lt;
#pragma unroll
  for (int dt = 0; dt < 4; ++dt) {
    u32x2 o; o[0] = pack2(O[dt][0] * inv, O[dt][1] * inv); o[1] = pack2(O[dt][2] * inv, O[dt][3] * inv);
    *(u32x2*)(OG + qtok * 768 + g * 256 + h * 64 + dt * 16 + lg * 4) = o;
  }
  if (lg == 0) LSE[qtok * 12 + g * 4 + h] = m + __logf(lt);
}

DI void diff_attn_item(const Params& p, int l_, int item, char* smem) {
  const int n = 31 - (item & 31), h = (item >> 5) & 3, bl = item >> 7;
  const int tid = otid(), lane = tid & 63, wave = tid >> 6, li = lane & 15, lg = lane >> 4;
  const u16* SEG = (const u16*)(p.ws + O_SEG);
  const long tok0 = (long)bl * S;
  const int qcol = 2304 + h * 128, kcol = 2304 + 512 + h * 128, vcol = 2304 + 1024 + h * 128;
  const int qlo = n * 128 + wave * 16;
  const int q = qlo + li;
  bf16x8 Q1[2], Q2[2];
#pragma unroll
  for (int ks = 0; ks < 2; ++ks) {
    Q1[ks] = *(const bf16x8*)(SEG + (tok0 + q) * NSG + qcol + ks * 32 + lg * 8);
    Q2[ks] = *(const bf16x8*)(SEG + (tok0 + q) * NSG + qcol + 64 + ks * 32 + lg * 8);
  }
  f32x4 O1[8], O2[8];
  float m1 = -INFINITY, l1 = 0.f, m2 = -INFINITY, l2 = 0.f, alpha;
#pragma unroll
  for (int dt = 0; dt < 8; ++dt) { O1[dt] = f32x4{0.f, 0.f, 0.f, 0.f}; O2[dt] = f32x4{0.f, 0.f, 0.f, 0.f}; }
  char* K1s = smem; char* K2s = smem + 9216; char* Vs = smem + 18432;
  TileRegs<64> rk1, rk2; TileRegs<128> rv;
  rk1.load(SEG + tok0 * NSG + kcol, NSG, tid);
  rk2.load(SEG + tok0 * NSG + kcol + 64, NSG, tid);
  rv.load(SEG + tok0 * NSG + vcol, NSG, tid);
  const int nt = 2 * n + 2;
  for (int kt = 0; kt < nt; ++kt) {
    __syncthreads();
    rk1.store(K1s, 16, tid); rk2.store(K2s, 16, tid); rv.store(Vs, 32, tid);
    __syncthreads();
    if (kt + 1 < nt) {
      const long kr = tok0 + (kt + 1) * 64;
      rk1.load(SEG + kr * NSG + kcol, NSG, tid);
      rk2.load(SEG + kr * NSG + kcol + 64, NSG, tid);
      rv.load(SEG + kr * NSG + vcol, NSG, tid);
    }
    const int klo = kt * 64;
    if (klo <= qlo + 15) {
      const bool need_mask = (klo + 63 > qlo);
      bf16x8 P[2], Pb[2];
      float alpha2;
      f32x4 Sa[4], Sb[4];
#pragma unroll
      for (int ks = 0; ks < 4; ++ks) { Sa[ks] = f32x4{0.f, 0.f, 0.f, 0.f}; Sb[ks] = f32x4{0.f, 0.f, 0.f, 0.f}; }
      attn_scores<64>(Sa, Q1, K1s, li, lg);
      attn_scores<64>(Sb, Q2, K2s, li, lg);
      if (need_mask) {
#pragma unroll
        for (int ksub = 0; ksub < 4; ++ksub)
#pragma unroll
          for (int j = 0; j < 4; ++j) if (klo + ksub * 16 + lg * 4 + j > q) { Sa[ksub][j] = -INFINITY; Sb[ksub][j] = -INFINITY; }
      }
      softmax_step(Sa, m1, l1, alpha, P);
      softmax_step(Sb, m2, l2, alpha2, Pb);
      attn_pv_pipe<128, 2>(O1, O2, P, Pb, alpha, alpha2, Vs, li, lg);
    }
  }
  float lt1 = l1; lt1 += __shfl_xor(lt1, 16); lt1 += __shfl_xor(lt1, 32);
  float lt2 = l2; lt2 += __shfl_xor(lt2, 16); lt2 += __shfl_xor(lt2, 32);
  const float lam = ((const float*)(p.ws + O_SCAL))[l_];
  const float lam_init = (l_ == 0) ? 0.2f : 0.355509067591f;
  const float i1 = 1.f / lt1, i2 = lam / lt2;
  float ss = 0.f;
#pragma unroll
  for (int dt = 0; dt < 8; ++dt)
#pragma unroll
    for (int j = 0; j < 4; ++j) { const float o = O1[dt][j] * i1 - O2[dt][j] * i2; O1[dt][j] = o; ss += o * o; }
  ss += __shfl_xor(ss, 16); ss += __shfl_xor(ss, 32);
  const float rstd = (1.f - lam_init) / sqrtf(ss * (1.f / 128.f) + EPS);
  const float* ng = p.in[6] + l_ * 128;
  u16* Y = (u16*)(p.ws + O_Y);
#pragma unroll
  for (int dt = 0; dt < 8; ++dt) {
    const int dv = dt * 16 + lg * 4;
    const float4 gg = *(const float4*)(ng + dv);
    u32x2 o; o[0] = pack2(O1[dt][0] * rstd * gg.x, O1[dt][1] * rstd * gg.y); o[1] = pack2(O1[dt][2] * rstd * gg.z, O1[dt][3] * rstd * gg.w);
    *(u32x2*)(Y + (tok0 + q) * YW + 256 + h * 128 + dv) = o;
  }
}

DI void cross_attn_item(const Params& p, int l_, int grp, int item, char* smem) {
  const int qb = item & 31, hm = (item >> 5) & 3, bl = item >> 7;
  const int tid = otid(), lane = tid & 63, wave = tid >> 6, li = lane & 15, lg = lane >> 4;
  const u16* Q = (const u16*)(p.ws + O_Q);
  const u16* KV = (const u16*)(p.ws + O_KV) + (size_t)l_ * 4096 * 2048 + (size_t)(grp * BG + bl) * 256 * 2048;
  const long tok = (long)bl * S + qb * 128 + wave * 16 + li;
  bf16x8 Qf[8];
#pragma unroll
  for (int ks = 0; ks < 8; ++ks) Qf[ks] = *(const bf16x8*)(Q + tok * 1024 + hm * 256 + ks * 32 + lg * 8);
  f32x4 O[16];
#pragma unroll
  for (int dt = 0; dt < 16; ++dt) O[dt] = f32x4{0.f, 0.f, 0.f, 0.f};
  float m = -INFINITY, l = 0.f, alpha;
  char* Ks = smem; char* Vs = smem + 64 * 528;
  TileRegs<256> rk, rv;
  rk.load(KV + hm * 256, 2048, tid);
  rv.load(KV + 1024 + hm * 256, 2048, tid);
  for (int kt = 0; kt < 4; ++kt) {
    __syncthreads();
    rk.store(Ks, 16, tid); rv.store(Vs, 32, tid);
    __syncthreads();
    if (kt + 1 < 4) {
      rk.load(KV + (size_t)((kt + 1) * 64) * 2048 + hm * 256, 2048, tid);
      rv.load(KV + (size_t)((kt + 1) * 64) * 2048 + 1024 + hm * 256, 2048, tid);
    }
    f32x4 Sa[4];
#pragma unroll
    for (int ks = 0; ks < 4; ++ks) Sa[ks] = f32x4{0.f, 0.f, 0.f, 0.f};
    attn_scores<256>(Sa, Qf, Ks, li, lg);
    bf16x8 P[2];
    softmax_step(Sa, m, l, alpha, P);
    attn_pv<256>(O, P, alpha, Vs, li, lg);
  }
  float lt = l; lt += __shfl_xor(lt, 16); lt += __shfl_xor(lt, 32);
  const float inv = 1.f / lt;
  u16* OB = (u16*)(p.ws + O_O);
#pragma unroll
  for (int dt = 0; dt < 16; ++dt) {
    u32x2 o; o[0] = pack2(O[dt][0] * inv, O[dt][1] * inv); o[1] = pack2(O[dt][2] * inv, O[dt][3] * inv);
    *(u32x2*)(OB + tok * 1024 + hm * 256 + dt * 16 + lg * 4) = o;
  }
}

template <int PASS>
DI void hgrn_item(const Params& p, int l_, int item, char* smem) {
  const int c = item & 31, h = (item >> 5) & 3, bl = item >> 7;
  const int tid = otid(), v = tid & 63, kq = tid >> 6;
  float* sF = (float*)smem;
  float* sK = sF + 1024;
  float* sQ = sK + 1024;
  float* sI = sQ + 1024;
  float* sG = sI + 1024;
  float* sO = sG + 1024;
  const u16* SEG = (const u16*)(p.ws + O_SEG);
  float* HGS = (float*)(p.ws + O_HGS);
  float* HGF = (float*)(p.ws + O_HGF);
  const int arr = tid >> 7, stok = (tid >> 3) & 15, sch = tid & 7;
  const bool ld_on = (PASS == 3) || (arr == 1) || (arr == 2);
  const u16* sbase = SEG + ((size_t)bl * S + c * 128 + stok) * NSG + 3840 + arr * 256 + h * 64 + sch * 8;
  float lbv[8];
#pragma unroll
  for (int e = 0; e < 8; ++e) {
    lbv[e] = 0.f;
    if (l_ == 1) { const float* lg0 = p.in[7]; const int k = h * 64 + sch * 8 + e; lbv[e] = 1.f / (1.f + __expf(lg0[k] - lg0[256 + k])); }
  }
  u32x4 pre = u32x4{0u, 0u, 0u, 0u};
  if (ld_on) pre = *(const u32x4*)sbase;
  float s[8], Fp[8];
#pragma unroll
  for (int e = 0; e < 8; ++e) { s[e] = 0.f; Fp[e] = 1.f; }
  if (PASS == 3) {
#pragma unroll 4
    for (int cc = 0; cc < c; ++cc) {
      const size_t it = (size_t)((bl * 4 + h) * 32 + cc);
      const float* st = HGS + it * 4096;
      const float* ff = HGF + it * 64;
#pragma unroll
      for (int e = 0; e < 8; ++e) { const int k = kq * 8 + e; s[e] = ff[k] * s[e] + st[k * 64 + v]; }
    }
  }
#pragma unroll 1
  for (int sub = 0; sub < 8; ++sub) {
    const int t0 = c * 128 + sub * 16;
    __syncthreads();
    if (ld_on) {
      float x[8];
      x[0] = bflo(pre[0]); x[1] = bfhi(pre[0]); x[2] = bflo(pre[1]); x[3] = bfhi(pre[1]);
      x[4] = bflo(pre[2]); x[5] = bfhi(pre[2]); x[6] = bflo(pre[3]); x[7] = bfhi(pre[3]);
      const int o = stok * 64 + sch * 8;
      if (arr == 1) {
#pragma unroll
        for (int e = 0; e < 8; ++e) { sF[o + e] = lbv[e] + (1.f - lbv[e]) * sigm(x[e]); sK[o + e] = (1.f - lbv[e]) * sigm(-x[e]); }
      } else if (arr == 2) {
#pragma unroll
        for (int e = 0; e < 8; ++e) sI[o + e] = x[e];
      } else if (arr == 0) {
#pragma unroll
        for (int e = 0; e < 8; ++e) sQ[o + e] = silu(x[e]);
      } else {
#pragma unroll
        for (int e = 0; e < 8; ++e) sG[o + e] = silu(x[e]);
      }
    }
    __syncthreads();
    if (ld_on && sub + 1 < 8) pre = *(const u32x4*)(sbase + (size_t)(sub + 1) * 16 * NSG);
    {
      float ivn = sI[v];
      float4 fn[2], kn[2], qn[2];
#pragma unroll
      for (int e4 = 0; e4 < 2; ++e4) {
        fn[e4] = *(const float4*)(sF + kq * 8 + e4 * 4); kn[e4] = *(const float4*)(sK + kq * 8 + e4 * 4);
        if (PASS == 3) qn[e4] = *(const float4*)(sQ + kq * 8 + e4 * 4);
      }
#pragma unroll 4
      for (int tt = 0; tt < 16; ++tt) {
        const float iv = ivn;
        float4 fc[2], kc[2], qc[2];
#pragma unroll
        for (int e4 = 0; e4 < 2; ++e4) { fc[e4] = fn[e4]; kc[e4] = kn[e4]; if (PASS == 3) qc[e4] = qn[e4]; }
        {
          const int tn = (tt + 1) & 15;
          ivn = sI[tn * 64 + v];
#pragma unroll
          for (int e4 = 0; e4 < 2; ++e4) {
            fn[e4] = *(const float4*)(sF + tn * 64 + kq * 8 + e4 * 4); kn[e4] = *(const float4*)(sK + tn * 64 + kq * 8 + e4 * 4);
            if (PASS == 3) qn[e4] = *(const float4*)(sQ + tn * 64 + kq * 8 + e4 * 4);
          }
        }
        __builtin_amdgcn_sched_barrier(0);
        float o = 0.f;
#pragma unroll
        for (int e4 = 0; e4 < 2; ++e4) {
          const float4 f4 = fc[e4], k4 = kc[e4];
          s[e4 * 4 + 0] = f4.x * s[e4 * 4 + 0] + k4.x * iv;
          s[e4 * 4 + 1] = f4.y * s[e4 * 4 + 1] + k4.y * iv;
          s[e4 * 4 + 2] = f4.z * s[e4 * 4 + 2] + k4.z * iv;
          s[e4 * 4 + 3] = f4.w * s[e4 * 4 + 3] + k4.w * iv;
          if (PASS == 1) { Fp[e4 * 4 + 0] *= f4.x; Fp[e4 * 4 + 1] *= f4.y; Fp[e4 * 4 + 2] *= f4.z; Fp[e4 * 4 + 3] *= f4.w; }
          if (PASS == 3) {
            const float4 q4 = qc[e4];
            o += s[e4 * 4 + 0] * q4.x + s[e4 * 4 + 1] * q4.y + s[e4 * 4 + 2] * q4.z + s[e4 * 4 + 3] * q4.w;
          }
        }
        if (PASS == 3) sO[(tt * 8 + kq) * 64 + v] = o;
        __builtin_amdgcn_sched_barrier(0);
      }
    }
    if (PASS == 3) {
      __syncthreads();
      u16* Y = (u16*)(p.ws + O_Y);
      const float* ng = p.in[8] + l_ * 64;
#pragma unroll
      for (int i = 0; i < 2; ++i) {
        const int tt = i * 8 + kq;
        float o = 0.f;
#pragma unroll
        for (int qq = 0; qq < 8; ++qq) o += sO[(tt * 8 + qq) * 64 + v];
        const float ss = wave_sum(o * o);
        const float rstd = 1.0f / sqrtf(ss * (1.f / 64.f) + EPS);
        const size_t tok = (size_t)bl * S + t0 + tt;
        Y[tok * YW + 768 + h * 64 + v] = f2bf(o * rstd * ng[v] * sG[tt * 64 + v]);
      }
    }
  }
  if (PASS == 1) {
#pragma unroll
    for (int e = 0; e < 8; ++e) {
      HGS[(size_t)item * 4096 + (kq * 8 + e) * 64 + v] = s[e];
      if (v == 0) HGF[(size_t)item * 64 + kq * 8 + e] = Fp[e];
    }
  }
}

DI void rwkv_prep_item(const Params& p, int l_, int item, char* smem) {
  const int tid = otid(), lane = tid & 63, wave = tid >> 6, c = tid & 255, half = tid >> 8;
  float* lin = (float*)smem;
  float* vv = lin + 4096;
  float* t1 = vv + 4096;
  float* sV1 = t1 + 512;
  const u16* SEGD = (const u16*)(p.ws + O_SEGD);
  const float* mu = p.in[9] + l_ * 1024;
  const size_t tokb = (size_t)item * 16 + half * 8;
  u16* VF = (u16*)(p.ws + O_VFIRST);
  float xr[8], xk[8];
  float vfv[8];
  __syncthreads();
  {
    const float mr = mu[c], mk = mu[256 + c], mv = mu[512 + c], ml = mu[768 + c];
    u16 raw[9][4];
    const bool first0 = ((tokb & (S - 1)) == 0);
#pragma unroll
    for (int rr = 0; rr < 9; ++rr) {
      const u16* row = SEGD + (tokb + rr - 1) * 1024;
      if (rr == 0 && first0) { raw[rr][0] = 0; raw[rr][1] = 0; raw[rr][2] = 0; raw[rr][3] = 0; }
      else { raw[rr][0] = row[c]; raw[rr][1] = row[256 + c]; raw[rr][2] = row[512 + c]; raw[rr][3] = row[768 + c]; }
    }
    if (l_ == 1) {
#pragma unroll
      for (int tk = 0; tk < 8; ++tk) vfv[tk] = bf2f(VF[(tokb + tk) * 256 + c]);
      const float4* v1 = (const float4*)p.in[21];
#pragma unroll
      for (int i = 0; i < 4; ++i) ((float4*)sV1)[tid + NTH * i] = v1[tid + NTH * i];
    }
#pragma unroll
    for (int tk = 0; tk < 8; ++tk) {
      float a, b;
      a = bf2f(raw[tk + 1][0]); b = bf2f(raw[tk][0]); xr[tk] = a + (b - a) * mr;
      a = bf2f(raw[tk + 1][1]); b = bf2f(raw[tk][1]); xk[tk] = a + (b - a) * mk;
      a = bf2f(raw[tk + 1][2]); b = bf2f(raw[tk][2]); const float xv_ = a + (b - a) * mv;
      a = bf2f(raw[tk + 1][3]); b = bf2f(raw[tk][3]);
      float x = a + (b - a) * ml;
      if (c < 64) x = 1.f - 2.f / (__expf(2.f * x) + 1.f);
      else if (c >= 128) x = sigm(x);
      lin[(half * 8 + tk) * 256 + c] = x;
      vv[(half * 8 + tk) * 256 + c] = xv_;
    }
  }
  __syncthreads();
  float lw[8], la[8], lgg[8];
#pragma unroll
  for (int tk = 0; tk < 8; ++tk) { lw[tk] = 0.f; la[tk] = 0.f; lgg[tk] = 0.f; }
  const float* w2 = p.in[11] + l_ * 64 * 256;
  const float* a2 = p.in[13] + l_ * 64 * 256;
  const float* g2 = p.in[14] + l_ * 128 * 256;
  float wn[16];
#pragma unroll
  for (int j = 0; j < 16; ++j) wn[j] = w2[j * 256 + c];
#pragma unroll 1
  for (int ch = 0; ch < 16; ++ch) {
    float wr[16];
#pragma unroll
    for (int j = 0; j < 16; ++j) wr[j] = wn[j];
    if (ch + 1 < 16) {
      const int cn = ch + 1;
      const float* wsrc = (cn < 4) ? (w2 + cn * 16 * 256) : (cn < 8 ? (a2 + (cn - 4) * 16 * 256) : (g2 + (cn - 8) * 16 * 256));
#pragma unroll
      for (int j = 0; j < 16; ++j) wn[j] = wsrc[j * 256 + c];
    }
#pragma unroll
    for (int tk = 0; tk < 8; ++tk) {
      float acc = 0.f;
#pragma unroll
      for (int j4 = 0; j4 < 4; ++j4) {
        const float4 x4 = *(const float4*)(lin + (half * 8 + tk) * 256 + ch * 16 + j4 * 4);
        acc += x4.x * wr[j4 * 4] + x4.y * wr[j4 * 4 + 1] + x4.z * wr[j4 * 4 + 2] + x4.w * wr[j4 * 4 + 3];
      }
      if (ch < 4) lw[tk] += acc; else if (ch < 8) la[tk] += acc; else lgg[tk] += acc;
    }
  }
  float vmixw[8];
  if (l_ == 1) {
    {
      const int tk = tid >> 5, j0 = tid & 31;
      float a0 = 0.f, a1 = 0.f;
#pragma unroll 8
      for (int cc = 0; cc < 256; cc += 2) { a0 += vv[tk * 256 + cc] * sV1[cc * 32 + j0]; a1 += vv[tk * 256 + cc + 1] * sV1[(cc + 1) * 32 + j0]; }
      t1[tk * 32 + j0] = a0 + a1;
    }
    const float* v2 = p.in[22];
    float wr[32];
#pragma unroll
    for (int j = 0; j < 32; ++j) wr[j] = v2[j * 256 + c];
    __syncthreads();
#pragma unroll
    for (int tk = 0; tk < 8; ++tk) {
      float acc = 0.f;
#pragma unroll
      for (int j4 = 0; j4 < 8; ++j4) {
        const float4 x4 = *(const float4*)(t1 + (half * 8 + tk) * 32 + j4 * 4);
        acc += x4.x * wr[j4 * 4] + x4.y * wr[j4 * 4 + 1] + x4.z * wr[j4 * 4 + 2] + x4.w * wr[j4 * 4 + 3];
      }
      vmixw[tk] = acc;
    }
  }
  const float w0 = p.in[10][l_ * 256 + c], a0 = p.in[12][l_ * 256 + c];
  const float k_k = p.in[15][l_ * 256 + c], k_a = p.in[16][l_ * 256 + c], r_k = p.in[17][l_ * 256 + c];
  const float v0 = (l_ == 1) ? p.in[20][c] : 0.f;
  u16* RWR = (u16*)(p.ws + O_RWR); u16* RWK = (u16*)(p.ws + O_RWK); u16* RWV = (u16*)(p.ws + O_RWV);
  u16* RWKK = (u16*)(p.ws + O_RWKK); u16* RWKKA = (u16*)(p.ws + O_RWKKA); u16* RWG = (u16*)(p.ws + O_RWG);
  float* RWW = (float*)(p.ws + O_RWW); float* RWRK = (float*)(p.ws + O_RWRK);
#pragma unroll
  for (int tk = 0; tk < 8; ++tk) {
    const size_t tok = tokb + tk;
    const float xv_ = vv[(half * 8 + tk) * 256 + c];
    const float u = w0 + lw[tk];
    const float z = -u;
    const float sp = fmaxf(z, 0.f) + __logf(1.f + __expf(-fabsf(z)));
    const float wv = -sp - 0.5f;
    const float decay = __expf(-__expf(wv));
    const float a = sigm(a0 + la[tk]);
    const float kkx = xk[tk] * k_k;
    const float nrm = sqrtf(wave_sum(kkx * kkx));
    const float kkn = kkx / fmaxf(nrm, 1e-12f);
    const float k2 = xk[tk] * (1.f + (a - 1.f) * k_a);
    float v2v = xv_;
    if (l_ == 0) VF[tok * 256 + c] = f2bf(v2v);
    else v2v = v2v + (vfv[tk] - v2v) * sigm(v0 + vmixw[tk]);
    const float rk = wave_sum(xr[tk] * k2 * r_k);
    RWR[tok * 256 + c] = f2bf(xr[tk]);
    RWK[tok * 256 + c] = f2bf(k2);
    RWV[tok * 256 + c] = f2bf(v2v);
    RWKK[tok * 256 + c] = f2bf(kkn);
    RWKKA[tok * 256 + c] = f2bf(kkn * a);
    RWG[tok * 256 + c] = f2bf(lgg[tk]);
    RWW[tok * 256 + c] = decay;
    if (lane == 0) RWRK[tok * 4 + (wave & 3)] = rk;
  }
}

DI void rwkv_scan_item(const Params& p, int item, char* smem) {
  const int rg = item & 1, h = (item >> 1) & 3, b = item >> 3;
  const int tid = otid(), lane = tid & 63, wave = tid >> 6, kap = lane & 15, rho = lane >> 4;
  const int rowh = rg * 32 + wave * 4 + rho;
  float* sW = (float*)smem;
  float* sKK = sW + 2048;
  float* sKA = sKK + 2048;
  float* sK = sKA + 2048;
  float* sR = sK + 2048;
  float* sV = sR + 2048;
  float* sY = sV + 2048;
  const float* RWW = (const float*)(p.ws + O_RWW);
  const u16* RWR = (const u16*)(p.ws + O_RWR); const u16* RWK = (const u16*)(p.ws + O_RWK); const u16* RWV = (const u16*)(p.ws + O_RWV);
  const u16* RWKK = (const u16*)(p.ws + O_RWKK); const u16* RWKKA = (const u16*)(p.ws + O_RWKKA);
  float* RWY = (float*)(p.ws + O_RWY);
  const size_t tokb = (size_t)b * S;
  u32x4 pw, pa, pb, pv;
  const int wtok = tid >> 4, wch = tid & 15;
  const int hsel = tid >> 8, btok = (tid & 255) >> 3, bch = tid & 7;
  const u16* arrA = hsel ? RWKKA : RWKK;
  const u16* arrB = hsel ? RWR : RWK;
  float* dstA = hsel ? sKA : sKK;
  float* dstB = hsel ? sR : sK;
  const float sgnA = hsel ? 1.f : -1.f;
  pv = u32x4{0u, 0u, 0u, 0u};
  float S0 = 0.f, S1 = 0.f, S2 = 0.f, S3 = 0.f;
  {
    pw = *(const u32x4*)(RWW + (tokb + wtok) * 256 + h * 64 + wch * 4);
    const size_t off = (tokb + btok) * 256 + h * 64 + bch * 8;
    pa = *(const u32x4*)(arrA + off); pb = *(const u32x4*)(arrB + off);
    if (hsel == 0) pv = *(const u32x4*)(RWV + off);
  }
#pragma unroll 1
  for (int c = 0; c < S / 32; ++c) {
    __syncthreads();
    *(u32x4*)(sW + wtok * 64 + wch * 4) = pw;
    {
      float* da = dstA + btok * 64 + bch * 8; float* db = dstB + btok * 64 + bch * 8;
      *(f32x4*)(da) = f32x4{bflo(pa[0]) * sgnA, bfhi(pa[0]) * sgnA, bflo(pa[1]) * sgnA, bfhi(pa[1]) * sgnA};
      *(f32x4*)(da + 4) = f32x4{bflo(pa[2]) * sgnA, bfhi(pa[2]) * sgnA, bflo(pa[3]) * sgnA, bfhi(pa[3]) * sgnA};
      *(f32x4*)(db) = f32x4{bflo(pb[0]), bfhi(pb[0]), bflo(pb[1]), bfhi(pb[1])};
      *(f32x4*)(db + 4) = f32x4{bflo(pb[2]), bfhi(pb[2]), bflo(pb[3]), bfhi(pb[3])};
      if (hsel == 0) {
        float* dv = sV + btok * 64 + bch * 8;
        *(f32x4*)(dv) = f32x4{bflo(pv[0]), bfhi(pv[0]), bflo(pv[1]), bfhi(pv[1])};
        *(f32x4*)(dv + 4) = f32x4{bflo(pv[2]), bfhi(pv[2]), bflo(pv[3]), bfhi(pv[3])};
      }
    }
    __syncthreads();
    if (c + 1 < S / 32) {
      const size_t t0 = tokb + (size_t)(c + 1) * 32;
      pw = *(const u32x4*)(RWW + (t0 + wtok) * 256 + h * 64 + wch * 4);
      const size_t off = (t0 + btok) * 256 + h * 64 + bch * 8;
      pa = *(const u32x4*)(arrA + off); pb = *(const u32x4*)(arrB + off);
      if (hsel == 0) pv = *(const u32x4*)(RWV + off);
    }
    f32x4 w4n = *(const f32x4*)(sW + kap * 4), nk4n = *(const f32x4*)(sKK + kap * 4), ka4n = *(const f32x4*)(sKA + kap * 4);
    f32x4 k4n = *(const f32x4*)(sK + kap * 4), r4n = *(const f32x4*)(sR + kap * 4);
    float vvn = sV[rowh];
    f32x4 rprev = f32x4{0.f, 0.f, 0.f, 0.f};
#pragma unroll 4
    for (int tt = 0; tt < 32; ++tt) {
      const f32x4 w4 = w4n, nk4 = nk4n, ka4 = ka4n, k4 = k4n, r4 = r4n;
      const float vv = vvn;
      {
        const int tn = (tt + 1) & 31;
        w4n = *(const f32x4*)(sW + tn * 64 + kap * 4); nk4n = *(const f32x4*)(sKK + tn * 64 + kap * 4); ka4n = *(const f32x4*)(sKA + tn * 64 + kap * 4);
        k4n = *(const f32x4*)(sK + tn * 64 + kap * 4); r4n = *(const f32x4*)(sR + tn * 64 + kap * 4);
        vvn = sV[tn * 64 + rowh];
      }
      __builtin_amdgcn_sched_barrier(0);
      float sa, y;
      float u0, u1, u2, u3;
      {
        float a1 = S0 * nk4[0], b1 = S0 * rprev[0];
        float a2 = S2 * nk4[2], b2 = S2 * rprev[2];
        a1 = fmaf(S1, nk4[1], a1); b1 = fmaf(S1, rprev[1], b1);
        a2 = fmaf(S3, nk4[3], a2); b2 = fmaf(S3, rprev[3], b2);
        sa = a1 + a2; y = b1 + b2;
        u0 = vv * k4[0]; u1 = vv * k4[1];
        sa += dpp_mov<0xB1>(sa);  y += dpp_mov<0xB1>(y);
        u2 = vv * k4[2]; u3 = vv * k4[3];
        sa += dpp_mov<0x4E>(sa);  y += dpp_mov<0x4E>(y);
        u0 = fmaf(S0, w4[0], u0); u1 = fmaf(S1, w4[1], u1);
        sa += dpp_mov<0x141>(sa); y += dpp_mov<0x141>(y);
        u2 = fmaf(S2, w4[2], u2); u3 = fmaf(S3, w4[3], u3);
        sa += dpp_mov<0x140>(sa); y += dpp_mov<0x140>(y);
      }
      if (tt > 0 && kap == 0) sY[(tt - 1) * 32 + wave * 4 + rho] = y;
      S0 = fmaf(sa, ka4[0], u0);
      S1 = fmaf(sa, ka4[1], u1);
      S2 = fmaf(sa, ka4[2], u2);
      S3 = fmaf(sa, ka4[3], u3);
      rprev = r4;
      __builtin_amdgcn_sched_barrier(0);
    }
    {
      float y = (S0 * rprev[0] + S1 * rprev[1]) + (S2 * rprev[2] + S3 * rprev[3]);
      y = red16(y);
      if (kap == 0) sY[31 * 32 + wave * 4 + rho] = y;
    }
    __syncthreads();
    {
      const size_t t0 = tokb + (size_t)c * 32;
#pragma unroll
      for (int i = 0; i < 2; ++i) {
        const int idx = tid + NTH * i, tt = idx >> 5, rr = idx & 31;
        RWY[(t0 + tt) * 256 + h * 64 + rg * 32 + rr] = sY[idx];
      }
    }
  }
}

DI void rwkv_post_item(const Params& p, int l_, int item) {
  const int tid = otid(), lane = tid & 63, wave = tid >> 6, hd = lane >> 4, c = hd * 64 + (lane & 15) * 4;
  const float* RWY = (const float*)(p.ws + O_RWY);
  const float* RWRK = (const float*)(p.ws + O_RWRK);
  const u16* RWV = (const u16*)(p.ws + O_RWV); const u16* RWG = (const u16*)(p.ws + O_RWG);
  u16* YD = (u16*)(p.ws + O_YD);
  const f32x4 lg = *(const f32x4*)(p.in[18] + l_ * 256 + c), lb = *(const f32x4*)(p.in[19] + l_ * 256 + c);
#pragma unroll 1
  for (int ps = 0; ps < 2; ++ps) {
    f32x4 y[4]; u32x2 v2[4], g2[4]; float rk[4];
#pragma unroll
    for (int u = 0; u < 4; ++u) {
      const size_t tok = (size_t)item * 64 + (ps * 4 + u) * 8 + wave;
      y[u] = *(const f32x4*)(RWY + tok * 256 + c);
      v2[u] = *(const u32x2*)(RWV + tok * 256 + c); g2[u] = *(const u32x2*)(RWG + tok * 256 + c);
      rk[u] = RWRK[tok * 4 + hd];
    }
#pragma unroll
    for (int u = 0; u < 4; ++u) {
      const size_t tok = (size_t)item * 64 + (ps * 4 + u) * 8 + wave;
      const float mean = red16((y[u][0] + y[u][1]) + (y[u][2] + y[u][3])) * (1.f / 64.f);
      const f32x4 d = y[u] - mean;
      const float var = red16((d[0] * d[0] + d[1] * d[1]) + (d[2] * d[2] + d[3] * d[3])) * (1.f / 64.f);
      const float rs = 1.0f / sqrtf(var + 64e-5f);
      f32x4 o;
      o[0] = (d[0] * rs * lg[0] + lb[0] + rk[u] * bflo(v2[u][0])) * bflo(g2[u][0]);
      o[1] = (d[1] * rs * lg[1] + lb[1] + rk[u] * bfhi(v2[u][0])) * bfhi(g2[u][0]);
      o[2] = (d[2] * rs * lg[2] + lb[2] + rk[u] * bflo(v2[u][1])) * bflo(g2[u][1]);
      o[3] = (d[3] * rs * lg[3] + lb[3] + rk[u] * bfhi(v2[u][1])) * bfhi(g2[u][1]);
      *(u32x2*)(YD + tok * 256 + c) = pack4(o);
    }
  }
}

DI void dil_combine_item(const Params& p, int item) {
  const int tid = otid(), ch = tid & 31, tl = tid >> 5, h = ch >> 3;
  const u16* OG = (const u16*)(p.ws + O_OG);
  const float* LSE = (const float*)(p.ws + O_LSE);
  u16* Y = (u16*)(p.ws + O_Y);
  u32x4 o0[4], o1[4], o2[4]; float l0[4], l1[4], l2[4];
#pragma unroll
  for (int ps = 0; ps < 4; ++ps) {
    const size_t tok = (size_t)item * 64 + ps * 16 + tl;
    o0[ps] = *(const u32x4*)(OG + tok * 768 + ch * 8);
    o1[ps] = *(const u32x4*)(OG + tok * 768 + 256 + ch * 8);
    o2[ps] = *(const u32x4*)(OG + tok * 768 + 512 + ch * 8);
    l0[ps] = LSE[tok * 12 + h]; l1[ps] = LSE[tok * 12 + 4 + h]; l2[ps] = LSE[tok * 12 + 8 + h];
  }
#pragma unroll
  for (int ps = 0; ps < 4; ++ps) {
    const size_t tok = (size_t)item * 64 + ps * 16 + tl;
    const float mx = fmaxf(l0[ps], fmaxf(l1[ps], l2[ps]));
    float e0 = __expf(l0[ps] - mx), e1 = __expf(l1[ps] - mx), e2 = __expf(l2[ps] - mx);
    const float inv = 1.f / (e0 + e1 + e2);
    e0 *= inv; e1 *= inv; e2 *= inv;
    u32x4 r;
#pragma unroll
    for (int q = 0; q < 4; ++q)
      r[q] = pack2(e0 * bflo(o0[ps][q]) + e1 * bflo(o1[ps][q]) + e2 * bflo(o2[ps][q]), e0 * bfhi(o0[ps][q]) + e1 * bfhi(o1[ps][q]) + e2 * bfhi(o2[ps][q]));
    *(u32x4*)(Y + tok * YW + ch * 8) = r;
  }
}

DI int next_item(int* counter, int* s_item) {
  __syncthreads();
  if (otid() == 0) *s_item = atomicAdd(counter, 1);
  __syncthreads();
  return *s_item;
}
constexpr int N_DIL = BG * 3 * 4 * 32, N_HG = BG * 4 * 32;
constexpr int N_SCAN = NB * 8, N_DIFF = BG * 4 * 32, N_COMB = TG / 64;

DI void phase_stage1(const Params& p, int l, int grp, char* smem, int* s_item) {
  int* counter = (int*)(p.ws + O_CNT) + (l * NGRP + grp) * 2;
  const int nscan = (grp == 0) ? N_SCAN : 0;
  for (;;) {
    int it = next_item(counter, s_item);
    if (it >= nscan + N_DIFF + N_DIL + N_HG) break;
    if (it < nscan) { rwkv_scan_item(p, it, smem); continue; }
    it -= nscan;
    if (it < N_DIFF) { diff_attn_item(p, l, it, smem); continue; }
    it -= N_DIFF;
    if (it < N_DIL) dil_attn_item(p, it, smem);
    else hgrn_item<1>(p, l, it - N_DIL, smem);
  }
}
DI void phase_stage2(const Params& p, int l, int grp, char* smem, int* s_item) {
  int* counter = (int*)(p.ws + O_CNT) + (l * NGRP + grp) * 2 + 1;
  for (;;) {
    int it = next_item(counter, s_item);
    if (it >= N_HG + N_COMB) break;
    if (it < N_HG) hgrn_item<3>(p, l, it, smem);
    else dil_combine_item(p, it - N_HG);
  }
}

DI void phase_merge(const Params& p, int l, int grp, char* smem) {
  const u16* Y = (const u16*)(p.ws + O_Y);
  const u16* YD = (const u16*)(p.ws + O_YD) + (size_t)grp * TG * 256;
  const u16* SEG = (const u16*)(p.ws + O_SEG);
  u16* MG = (u16*)(p.ws + O_MERGED);
  auto sel = [&](int i, int mt, int nt, const u16*& Ai, int& lda, const u16*& Bi, int& Ki) {
    if (i == 0) { Ki = 256; Ai = Y + (size_t)mt * 128 * YW; lda = YW; Bi = (const u16*)(p.ws + O_PA) + (size_t)l * E_PA + (size_t)(nt * 256) * 256; }
    else if (i == 1) { Ki = 512; Ai = Y + (size_t)mt * 128 * YW + 256; lda = YW; Bi = (const u16*)(p.ws + O_PB) + (size_t)l * E_PB + (size_t)(nt * 256) * 512; }
    else if (i == 2) { Ki = 256; Ai = Y + (size_t)mt * 128 * YW + 768; lda = YW; Bi = (const u16*)(p.ws + O_PC) + (size_t)l * E_PC + (size_t)(nt * 256) * 256; }
    else { Ki = 256; Ai = YD + (size_t)mt * 128 * 256; lda = 256; Bi = (const u16*)(p.ws + O_PD) + (size_t)l * E_PD + (size_t)(nt * 256) * 256; }
  };
  TileWalk<8> tw(TG / 128, 4);
  int mt = 0, nt = 0, rb = 0;
  bool have = tw.next(mt, nt);
  if (have) {
    const u16* A0; const u16* B0; int lda0, K0; sel(0, mt, nt, A0, lda0, B0, K0);
    __syncthreads();
    gemm_issue0<4>(A0, lda0, B0, K0, smem, rb);
  }
  while (have) {
    int mt2 = 0, nt2 = 0;
    const bool have2 = tw.next(mt2, nt2);
    f32x4 accm[4][4]; zero_acc<4>(accm);
#pragma unroll 1
    for (int i = 0; i < 4; ++i) {
      f32x4 accp[4][4];
      zero_acc<4>(accp);
      const u16* Ai; const u16* Bi; int Ki, lda; sel(i, mt, nt, Ai, lda, Bi, Ki);
      gemm_run<4>(accp, Ai, lda, Bi, Ki, Ki, smem, true, rb);
      if (i < 3) { const u16* An; const u16* Bn; int ldn, Kn; sel(i + 1, mt, nt, An, ldn, Bn, Kn); gemm_issue0<4>(An, ldn, Bn, Kn, smem, rb); }
      else if (have2) { const u16* An; const u16* Bn; int ldn, Kn; sel(0, mt2, nt2, An, ldn, Bn, Kn); gemm_issue0<4>(An, ldn, Bn, Kn, smem, rb); }
      int mtx = mt; asm volatile("" : "+s"(mtx));
      const u16* gb = SEG + (size_t)mtx * 128 * NSG + GOFF + i * 1024 + nt * 256;
      epi_foreach<4>(accp, [&](int mi, int ni, int r, int c, f32x4& v) {
        const u32x2 g = *(const u32x2*)(gb + (unsigned)(r * NSG + c));
        accm[mi][ni][0] += bflo(g[0]) * v[0]; accm[mi][ni][1] += bfhi(g[0]) * v[1];
        accm[mi][ni][2] += bflo(g[1]) * v[2]; accm[mi][ni][3] += bfhi(g[1]) * v[3];
      });
    }
    u16* mgb = MG + (size_t)mt * 128 * 1024 + nt * 256;
    epi_foreach<4>(accm, [&](int mi, int ni, int r, int c, f32x4& v) { *(u32x2*)(mgb + (unsigned)(r * 1024 + c)) = pack4(v); });
    mt = mt2; nt = nt2; have = have2;
  }
}

enum { EPI_RESID = 0, EPI_BF16 = 1 };
template <int KIND>
DI void phase_gemm(const u16* A, int lda, const u16* Wt, int K, int N, int rows, const float* xin, float* xout, u16* cb, int ldc, float scale, char* smem) {
  const int NT = N / 256;
  TileWalk<4> tw(rows / 256, NT);
  int mt = 0, nt = 0;
  bool have = tw.next(mt, nt);
  int rb = 0;
  if (have) { __syncthreads(); gemm_issue0<8>(A + (size_t)mt * 256 * lda, lda, Wt + (size_t)nt * 256 * K, K, smem, rb); }
  while (have) {
    f32x4 acc[8][4]; zero_acc<8>(acc);
    gemm_run<8>(acc, A + (size_t)mt * 256 * lda, lda, Wt + (size_t)nt * 256 * K, K, K, smem, true, rb);
    int mt2 = 0, nt2 = 0;
    const bool have2 = tw.next(mt2, nt2);
    if (have2) gemm_issue0<8>(A + (size_t)mt2 * 256 * lda, lda, Wt + (size_t)nt2 * 256 * K, K, smem, rb);
    if (KIND == EPI_RESID) {
      const float* xib = xin + (size_t)mt * 256 * 1024 + nt * 256;
      float* xob = xout + (size_t)mt * 256 * 1024 + nt * 256;
      epi_foreach<8>(acc, [&](int mi, int ni, int r, int c, f32x4& v) {
        const unsigned o = (unsigned)(r * 1024 + c);
        const f32x4 x = *(const f32x4*)(xib + o);
        *(f32x4*)(xob + o) = x + v;
      });
    } else {
      u16* cbb = cb + (size_t)mt * 256 * ldc + nt * 256;
      epi_foreach<8>(acc, [&](int mi, int ni, int r, int c, f32x4& v) { *(u32x2*)(cbb + (unsigned)(r * ldc + c)) = pack4(v * scale); });
    }
    mt = mt2; nt = nt2; have = have2;
  }
}

DI void phase_cross(const Params& p, int l, int grp, char* smem) {
  const u16* H = (const u16*)(p.ws + O_H);
  const u16* WQ = (const u16*)(p.ws + O_MQ) + (size_t)l * E_MQ;
  u16* Q = (u16*)(p.ws + O_Q);
  for (int it = blockIdx.x; it < BG * 4 * 32; it += gridDim.x) {
    const int qb = it & 31, hm = (it >> 5) & 3, bl = it >> 7;
    const size_t row0 = (size_t)bl * S + qb * 128;
    f32x4 acc[4][4]; zero_acc<4>(acc);
    gemm_main<4>(acc, H + row0 * 1024, 1024, WQ + (size_t)hm * 256 * 1024, 1024, 1024, smem);
    u16* qbase = Q + row0 * 1024 + hm * 256;
    epi_foreach<4>(acc, [&](int mi, int ni, int r, int c, f32x4& v) { *(u32x2*)(qbase + (unsigned)(r * 1024 + c)) = pack4(v * 0.0625f); });
    __threadfence_block();
    __syncthreads();
    cross_attn_item(p, l, grp, it, smem);
  }
}

DI void phase_convact(const Params& p, int l) {
  const u16* U = (const u16*)(p.ws + O_U);
  u16* ACT = (u16*)(p.ws + O_ACT);
  const float* cw = p.in[35] + (size_t)l * 3 * NFF2;
  const float* cbias = p.in[36] + (size_t)l * NFF2;
  constexpr int CH = DFF / 8;
  const int tid = otid();
#pragma unroll 1
  for (int idx = blockIdx.x * NTH + tid; idx < (TG / 8) * CH; idx += gridDim.x * NTH) {
    const int run = idx / CH, ch = idx - run * CH;
    const int tok0 = run * 8, s0 = tok0 & (S - 1);
    u32x4 ug[10], uv[10];
#pragma unroll
    for (int rr = 0; rr < 10; ++rr) {
      if (rr < 2 && s0 == 0) { ug[rr] = u32x4{0u, 0u, 0u, 0u}; uv[rr] = u32x4{0u, 0u, 0u, 0u}; }
      else {
        const u16* row = U + (size_t)(tok0 + rr - 2) * NFF2;
        ug[rr] = *(const u32x4*)(row + ch * 8); uv[rr] = *(const u32x4*)(row + DFF + ch * 8);
      }
    }
    float wg[3][8], wv[3][8], bg[8], bv[8];
#pragma unroll
    for (int jj = 0; jj < 3; ++jj)
#pragma unroll
      for (int e4 = 0; e4 < 2; ++e4) {
        const float4 a = *(const float4*)(cw + jj * NFF2 + ch * 8 + e4 * 4), b = *(const float4*)(cw + jj * NFF2 + DFF + ch * 8 + e4 * 4);
        wg[jj][e4 * 4] = a.x; wg[jj][e4 * 4 + 1] = a.y; wg[jj][e4 * 4 + 2] = a.z; wg[jj][e4 * 4 + 3] = a.w;
        wv[jj][e4 * 4] = b.x; wv[jj][e4 * 4 + 1] = b.y; wv[jj][e4 * 4 + 2] = b.z; wv[jj][e4 * 4 + 3] = b.w;
      }
#pragma unroll
    for (int e4 = 0; e4 < 2; ++e4) {
      const float4 a = *(const float4*)(cbias + ch * 8 + e4 * 4), b = *(const float4*)(cbias + DFF + ch * 8 + e4 * 4);
      bg[e4 * 4] = a.x; bg[e4 * 4 + 1] = a.y; bg[e4 * 4 + 2] = a.z; bg[e4 * 4 + 3] = a.w;
      bv[e4 * 4] = b.x; bv[e4 * 4 + 1] = b.y; bv[e4 * 4 + 2] = b.z; bv[e4 * 4 + 3] = b.w;
    }
#pragma unroll
    for (int t = 0; t < 8; ++t) {
      u32x4 o;
#pragma unroll
      for (int e2 = 0; e2 < 4; ++e2) {
        float g0 = bg[2 * e2], g1 = bg[2 * e2 + 1], v0 = bv[2 * e2], v1 = bv[2 * e2 + 1];
#pragma unroll
        for (int jj = 0; jj < 3; ++jj) {
          g0 += bflo(ug[t + jj][e2]) * wg[jj][2 * e2]; g1 += bfhi(ug[t + jj][e2]) * wg[jj][2 * e2 + 1];
          v0 += bflo(uv[t + jj][e2]) * wv[jj][2 * e2]; v1 += bfhi(uv[t + jj][e2]) * wv[jj][2 * e2 + 1];
        }
        o[e2] = pack2(silu(g0) * v0, silu(g1) * v1);
      }
      *(u32x4*)(ACT + (size_t)(tok0 + t) * DFF + ch * 8) = o;
    }
  }
}

__global__ void __launch_bounds__(NTH, 2) fwd_megakernel(Params p) {
  cg::grid_group grid = cg::this_grid();
  __shared__ __attribute__((aligned(1024))) char smem[SMEM_BYTES];
  int& s_item = *(int*)(smem + SMEM_BYTES - 64);
  XcdBarrier xb = xcd_barrier_post((unsigned*)(p.ws + O_XBAR));

  phase_prologue(p, smem);
  grid.sync();
  phase_kv_gemm(p, smem);

#pragma unroll 1
  for (int l = 0; l < NL; ++l) {
    xcd_barrier(xb);
    phase_norm((l == 0) ? p.in[0] : (const float*)p.out, p.in[3] + l * 1024, (u16*)(p.ws + O_HALL), T);
    xcd_barrier(xb);
    phase_gemm<EPI_BF16>((const u16*)(p.ws + O_HALL), 1024, (const u16*)(p.ws + O_WIN) + (size_t)l * E_WIN + (size_t)4864 * 1024, 1024, 1024, T,
                         nullptr, nullptr, (u16*)(p.ws + O_SEGD), 1024, 1.f, smem);
    xcd_barrier(xb);
    for (int it = blockIdx.x; it < T / 16; it += gridDim.x) rwkv_prep_item(p, l, it, smem);
#pragma unroll 1
    for (int grp = 0; grp < NGRP; ++grp) {
      const size_t xoff = (size_t)grp * TG * 1024;
      const float* xin = ((l == 0) ? p.in[0] : (const float*)p.out) + xoff;
      float* xout = p.out + xoff;
      u16* H = (u16*)(p.ws + O_H);
      xcd_barrier(xb);
      phase_norm(xin, p.in[3] + l * 1024, H, TG);
      xcd_barrier(xb);
      phase_gemm1(p, l, grp, smem);
      xcd_barrier(xb);
      phase_stage1(p, l, grp, smem, &s_item);
      xcd_barrier(xb);
      phase_stage2(p, l, grp, smem, &s_item);
      if (grp == 0) {
        xcd_barrier(xb);
        for (int it = blockIdx.x; it < T / 64; it += gridDim.x) rwkv_post_item(p, l, it);
      }
      xcd_barrier(xb);
      phase_merge(p, l, grp, smem);
      xcd_barrier(xb);
      phase_gemm<EPI_RESID>((const u16*)(p.ws + O_MERGED), 1024, (const u16*)(p.ws + O_MIX) + (size_t)l * E_MIX, 1024, 1024, TG, xin, xout, nullptr, 0, 1.f, smem);
      xcd_barrier(xb);
      phase_norm(xout, p.in[28] + l * 1024, H, TG);
      xcd_barrier(xb);
      phase_cross(p, l, grp, smem);
      xcd_barrier(xb);
      phase_gemm<EPI_RESID>((const u16*)(p.ws + O_O), 1024, (const u16*)(p.ws + O_MO) + (size_t)l * E_MO, 1024, 1024, TG, xout, xout, nullptr, 0, 1.f, smem);
      xcd_barrier(xb);
      phase_norm(xout, p.in[33] + l * 1024, H, TG);
      xcd_barrier(xb);
      phase_gemm<EPI_BF16>(H, 1024, (const u16*)(p.ws + O_FIN) + (size_t)l * E_FIN, 1024, NFF2, TG, nullptr, nullptr, (u16*)(p.ws + O_U), NFF2, 1.f, smem);
      xcd_barrier(xb);
      phase_convact(p, l);
      xcd_barrier(xb);
      phase_gemm<EPI_RESID>((const u16*)(p.ws + O_ACT), DFF, (const u16*)(p.ws + O_FOUT) + (size_t)l * E_FOUT, DFF, 1024, TG, xout, xout, nullptr, 0, 1.f, smem);
    }
  }
  xcd_barrier(xb);
  phase_final_norm(p.out, p.in[38]);
}

extern "C" void kernel_launch(void* const* d_in, const int* in_sizes, int n_in, void* d_out, int out_size, void* d_ws, size_t ws_size,
                              hipStream_t stream) {
  static int grid_blocks = 0;
  if (!grid_blocks) {
    int dev = 0, cus = 0, per_cu = 0;
    (void)hipGetDevice(&dev);
    (void)hipDeviceGetAttribute(&cus, hipDeviceAttributeMultiprocessorCount, dev);
    (void)hipOccupancyMaxActiveBlocksPerMultiprocessor(&per_cu, fwd_megakernel, NTH, 0);
    if (per_cu < 1) per_cu = 1;
    if (per_cu > 1) per_cu = 1;
    grid_blocks = cus * per_cu;
  }
  Params p{};
  for (int i = 0; i < 39; ++i) p.in[i] = (const float*)d_in[i];
  p.out = (float*)d_out;
  p.ws = (char*)d_ws;
  (void)hipMemsetAsync((char*)d_ws + O_XBAR, 0, XCD_BAR_WORDS * 4, stream);
  void* args[] = {&p};
  hipError_t e = hipLaunchCooperativeKernel((void*)fwd_megakernel, dim3(grid_blocks), dim3(NTH), args, 0, stream);
  if (e != hipSuccess) fprintf(stderr, "cooperative launch failed: %s (grid %d)\n", hipGetErrorString(e), grid_blocks);
}
```

```cpp
#include <hip/hip_runtime.h>
#include <hip/hip_cooperative_groups.h>
#include <stdint.h>
#include <stdio.h>
namespace cg = cooperative_groups;

#define DI __device__ __forceinline__
typedef unsigned short u16;
using bf16x8 = __attribute__((ext_vector_type(8))) short;
using s16x4  = __attribute__((ext_vector_type(4))) short;
using f32x4  = __attribute__((ext_vector_type(4))) float;
using u32x4  = __attribute__((ext_vector_type(4))) unsigned;
using u32x2  = __attribute__((ext_vector_type(2))) unsigned;

constexpr int NTH = 512;
constexpr int D = 1024, NB = 16, S = 4096, T = NB * S, NL = 2, MEM = 256;
constexpr int BG = 4, TG = BG * S, NGRP = NB / BG;
constexpr int NIN = 9984, DFF = 2816, NFF2 = 2 * DFF;
constexpr int NSG = 8960;
constexpr int GOFF = 4864;
constexpr int YW = 1024;
constexpr float EPS = 1e-5f;

constexpr size_t al(size_t x) { return (x + 255) & ~(size_t)255; }
constexpr size_t E_WIN = (size_t)NIN * D, E_PA = 1024 * 256, E_PB = 1024 * 512, E_PC = 1024 * 256, E_PD = 1024 * 256;
constexpr size_t E_MIX = 1024 * 1024, E_MQ = 1024 * 1024, E_MKV = 2048 * 1024, E_MO = 1024 * 1024;
constexpr size_t E_FIN = (size_t)NFF2 * D, E_FOUT = (size_t)D * DFF;
constexpr size_t O_WIN = 0;
constexpr size_t O_PA = O_WIN + al(NL * E_WIN * 2);
constexpr size_t O_PB = O_PA + al(NL * E_PA * 2);
constexpr size_t O_PC = O_PB + al(NL * E_PB * 2);
constexpr size_t O_PD = O_PC + al(NL * E_PC * 2);
constexpr size_t O_MIX = O_PD + al(NL * E_PD * 2);
constexpr size_t O_MQ = O_MIX + al(NL * E_MIX * 2);
constexpr size_t O_MKV = O_MQ + al(NL * E_MQ * 2);
constexpr size_t O_MO = O_MKV + al(NL * E_MKV * 2);
constexpr size_t O_FIN = O_MO + al(NL * E_MO * 2);
constexpr size_t O_FOUT = O_FIN + al(NL * E_FIN * 2);
constexpr size_t O_ROPE = O_FOUT + al(NL * E_FOUT * 2);
constexpr size_t O_MEMN = O_ROPE + al((size_t)T * 16 * 4);
constexpr size_t O_KV = O_MEMN + al((size_t)NL * 4096 * 1024 * 2);
constexpr size_t O_VFIRST = O_KV + al((size_t)NL * 4096 * 2048 * 2);
constexpr size_t O_SCAL = O_VFIRST + al((size_t)T * 256 * 2);
constexpr size_t O_BAR = O_SCAL + 128;
constexpr size_t O_CNT = O_SCAL + 256;
constexpr size_t SZ_RW = al((size_t)T * 256 * 2);
constexpr size_t O_XBAR = O_CNT + 2048;
constexpr size_t O_RWR = O_XBAR + 16384;
constexpr size_t O_RWK = O_RWR + SZ_RW, O_RWV = O_RWK + SZ_RW, O_RWKK = O_RWV + SZ_RW, O_RWKKA = O_RWKK + SZ_RW, O_RWG = O_RWKKA + SZ_RW;
constexpr size_t O_YD = O_RWG + SZ_RW;
constexpr size_t O_RWW = O_YD + SZ_RW;
constexpr size_t O_RWY = O_RWW + al((size_t)T * 256 * 4);
constexpr size_t O_RWRK = O_RWY + al((size_t)T * 256 * 4);
constexpr size_t O_TR = O_RWRK + al((size_t)T * 4 * 4);
constexpr size_t O_H = O_TR;
constexpr size_t O_SEG = O_H + al((size_t)TG * 1024 * 2);
constexpr size_t O_HGS = O_SEG + al((size_t)TG * NSG * 2);
constexpr size_t O_HGF = O_HGS + al((size_t)BG * 4 * 32 * 4096 * 4);
constexpr size_t O_OG = O_HGF + al((size_t)BG * 4 * 32 * 64 * 4);
constexpr size_t O_LSE = O_OG + al((size_t)TG * 768 * 2);
constexpr size_t O_Y = O_LSE + al((size_t)TG * 12 * 4);
constexpr size_t O_MERGED = O_Y + al((size_t)TG * YW * 2);
constexpr size_t WS_TOTAL = O_MERGED + al((size_t)TG * 1024 * 2);
constexpr size_t O_HALL = O_TR;
constexpr size_t O_SEGD = O_TR + al((size_t)T * 1024 * 2);
constexpr size_t O_Q = O_SEG;
constexpr size_t O_O = O_SEG + al((size_t)TG * 1024 * 2);
constexpr size_t O_U = O_SEG;
constexpr size_t O_ACT = O_SEG + al((size_t)TG * NFF2 * 2);
static_assert(O_ACT + (size_t)TG * DFF * 2 <= O_HGS, "U + ACT fit in SEG");
static_assert(O_SEGD + (size_t)T * 1024 * 2 <= WS_TOTAL, "front buffers fit in the transient region");
static_assert(WS_TOTAL <= ((size_t)1 << 30), "workspace fits 1 GiB");

constexpr int SMEM_BYTES = 163840;

struct Params {
  const float* in[39];
  float* out;
  char* ws;
};

DI int otid() { int t = threadIdx.x; asm volatile("" : "+v"(t)); return t; }
typedef __bf16 bf16x2_t __attribute__((ext_vector_type(2)));
typedef float f32x2_t __attribute__((ext_vector_type(2)));
DI unsigned pack2(float a, float b) { f32x2_t f = {a, b}; bf16x2_t r = __builtin_convertvector(f, bf16x2_t); return __builtin_bit_cast(unsigned, r); }
DI u16 f2bf(float x) { return (u16)(pack2(x, 0.f) & 0xffffu); }
DI float bf2f(u16 b) { return __uint_as_float(((unsigned)b) << 16); }
DI float bflo(unsigned u) { return __uint_as_float(u << 16); }
DI float bfhi(unsigned u) { return __uint_as_float(u & 0xffff0000u); }
DI float sigm(float x) { return __builtin_amdgcn_rcpf(1.f + __expf(-x)); }
DI float silu(float x) { return x * __builtin_amdgcn_rcpf(1.f + __expf(-x)); }
DI float wave_sum_slow(float v) {
#pragma unroll
  for (int o = 32; o > 0; o >>= 1) v += __shfl_xor(v, o);
  return v;
}
DI f32x4 mfma16(bf16x8 a, bf16x8 b, f32x4 c) { return __builtin_amdgcn_mfma_f32_16x16x32_bf16(a, b, c, 0, 0, 0); }
template <int CTRL> DI float dpp_mov(float x) {
  return __int_as_float(__builtin_amdgcn_update_dpp(0, __float_as_int(x), CTRL, 0xF, 0xF, true));
}
DI float red16(float x) {
  x += dpp_mov<0xB1>(x);
  x += dpp_mov<0x4E>(x);
  x += dpp_mov<0x141>(x);
  x += dpp_mov<0x140>(x);
  return x;
}
DI float wave_sum(float v) { v = red16(v); v += __shfl_xor(v, 16); v += __shfl_xor(v, 32); return v; }
DI void red16_2(float& a, float& b) {
  a += dpp_mov<0xB1>(a);  b += dpp_mov<0xB1>(b);
  a += dpp_mov<0x4E>(a);  b += dpp_mov<0x4E>(b);
  a += dpp_mov<0x141>(a); b += dpp_mov<0x141>(b);
  a += dpp_mov<0x140>(a); b += dpp_mov<0x140>(b);
}

#define XB_TMO      128
#define XB_XCNT(j)  (256  + 64 * (j))
#define XB_XSUB(j)  (1280 + 64 * (j))
#define XB_XGEN(j)  (2304 + 64 * (j))
#define XB_TOP      3328
#define XB_TOPGEN   3392
#define XCD_BAR_WORDS 3456
#define XB_SPIN_CAP (1u << 18)
#define LAS __attribute__((address_space(3)))
DI unsigned xb_ld(unsigned* p)              { return __hip_atomic_load(p, __ATOMIC_RELAXED, __HIP_MEMORY_SCOPE_AGENT); }
DI unsigned xb_add(unsigned* p, unsigned v) { return __hip_atomic_fetch_add(p, v, __ATOMIC_RELAXED, __HIP_MEMORY_SCOPE_AGENT); }
DI unsigned xb_xcc_id() { return (unsigned)__builtin_amdgcn_s_getreg((3 << 11) | 20) & 0xFu; }
#define XB_SPIN(cond, bar) do { unsigned _sp = 0; while (cond) { __builtin_amdgcn_s_sleep(1); \
    if ((++_sp & 255u) == 0u) { if (xb_ld(&(bar)[XB_TMO])) break; if (_sp > XB_SPIN_CAP) { atomicAdd(&(bar)[XB_TMO], 1u); break; } } } } while (0)
struct XcdBarrier { unsigned* bar; unsigned x; unsigned nloc, nx; };
DI XcdBarrier xcd_barrier_post(unsigned* bar) {
  XcdBarrier b; b.bar = bar; b.x = xb_xcc_id(); b.nloc = 0u; b.nx = 0u;
  if (threadIdx.x == 0) (void)xb_add(&bar[XB_XCNT(b.x)], 1u);
  return b;
}
DI void xcd_barrier_complete(unsigned* bar, unsigned x, unsigned& nloc, unsigned& nx) {
  const unsigned G = gridDim.x * gridDim.y * gridDim.z;
  unsigned sum, cnt, mine, sp = 0u;
  for (;;) {
    sum = 0u; cnt = 0u; mine = 0u;
#pragma unroll
    for (unsigned j = 0; j < 16; ++j) { const unsigned c = xb_ld(&bar[XB_XCNT(j)]); sum += c; cnt += (c > 0u) ? 1u : 0u; mine = (j == x) ? c : mine; }
    if (sum == G) break;
    __builtin_amdgcn_s_sleep(1);
    if ((++sp & 255u) == 0u) { if (xb_ld(&bar[XB_TMO])) break; if (sp > XB_SPIN_CAP) { atomicAdd(&bar[XB_TMO], 1u); break; } }
  }
  nloc = mine > 0u ? mine : 1u; nx = cnt > 0u ? cnt : 1u;
}
DI void xcd_barrier(XcdBarrier& b) {
  asm volatile("s_waitcnt vmcnt(0)" ::: "memory");
  __syncthreads();
  if (threadIdx.x == 0) {
    unsigned* bar = b.bar;
    __builtin_amdgcn_s_waitcnt(0);
    unsigned nloc = b.nloc, nx = b.nx;
    if (nloc == 0u) { xcd_barrier_complete(bar, b.x, nloc, nx); b.nloc = nloc; b.nx = nx; }
    const unsigned old = xb_add(&bar[XB_XSUB(b.x)], 1u);
    const unsigned gen = old / nloc;
    if (old + 1u == (gen + 1u) * nloc) {
      __builtin_amdgcn_fence(__ATOMIC_RELEASE, "agent");
      asm volatile("s_waitcnt vmcnt(0)" ::: "memory");
      const unsigned og = xb_add(&bar[XB_TOP], 1u);
      const unsigned tg = og / nx;
      if (og + 1u == (tg + 1u) * nx) xb_add(&bar[XB_TOPGEN], 1u);
      else XB_SPIN(xb_ld(&bar[XB_TOPGEN]) == tg, bar);
      __builtin_amdgcn_fence(__ATOMIC_ACQUIRE, "agent");
      xb_add(&bar[XB_XGEN(b.x)], 1u);
      asm volatile("s_waitcnt vmcnt(0)" ::: "memory");
    } else {
      XB_SPIN(xb_ld(&bar[XB_XGEN(b.x)]) == gen, bar);
      __builtin_amdgcn_fence(__ATOMIC_ACQUIRE, "agent");
      asm volatile("s_waitcnt vmcnt(0)" ::: "memory");
    }
  }
  __syncthreads();
}

DI int lds_byte2(int r, int c) {
  const int st = (r >> 4) * 2 + (c >> 5), ob = (r & 15) * 64 + (c & 31) * 2;
  return st * 1024 + (ob ^ (((ob >> 9) & 1) << 5));
}
typedef __attribute__((address_space(3))) unsigned* lds_u32_ptr;
template <int MI> struct GemmStage {
  static constexpr int AROWS = MI * 32, LA = AROWS / 128;
  static constexpr int A_BYTES = AROWS * 64, STAGE = A_BYTES + 256 * 64;
  static constexpr int LPS = LA + 2;
  unsigned aoff[LA], boff[2]; int wid;
  DI void init(long lda, long ldb) {
    const int tid = otid(), lane = tid & 63;
    wid = tid >> 6;
    const int sb = lane * 16, swz = sb ^ (((sb >> 9) & 1) << 5);
    const int rr = swz >> 6, cc = (swz & 63) >> 1;
#pragma unroll
    for (int i = 0; i < LA; ++i) aoff[i] = (unsigned)(((wid + 8 * i) * 16 + rr) * (int)lda + cc);
#pragma unroll
    for (int i = 0; i < 2; ++i) boff[i] = (unsigned)(((wid + 8 * i) * 16 + rr) * (int)ldb + cc);
  }
  DI void issue(const u16* __restrict__ A, const u16* __restrict__ Bt, int k0, char* buf) const {
#pragma unroll
    for (int i = 0; i < LA; ++i) __builtin_amdgcn_global_load_lds((const unsigned*)(A + aoff[i] + k0), (lds_u32_ptr)(buf + (wid + 8 * i) * 1024), 16, 0, 0);
#pragma unroll
    for (int i = 0; i < 2; ++i) __builtin_amdgcn_global_load_lds((const unsigned*)(Bt + boff[i] + k0), (lds_u32_ptr)(buf + A_BYTES + (wid + 8 * i) * 1024), 16, 0, 0);
  }
};
constexpr int NSTG = 5;
DI int ring_next(int b) { return (b + 1 == NSTG) ? 0 : b + 1; }
DI int ring_add(int b, int s) { int r = b + s; return (r >= NSTG) ? r - NSTG : r; }
template <int MI>
DI void gemm_issue0(const u16* __restrict__ A, long lda, const u16* __restrict__ Bt, long ldb, char* smem, int rb) {
  GemmStage<MI> gs; gs.init(lda, ldb);
#pragma unroll
  for (int s = 0; s < 4; ++s) gs.issue(A, Bt, s * 32, smem + ring_add(rb, s) * GemmStage<MI>::STAGE);
}
template <int MI>
DI void gemm_run(f32x4 (&acc)[MI][4], const u16* __restrict__ A, long lda, const u16* __restrict__ Bt, long ldb, int K, char* smem, bool preissued, int& rb) {
  constexpr int A_BYTES = GemmStage<MI>::A_BYTES, STAGE = GemmStage<MI>::STAGE, LPS = GemmStage<MI>::LPS;
  GemmStage<MI> gs; gs.init(lda, ldb);
  const int tid = otid(), lane = tid & 63, wid = tid >> 6, wr = wid >> 2, wc = wid & 3;
  const int li = lane & 15, lg = lane >> 4;
  const int fo = (li * 64 + lg * 16) ^ ((li >> 3) << 5);
  const int nk = K >> 5;
  if (!preissued) {
    __syncthreads();
#pragma unroll
    for (int s = 0; s < 4; ++s) gs.issue(A, Bt, s * 32, smem + ring_add(rb, s) * STAGE);
  }
  int cb = rb;
  for (int kk = 0; kk < nk; ++kk) {
    const int newer = nk - 1 - kk;
    if (newer == 0) asm volatile("s_waitcnt vmcnt(0)" ::: "memory");
    else if (newer == 1) asm volatile("s_waitcnt vmcnt(%0)" :: "n"(LPS) : "memory");
    else if (newer == 2) asm volatile("s_waitcnt vmcnt(%0)" :: "n"(2 * LPS) : "memory");
    else asm volatile("s_waitcnt vmcnt(%0)" :: "n"(3 * LPS) : "memory");
    asm volatile("s_waitcnt lgkmcnt(0)" ::: "memory");
    __builtin_amdgcn_s_barrier();
    asm volatile("" ::: "memory");
    char* cur = smem + cb * STAGE;
    {
      constexpr int NP = MI / 2;
      bf16x8 bq[4], ap[2][2];
      const char* aB = cur + (wr * MI) * 1024 + fo;
      const char* bB = cur + A_BYTES + (wc * 4) * 1024 + fo;
#pragma unroll
      for (int ni = 0; ni < 4; ++ni) bq[ni] = *(const bf16x8*)(bB + ni * 1024);
#pragma unroll
      for (int i = 0; i < 2; ++i) ap[0][i] = *(const bf16x8*)(aB + i * 1024);
      __builtin_amdgcn_sched_barrier(0);
      if (kk + 4 < nk) gs.issue(A, Bt, (kk + 4) << 5, smem + ring_add(cb, 4) * STAGE);
      __builtin_amdgcn_sched_barrier(0);
#pragma unroll
      for (int pp = 0; pp < NP; ++pp) {
        if (pp + 1 < NP) {
#pragma unroll
          for (int i = 0; i < 2; ++i) ap[(pp + 1) & 1][i] = *(const bf16x8*)(aB + (2 * (pp + 1) + i) * 1024);
        }
#pragma unroll
        for (int i = 0; i < 2; ++i)
#pragma unroll
          for (int ni = 0; ni < 4; ++ni) acc[2 * pp + i][ni] = mfma16(bq[ni], ap[pp & 1][i], acc[2 * pp + i][ni]);
        __builtin_amdgcn_sched_group_barrier(0x008, 1, 0);
        if (pp + 1 < NP) __builtin_amdgcn_sched_group_barrier(0x100, 2, 0);
        __builtin_amdgcn_sched_group_barrier(0x008, 7, 0);
        __builtin_amdgcn_sched_barrier(0);
      }
    }
    cb = ring_next(cb);
  }
  rb = cb;
}
template <int MI>
DI void gemm_main(f32x4 (&acc)[MI][4], const u16* __restrict__ A, long lda, const u16* __restrict__ Bt, long ldb, int K, char* smem) {
  int rb = 0;
  gemm_run<MI>(acc, A, lda, Bt, ldb, K, smem, false, rb);
}
template <int BH> struct TileWalk {
  int x, j, per, r, NT, total; bool plain;
  DI TileWalk(int MT, int NT_) : NT(NT_), total(MT * NT_) {
    plain = (gridDim.x & 7) != 0 || (MT % BH) != 0;
    x = blockIdx.x & 7; j = blockIdx.x >> 3; per = gridDim.x >> 3; r = 0;
  }
  DI bool next(int& mt, int& nt) {
    int tp;
    if (plain) tp = blockIdx.x + r * gridDim.x; else tp = (r * 8 + x) * per + j;
    ++r;
    if (tp >= total) return false;
    if (plain) { mt = tp / NT; nt = tp % NT; }
    else { const int band = tp / (BH * NT), idx = tp % (BH * NT); mt = band * BH + (idx % BH); nt = idx / BH; }
    return true;
  }
};
template <int MI> DI void zero_acc(f32x4 (&acc)[MI][4]) {
#pragma unroll
  for (int mi = 0; mi < MI; ++mi)
#pragma unroll
    for (int ni = 0; ni < 4; ++ni) acc[mi][ni] = f32x4{0.f, 0.f, 0.f, 0.f};
}
template <int MI, typename F> DI void epi_foreach(f32x4 (&acc)[MI][4], F&& f) {
  const int tid_ = otid(), lane_ = tid_ & 63, wid_ = tid_ >> 6, wr_ = wid_ >> 2, wc_ = wid_ & 3, li_ = lane_ & 15, lg_ = lane_ >> 4;
#pragma unroll
  for (int mi = 0; mi < MI; ++mi) {
    asm volatile("" ::: "memory");
#pragma unroll
    for (int ni = 0; ni < 4; ++ni) f(mi, ni, wr_ * (MI * 16) + mi * 16 + li_, wc_ * 64 + ni * 16 + lg_ * 4, acc[mi][ni]);
  }
}
DI u32x2 pack4(f32x4 v) { u32x2 o; o[0] = pack2(v[0], v[1]); o[1] = pack2(v[2], v[3]); return o; }

struct TrJob { const float* src; u16* dst; int K, N; };
DI TrJob tr_job(const Params& p, int j) {
  const int l = j / 11, w = j % 11;
  TrJob r;
  switch (w) {
    case 0: r = {p.in[4] + (size_t)l * E_WIN, (u16*)(p.ws + O_WIN) + (size_t)l * E_WIN, 1024, NIN}; break;
    case 1: r = {p.in[23] + (size_t)l * E_PA, (u16*)(p.ws + O_PA) + (size_t)l * E_PA, 256, 1024}; break;
    case 2: r = {p.in[24] + (size_t)l * E_PB, (u16*)(p.ws + O_PB) + (size_t)l * E_PB, 512, 1024}; break;
    case 3: r = {p.in[25] + (size_t)l * E_PC, (u16*)(p.ws + O_PC) + (size_t)l * E_PC, 256, 1024}; break;
    case 4: r = {p.in[26] + (size_t)l * E_PD, (u16*)(p.ws + O_PD) + (size_t)l * E_PD, 256, 1024}; break;
    case 5: r = {p.in[27] + (size_t)l * E_MIX, (u16*)(p.ws + O_MIX) + (size_t)l * E_MIX, 1024, 1024}; break;
    case 6: r = {p.in[30] + (size_t)l * E_MQ, (u16*)(p.ws + O_MQ) + (size_t)l * E_MQ, 1024, 1024}; break;
    case 7: r = {p.in[31] + (size_t)l * E_MKV, (u16*)(p.ws + O_MKV) + (size_t)l * E_MKV, 1024, 2048}; break;
    case 8: r = {p.in[32] + (size_t)l * E_MO, (u16*)(p.ws + O_MO) + (size_t)l * E_MO, 1024, 1024}; break;
    case 9: r = {p.in[34] + (size_t)l * E_FIN, (u16*)(p.ws + O_FIN) + (size_t)l * E_FIN, 1024, NFF2}; break;
    default: r = {p.in[37] + (size_t)l * E_FOUT, (u16*)(p.ws + O_FOUT) + (size_t)l * E_FOUT, DFF, 1024}; break;
  }
  return r;
}
DI int tr_tiles(int w) {
  switch (w) {
    case 0: return 16 * 156; case 1: return 4 * 16; case 2: return 8 * 16; case 3: return 4 * 16; case 4: return 4 * 16;
    case 5: return 256; case 6: return 256; case 7: return 16 * 32; case 8: return 256; case 9: return 16 * 88; default: return 44 * 16;
  }
}
constexpr int TR_TILES_L = 16 * 156 + 64 + 128 + 64 + 64 + 256 * 3 + 512 + 16 * 88 + 44 * 16;

DI void transpose_tile(const TrJob& jb, int tile, char* smem) {
  float* ts = (float*)smem;
  const int ntn = jb.N >> 6;
  const int k0 = (tile / ntn) << 6, n0 = (tile % ntn) << 6;
  const int tid = otid(), a = tid >> 6, b = tid & 63;
  __syncthreads();
#pragma unroll
  for (int i = 0; i < 8; ++i) { int k = i * 8 + a; ts[k * 65 + b] = jb.src[(size_t)(k0 + k) * jb.N + n0 + b]; }
  __syncthreads();
#pragma unroll
  for (int i = 0; i < 8; ++i) { int n = i * 8 + a; jb.dst[(size_t)(n0 + n) * jb.K + k0 + b] = f2bf(ts[b * 65 + n]); }
}

DI void sincos_acc(float ang, float& c, float& s) {
  double a = (double)ang;
  const double TWO_PI = 6.283185307179586476925;
  double n = rint(a / TWO_PI);
  double r = a - n * TWO_PI;
  double r2 = r * r;
  double sn = 0.0, cs = 0.0;
  double ts = r, tc = 1.0;
#pragma unroll
  for (int k = 0; k < 13; ++k) {
    cs += tc; sn += ts;
    tc = -tc * r2 / (double)((2 * k + 1) * (2 * k + 2));
    ts = -ts * r2 / (double)((2 * k + 2) * (2 * k + 3));
  }
  c = (float)cs; s = (float)sn;
}

DI void norm_row_bf16(const float* __restrict__ xr, const float* __restrict__ g, u16* __restrict__ outr, int lane) {
  float4 v[4]; float ss = 0.f;
#pragma unroll
  for (int i = 0; i < 4; ++i) { v[i] = ((const float4*)xr)[i * 64 + lane]; ss += v[i].x * v[i].x + v[i].y * v[i].y + v[i].z * v[i].z + v[i].w * v[i].w; }
  ss = wave_sum(ss);
  const float rstd = 1.0f / sqrtf(ss * (1.f / 1024.f) + EPS);
#pragma unroll
  for (int i = 0; i < 4; ++i) {
    float4 gg = ((const float4*)g)[i * 64 + lane];
    u32x2 o; o[0] = pack2(v[i].x * rstd * gg.x, v[i].y * rstd * gg.y); o[1] = pack2(v[i].z * rstd * gg.z, v[i].w * rstd * gg.w);
    *(u32x2*)(outr + (i * 64 + lane) * 4) = o;
  }
}

DI void phase_prologue(const Params& p, char* smem) {
  const int tid = otid(), lane = tid & 63, wave = tid >> 6;
  if (blockIdx.x == 0) {
    ((int*)(p.ws + O_CNT))[tid] = 0;
    if (tid < NL) {
      const float* lv = p.in[5] + tid * 256;
      float s1 = 0.f, s2 = 0.f;
      for (int i = 0; i < 64; ++i) { s1 += lv[i] * lv[64 + i]; s2 += lv[128 + i] * lv[192 + i]; }
      const float lam_init = (tid == 0) ? 0.2f : 0.355509067591f;
      ((float*)(p.ws + O_SCAL))[tid] = expf(s1) - expf(s2) + lam_init;
    }
  }
  for (int t = blockIdx.x; t < NL * TR_TILES_L; t += gridDim.x) {
    int l = t / TR_TILES_L, r = t % TR_TILES_L, w = 0;
    for (; w < 10; ++w) { int n = tr_tiles(w); if (r < n) break; r -= n; }
    TrJob jb = tr_job(p, l * 11 + w);
    transpose_tile(jb, r, smem);
  }
  {
    const int* pos = (const int*)p.in[2];
    float* tab = (float*)(p.ws + O_ROPE);
    for (int idx = blockIdx.x * NTH + tid; idx < T * 8; idx += gridDim.x * NTH) {
      const int t = idx >> 3, i = idx & 7;
      float invf;
      switch (i) {
        case 0: invf = 1.0f; break; case 1: invf = 0.1939227432012558f; break; case 2: invf = 0.03760603070259094f; break;
        case 3: invf = 0.007292664609849453f; break; case 4: invf = 0.0014142135623842478f; break; case 5: invf = 0.00027424818836152554f; break;
        case 6: invf = 5.3182957344688475e-05f; break; default: invf = 1.0313385246263351e-05f; break;
      }
      const float ang = (float)pos[t] * invf;
      float c, s; sincos_acc(ang, c, s);
      tab[t * 16 + i] = c; tab[t * 16 + 8 + i] = s;
    }
  }
  for (int row = blockIdx.x * 8 + wave; row < NL * 4096; row += gridDim.x * 8) {
    const int l = row >> 12, r = row & 4095;
    norm_row_bf16(p.in[1] + (size_t)r * 1024, p.in[29] + l * 1024, (u16*)(p.ws + O_MEMN) + (size_t)row * 1024, lane);
  }
}

DI void phase_kv_gemm(const Params& p, char* smem) {
  for (int t = blockIdx.x; t < NL * 16 * 8; t += gridDim.x) {
    const int l = t >> 7, r = t & 127, mt = r >> 3, nt = r & 7;
    f32x4 acc[8][4]; zero_acc<8>(acc);
    const u16* A = (const u16*)(p.ws + O_MEMN) + (size_t)l * 4096 * 1024 + (size_t)mt * 256 * 1024;
    const u16* B = (const u16*)(p.ws + O_MKV) + (size_t)l * E_MKV + (size_t)nt * 256 * 1024;
    gemm_main<8>(acc, A, 1024, B, 1024, 1024, smem);
    u16* C = (u16*)(p.ws + O_KV) + (size_t)l * 4096 * 2048 + (size_t)mt * 256 * 2048 + nt * 256;
    epi_foreach<8>(acc, [&](int mi, int ni, int r, int c, f32x4& v) { *(u32x2*)(C + (unsigned)(r * 2048 + c)) = pack4(v); });
  }
}

DI void phase_norm(const float* __restrict__ X, const float* __restrict__ g, u16* __restrict__ H, int rows) {
  const int tid = otid(), lane = tid & 63, wave = tid >> 6;
  for (int row = blockIdx.x * 8 + wave; row < rows; row += gridDim.x * 8)
    norm_row_bf16(X + (size_t)row * 1024, g, H + (size_t)row * 1024, lane);
}

DI void phase_final_norm(float* X, const float* __restrict__ g) {
  const int tid = otid(), lane = tid & 63, wave = tid >> 6;
  for (int row = blockIdx.x * 8 + wave; row < T; row += gridDim.x * 8) {
    float* xr = X + (size_t)row * 1024;
    float4 v[4]; float ss = 0.f;
#pragma unroll
    for (int i = 0; i < 4; ++i) { v[i] = ((const float4*)xr)[i * 64 + lane]; ss += v[i].x * v[i].x + v[i].y * v[i].y + v[i].z * v[i].z + v[i].w * v[i].w; }
    ss = wave_sum(ss);
    const float rstd = 1.0f / sqrtf(ss * (1.f / 1024.f) + EPS);
#pragma unroll
    for (int i = 0; i < 4; ++i) {
      float4 gg = ((const float4*)g)[i * 64 + lane];
      float4 o; o.x = v[i].x * rstd * gg.x; o.y = v[i].y * rstd * gg.y; o.z = v[i].z * rstd * gg.z; o.w = v[i].w * rstd * gg.w;
      ((float4*)xr)[i * 64 + lane] = o;
    }
  }
}

DI void phase_gemm1(const Params& p, int l, int grp, char* smem) {
  const u16* H = (const u16*)(p.ws + O_H);
  const u16* W = (const u16*)(p.ws + O_WIN) + (size_t)l * E_WIN;
  u16* SEG = (u16*)(p.ws + O_SEG);
  const float* tab = (const float*)(p.ws + O_ROPE) + (size_t)grp * TG * 16;
  constexpr int NT = NSG / 256;
  TileWalk<4> tw(TG / 256, NT);
  int mt = 0, nt = 0;
  bool have = tw.next(mt, nt);
  int rb = 0;
  if (have) { __syncthreads(); gemm_issue0<8>(H + (size_t)mt * 256 * 1024, 1024, W + (size_t)((nt < 19) ? nt * 256 : (nt + 4) * 256) * 1024, 1024, smem, rb); }
  while (have) {
    const int wrow = (nt < 19) ? nt * 256 : (nt + 4) * 256;
    f32x4 acc[8][4]; zero_acc<8>(acc);
    gemm_run<8>(acc, H + (size_t)mt * 256 * 1024, 1024, W + (size_t)wrow * 1024, 1024, 1024, smem, true, rb);
    int mt2 = 0, nt2 = 0;
    const bool have2 = tw.next(mt2, nt2);
    if (have2) gemm_issue0<8>(H + (size_t)mt2 * 256 * 1024, 1024, W + (size_t)((nt2 < 19) ? nt2 * 256 : (nt2 + 4) * 256) * 1024, 1024, smem, rb);
    u16* segb = SEG + (size_t)mt * 256 * NSG + nt * 256;
    const float* tabb = tab + (size_t)mt * 256 * 16;
    {
      const int tid_ = otid(), lane_ = tid_ & 63, wid_ = __builtin_amdgcn_readfirstlane(tid_ >> 6), wr_ = wid_ >> 2, wc_ = wid_ & 3;
      const int li_ = lane_ & 15, lg_ = lane_ >> 4;
#pragma unroll
      for (int ni = 0; ni < 4; ++ni) {
        const int cb = nt * 256 + wc_ * 64 + ni * 16;
        bool rot = false; float scale = 1.f;
        if (cb < 2304) { const int jj = (cb % 768) >> 8; rot = (jj < 2); if (jj == 0) scale = 0.125f; }
        else if (cb < 3840) { const int c2 = cb - 2304; rot = (c2 < 1024); if (c2 < 512) scale = 0.125f; }
        rot = rot && (ni == 0);
        const bool gate = (cb >= GOFF);
        const int c = wc_ * 64 + ni * 16 + lg_ * 4;
#pragma unroll
        for (int mi = 0; mi < 8; ++mi) {
          if ((mi & 1) == 0) asm volatile("" ::: "memory");
          const int r = wr_ * 128 + mi * 16 + li_;
          f32x4 o = acc[mi][ni];
          if (rot) {
            f32x4 other;
            other[0] = __shfl_xor(o[0], 32); other[1] = __shfl_xor(o[1], 32); other[2] = __shfl_xor(o[2], 32); other[3] = __shfl_xor(o[3], 32);
            const f32x4 cs = *(const f32x4*)(tabb + (unsigned)(r * 16 + (lg_ & 1) * 4));
            const f32x4 sn = *(const f32x4*)(tabb + (unsigned)(r * 16 + 8 + (lg_ & 1) * 4));
            o = (lg_ < 2) ? (o * cs - other * sn) : (o * cs + other * sn);
          }
          if (gate) { o[0] = sigm(o[0]); o[1] = sigm(o[1]); o[2] = sigm(o[2]); o[3] = sigm(o[3]); }
          *(u32x2*)(segb + (unsigned)(r * NSG + c)) = pack4(o * scale);
        }
      }
    }
    mt = mt2; nt = nt2; have = have2;
  }
}

template <int DK> struct TileRegs {
  static constexpr int CPR = DK / 8, NCH = (64 * CPR) / NTH;
  u32x4 r[NCH];
  DI void load(const u16* __restrict__ src, long row_stride, int tid) {
#pragma unroll
    for (int i = 0; i < NCH; ++i) { const int c = tid + NTH * i, row = c / CPR, kc = c % CPR; r[i] = *(const u32x4*)(src + (long)row * row_stride + kc * 8); }
  }
  DI void store(char* dst, int pad, int tid) const {
    const int rs = DK * 2 + pad;
#pragma unroll
    for (int i = 0; i < NCH; ++i) { const int c = tid + NTH * i, row = c / CPR, kc = c % CPR; *(u32x4*)(dst + row * rs + kc * 16) = r[i]; }
  }
};
template <int DK>
DI void attn_scores(f32x4 (&Sa)[4], const bf16x8 (&Qf)[DK / 32], const char* Ks, int li, int lg) {
  constexpr int RS = DK * 2 + 32, NKS = DK / 32;
  const char* kb = Ks + li * RS + lg * 16;
  if (DK == 64) {
    bf16x8 kf[4][NKS];
#pragma unroll
    for (int ksub = 0; ksub < 4; ++ksub)
#pragma unroll
      for (int ks = 0; ks < NKS; ++ks) kf[ksub][ks] = *(const bf16x8*)(kb + ksub * 16 * RS + ks * 64);
#pragma unroll
    for (int ks = 0; ks < NKS; ++ks)
#pragma unroll
      for (int ksub = 0; ksub < 4; ++ksub) Sa[ksub] = mfma16(kf[ksub][ks], Qf[ks], Sa[ksub]);
    __builtin_amdgcn_sched_group_barrier(0x100, 4 * NKS, 0);
    __builtin_amdgcn_sched_group_barrier(0x008, 4 * NKS, 0);
    __builtin_amdgcn_sched_barrier(0);
  } else {
    constexpr int HK = NKS / 2;
    bf16x8 kf[2][HK];
#pragma unroll
    for (int ks = 0; ks < HK; ++ks) kf[0][ks] = *(const bf16x8*)(kb + ks * 64);
#pragma unroll
    for (int g = 0; g < 8; ++g) {
      const int ksub = g >> 1, hf = g & 1;
      if (g + 1 < 8) {
        const int ks2 = (g + 1) >> 1, hf2 = (g + 1) & 1;
#pragma unroll
        for (int ks = 0; ks < HK; ++ks) kf[(g + 1) & 1][ks] = *(const bf16x8*)(kb + ks2 * 16 * RS + (hf2 * HK + ks) * 64);
      }
#pragma unroll
      for (int ks = 0; ks < HK; ++ks) Sa[ksub] = mfma16(kf[g & 1][ks], Qf[hf * HK + ks], Sa[ksub]);
      __builtin_amdgcn_sched_group_barrier(0x008, 1, 0);
      if (g + 1 < 8) __builtin_amdgcn_sched_group_barrier(0x100, HK, 0);
      __builtin_amdgcn_sched_group_barrier(0x008, HK - 1, 0);
      __builtin_amdgcn_sched_barrier(0);
    }
  }
}
DI void softmax_step(f32x4 (&Sa)[4], float& m, float& l, float& alpha, bf16x8 (&P)[2]) {
  float mx = -INFINITY;
#pragma unroll
  for (int ksub = 0; ksub < 4; ++ksub)
#pragma unroll
    for (int j = 0; j < 4; ++j) mx = fmaxf(mx, Sa[ksub][j]);
  mx = fmaxf(mx, __shfl_xor(mx, 16));
  mx = fmaxf(mx, __shfl_xor(mx, 32));
  const float mn = fmaxf(m, mx);
  const float ms = (mn == -INFINITY) ? 0.f : mn;
  alpha = __expf(m - ms);
  float ps = 0.f;
#pragma unroll
  for (int ksub = 0; ksub < 4; ++ksub)
#pragma unroll
    for (int j = 0; j < 4; ++j) { const float e = __expf(Sa[ksub][j] - ms); ps += e; Sa[ksub][j] = e; }
  l = l * alpha + ps;
  m = mn;
#pragma unroll
  for (int kp = 0; kp < 2; ++kp) {
    u32x4 u;
    u[0] = pack2(Sa[2 * kp][0], Sa[2 * kp][1]); u[1] = pack2(Sa[2 * kp][2], Sa[2 * kp][3]);
    u[2] = pack2(Sa[2 * kp + 1][0], Sa[2 * kp + 1][1]); u[3] = pack2(Sa[2 * kp + 1][2], Sa[2 * kp + 1][3]);
    P[kp] = __builtin_bit_cast(bf16x8, u);
  }
}
typedef __attribute__((address_space(3))) s16x4* lds_s16x4_ptr;
template <int DV, int NMAP>
DI void attn_pv_pipe(f32x4 (&O1)[DV / 16], f32x4 (&O2)[DV / 16], const bf16x8 (&P1)[2], const bf16x8 (&P2)[2], float a1, float a2,
                     const char* Vs, int li, int lg) {
  constexpr int RS = DV * 2 + 32, NB = DV / 16, NC = NB / 2;
#pragma unroll
  for (int dt = 0; dt < NB; ++dt) { O1[dt] *= a1; if (NMAP == 2) O2[dt] *= a2; }
  const char* b0 = Vs + (lg * 4 + (li >> 2)) * RS + (li & 3) * 8;
  s16x4 vlo[2][2][2], vhi[2][2][2];
#pragma unroll
  for (int dtl = 0; dtl < 2; ++dtl)
#pragma unroll
    for (int kp = 0; kp < 2; ++kp) {
      const char* b = b0 + kp * 32 * RS + dtl * 32;
      vlo[0][dtl][kp] = __builtin_amdgcn_ds_read_tr16_b64_v4i16((lds_s16x4_ptr)(b));
      vhi[0][dtl][kp] = __builtin_amdgcn_ds_read_tr16_b64_v4i16((lds_s16x4_ptr)(b + 16 * RS));
    }
#pragma unroll
  for (int c = 0; c < NC; ++c) {
    if (c + 1 < NC) {
#pragma unroll
      for (int dtl = 0; dtl < 2; ++dtl)
#pragma unroll
        for (int kp = 0; kp < 2; ++kp) {
          const char* b = b0 + kp * 32 * RS + (2 * (c + 1) + dtl) * 32;
          vlo[(c + 1) & 1][dtl][kp] = __builtin_amdgcn_ds_read_tr16_b64_v4i16((lds_s16x4_ptr)(b));
          vhi[(c + 1) & 1][dtl][kp] = __builtin_amdgcn_ds_read_tr16_b64_v4i16((lds_s16x4_ptr)(b + 16 * RS));
        }
    }
#pragma unroll
    for (int dtl = 0; dtl < 2; ++dtl)
#pragma unroll
      for (int kp = 0; kp < 2; ++kp) {
        const bf16x8 vf = __builtin_shufflevector(vlo[c & 1][dtl][kp], vhi[c & 1][dtl][kp], 0, 1, 2, 3, 4, 5, 6, 7);
        O1[2 * c + dtl] = mfma16(vf, P1[kp], O1[2 * c + dtl]);
        if (NMAP == 2) O2[2 * c + dtl] = mfma16(vf, P2[kp], O2[2 * c + dtl]);
      }
    __builtin_amdgcn_sched_group_barrier(0x008, 1, 0);
    if (c + 1 < NC) __builtin_amdgcn_sched_group_barrier(0x100, 8, 0);
    __builtin_amdgcn_sched_group_barrier(0x008, 4 * NMAP - 1, 0);
    __builtin_amdgcn_sched_barrier(0);
  }
}
template <int DV>
DI void attn_pv(f32x4 (&O)[DV / 16], const bf16x8 (&P)[2], float alpha, const char* Vs, int li, int lg) {
  attn_pv_pipe<DV, 1>(O, O, P, P, alpha, alpha, Vs, li, lg);
}

DI void dil_attn_item(const Params& p, int item, char* smem) {
  const int blk = item & 31, h = (item >> 5) & 3, gb = item >> 7, g = gb % 3, bl = gb / 3;
  const int dil = (g == 0) ? 1 : (g == 1 ? 4 : 16);
  const int nb = 32 / dil, r = blk / nb, n = blk % nb;
  const int tid = otid(), lane = tid & 63, wave = tid >> 6, li = lane & 15, lg = lane >> 4;
  const u16* SEG = (const u16*)(p.ws + O_SEG);
  const long tok0 = (long)bl * S;
  const int qcol = g * 768 + h * 64, kcol = qcol + 256, vcol = qcol + 512;
  const int qi = wave * 16 + li;
  const long qtok = tok0 + (long)(n * 128 + qi) * dil + r;
  bf16x8 Qf[2];
#pragma unroll
  for (int ks = 0; ks < 2; ++ks) Qf[ks] = *(const bf16x8*)(SEG + qtok * NSG + qcol + ks * 32 + lg * 8);
  f32x4 O[4];
  float m = -INFINITY, l = 0.f, alpha;
#pragma unroll
  for (int dt = 0; dt < 4; ++dt) O[dt] = f32x4{0.f, 0.f, 0.f, 0.f};
  char* Ks = smem; char* Vs = smem + 64 * 160;
  const int kt0 = (n == 0) ? 2 : 0;
  TileRegs<64> rk, rv;
  {
    const long s0 = (long)((n - 1) * 128 + kt0 * 64) * dil + r;
    rk.load(SEG + (tok0 + s0) * NSG + kcol, (long)dil * NSG, tid);
    rv.load(SEG + (tok0 + s0) * NSG + vcol, (long)dil * NSG, tid);
  }
  for (int kt = kt0; kt < 4; ++kt) {
    __syncthreads();
    rk.store(Ks, 32, tid); rv.store(Vs, 32, tid);
    __syncthreads();
    if (kt + 1 < 4) {
      const long s0 = (long)((n - 1) * 128 + (kt + 1) * 64) * dil + r;
      rk.load(SEG + (tok0 + s0) * NSG + kcol, (long)dil * NSG, tid);
      rv.load(SEG + (tok0 + s0) * NSG + vcol, (long)dil * NSG, tid);
    }
    const int qlo = wave * 16, klo = kt * 64;
    if (klo + 63 >= qlo && klo <= qlo + 15 + 128) {
      f32x4 Sa[4];
#pragma unroll
      for (int ks = 0; ks < 4; ++ks) Sa[ks] = f32x4{0.f, 0.f, 0.f, 0.f};
      attn_scores<64>(Sa, Qf, Ks, li, lg);
#pragma unroll
      for (int ksub = 0; ksub < 4; ++ksub)
#pragma unroll
        for (int j = 0; j < 4; ++j) {
          const int kj = klo + ksub * 16 + lg * 4 + j;
          const int dist = qi + 128 - kj;
          if (dist < 0 || dist > 128) Sa[ksub][j] = -INFINITY;
        }
      bf16x8 P[2];
      softmax_step(Sa, m, l, alpha, P);
      attn_pv<64>(O, P, alpha, Vs, li, lg);
    }
  }
  u16* OG = (u16*)(p.ws + O_OG);
  float* LSE = (float*)(p.ws + O_LSE);
  float lt = l; lt += __shfl_xor(lt, 16); lt += __shfl_xor(lt, 32);
  const float inv = 1.f / lt;
#pragma unroll
  for (int dt = 0; dt < 4; ++dt) {
    u32x2 o; o[0] = pack2(O[dt][0] * inv, O[dt][1] * inv); o[1] = pack2(O[dt][2] * inv, O[dt][3] * inv);
    *(u32x2*)(OG + qtok * 768 + g * 256 + h * 64 + dt * 16 + lg * 4) = o;
  }
  if (lg == 0) LSE[qtok * 12 + g * 4 + h] = m + __logf(lt);
}

DI void diff_attn_item(const Params& p, int l_, int item, char* smem) {
  const int n = 31 - (item & 31), h = (item >> 5) & 3, bl = item >> 7;
  const int tid = otid(), lane = tid & 63, wave = tid >> 6, li = lane & 15, lg = lane >> 4;
  const u16* SEG = (const u16*)(p.ws + O_SEG);
  const long tok0 = (long)bl * S;
  const int qcol = 2304 + h * 128, kcol = 2304 + 512 + h * 128, vcol = 2304 + 1024 + h * 128;
  const int qlo = n * 128 + wave * 16;
  const int q = qlo + li;
  bf16x8 Q1[2], Q2[2];
#pragma unroll
  for (int ks = 0; ks < 2; ++ks) {
    Q1[ks] = *(const bf16x8*)(SEG + (tok0 + q) * NSG + qcol + ks * 32 + lg * 8);
    Q2[ks] = *(const bf16x8*)(SEG + (tok0 + q) * NSG + qcol + 64 + ks * 32 + lg * 8);
  }
  f32x4 O1[8], O2[8];
  float m1 = -INFINITY, l1 = 0.f, m2 = -INFINITY, l2 = 0.f, alpha;
#pragma unroll
  for (int dt = 0; dt < 8; ++dt) { O1[dt] = f32x4{0.f, 0.f, 0.f, 0.f}; O2[dt] = f32x4{0.f, 0.f, 0.f, 0.f}; }
  char* K1s = smem; char* K2s = smem + 10240; char* Vs = smem + 20480;
  TileRegs<64> rk1, rk2; TileRegs<128> rv;
  rk1.load(SEG + tok0 * NSG + kcol, NSG, tid);
  rk2.load(SEG + tok0 * NSG + kcol + 64, NSG, tid);
  rv.load(SEG + tok0 * NSG + vcol, NSG, tid);
  const int nt = 2 * n + 2;
  for (int kt = 0; kt < nt; ++kt) {
    __syncthreads();
    rk1.store(K1s, 32, tid); rk2.store(K2s, 32, tid); rv.store(Vs, 32, tid);
    __syncthreads();
    if (kt + 1 < nt) {
      const long kr = tok0 + (kt + 1) * 64;
      rk1.load(SEG + kr * NSG + kcol, NSG, tid);
      rk2.load(SEG + kr * NSG + kcol + 64, NSG, tid);
      rv.load(SEG + kr * NSG + vcol, NSG, tid);
    }
    const int klo = kt * 64;
    if (klo <= qlo + 15) {
      const bool need_mask = (klo + 63 > qlo);
      bf16x8 P[2], Pb[2];
      float alpha2;
      f32x4 Sa[4], Sb[4];
#pragma unroll
      for (int ks = 0; ks < 4; ++ks) { Sa[ks] = f32x4{0.f, 0.f, 0.f, 0.f}; Sb[ks] = f32x4{0.f, 0.f, 0.f, 0.f}; }
      attn_scores<64>(Sa, Q1, K1s, li, lg);
      attn_scores<64>(Sb, Q2, K2s, li, lg);
      if (need_mask) {
#pragma unroll
        for (int ksub = 0; ksub < 4; ++ksub)
#pragma unroll
          for (int j = 0; j < 4; ++j) if (klo + ksub * 16 + lg * 4 + j > q) { Sa[ksub][j] = -INFINITY; Sb[ksub][j] = -INFINITY; }
      }
      softmax_step(Sa, m1, l1, alpha, P);
      softmax_step(Sb, m2, l2, alpha2, Pb);
      attn_pv_pipe<128, 2>(O1, O2, P, Pb, alpha, alpha2, Vs, li, lg);
    }
  }
  float lt1 = l1; lt1 += __shfl_xor(lt1, 16); lt1 += __shfl_xor(lt1, 32);
  float lt2 = l2; lt2 += __shfl_xor(lt2, 16); lt2 += __shfl_xor(lt2, 32);
  const float lam = ((const float*)(p.ws + O_SCAL))[l_];
  const float lam_init = (l_ == 0) ? 0.2f : 0.355509067591f;
  const float i1 = 1.f / lt1, i2 = lam / lt2;
  float ss = 0.f;
#pragma unroll
  for (int dt = 0; dt < 8; ++dt)
#pragma unroll
    for (int j = 0; j < 4; ++j) { const float o = O1[dt][j] * i1 - O2[dt][j] * i2; O1[dt][j] = o; ss += o * o; }
  ss += __shfl_xor(ss, 16); ss += __shfl_xor(ss, 32);
  const float rstd = (1.f - lam_init) / sqrtf(ss * (1.f / 128.f) + EPS);
  const float* ng = p.in[6] + l_ * 128;
  u16* Y = (u16*)(p.ws + O_Y);
#pragma unroll
  for (int dt = 0; dt < 8; ++dt) {
    const int dv = dt * 16 + lg * 4;
    const float4 gg = *(const float4*)(ng + dv);
    u32x2 o; o[0] = pack2(O1[dt][0] * rstd * gg.x, O1[dt][1] * rstd * gg.y); o[1] = pack2(O1[dt][2] * rstd * gg.z, O1[dt][3] * rstd * gg.w);
    *(u32x2*)(Y + (tok0 + q) * YW + 256 + h * 128 + dv) = o;
  }
}

DI void cross_attn_item(const Params& p, int l_, int grp, int item, char* smem) {
  const int qb = item & 31, hm = (item >> 5) & 3, bl = item >> 7;
  const int tid = otid(), lane = tid & 63, wave = tid >> 6, li = lane & 15, lg = lane >> 4;
  const u16* Q = (const u16*)(p.ws + O_Q);
  const u16* KV = (const u16*)(p.ws + O_KV) + (size_t)l_ * 4096 * 2048 + (size_t)(grp * BG + bl) * 256 * 2048;
  const long tok = (long)bl * S + qb * 128 + wave * 16 + li;
  bf16x8 Qf[8];
#pragma unroll
  for (int ks = 0; ks < 8; ++ks) Qf[ks] = *(const bf16x8*)(Q + tok * 1024 + hm * 256 + ks * 32 + lg * 8);
  f32x4 O[16];
#pragma unroll
  for (int dt = 0; dt < 16; ++dt) O[dt] = f32x4{0.f, 0.f, 0.f, 0.f};
  float m = -INFINITY, l = 0.f, alpha;
  char* Ks = smem; char* Vs = smem + 64 * 544;
  TileRegs<256> rk, rv;
  rk.load(KV + hm * 256, 2048, tid);
  rv.load(KV + 1024 + hm * 256, 2048, tid);
  for (int kt = 0; kt < 4; ++kt) {
    __syncthreads();
    rk.store(Ks, 32, tid); rv.store(Vs, 32, tid);
    __syncthreads();
    if (kt + 1 < 4) {
      rk.load(KV + (size_t)((kt + 1) * 64) * 2048 + hm * 256, 2048, tid);
      rv.load(KV + (size_t)((kt + 1) * 64) * 2048 + 1024 + hm * 256, 2048, tid);
    }
    f32x4 Sa[4];
#pragma unroll
    for (int ks = 0; ks < 4; ++ks) Sa[ks] = f32x4{0.f, 0.f, 0.f, 0.f};
    attn_scores<256>(Sa, Qf, Ks, li, lg);
    bf16x8 P[2];
    softmax_step(Sa, m, l, alpha, P);
    attn_pv<256>(O, P, alpha, Vs, li, lg);
  }
  float lt = l; lt += __shfl_xor(lt, 16); lt += __shfl_xor(lt, 32);
  const float inv = 1.f / lt;
  u16* OB = (u16*)(p.ws + O_O);
#pragma unroll
  for (int dt = 0; dt < 16; ++dt) {
    u32x2 o; o[0] = pack2(O[dt][0] * inv, O[dt][1] * inv); o[1] = pack2(O[dt][2] * inv, O[dt][3] * inv);
    *(u32x2*)(OB + tok * 1024 + hm * 256 + dt * 16 + lg * 4) = o;
  }
}

template <int PASS>
DI void hgrn_item(const Params& p, int l_, int item, char* smem) {
  const int c = item & 31, h = (item >> 5) & 3, bl = item >> 7;
  const int tid = otid(), v = tid & 63, kq = tid >> 6;
  float* sF = (float*)smem;
  float* sK = sF + 1024;
  float* sQ = sK + 1024;
  float* sI = sQ + 1024;
  float* sG = sI + 1024;
  float* sO = sG + 1024;
  const u16* SEG = (const u16*)(p.ws + O_SEG);
  float* HGS = (float*)(p.ws + O_HGS);
  float* HGF = (float*)(p.ws + O_HGF);
  const int arr = tid >> 7, stok = (tid >> 3) & 15, sch = tid & 7;
  const bool ld_on = (PASS == 3) || (arr == 1) || (arr == 2);
  const u16* sbase = SEG + ((size_t)bl * S + c * 128 + stok) * NSG + 3840 + arr * 256 + h * 64 + sch * 8;
  float lbv[8];
#pragma unroll
  for (int e = 0; e < 8; ++e) {
    lbv[e] = 0.f;
    if (l_ == 1) { const float* lg0 = p.in[7]; const int k = h * 64 + sch * 8 + e; lbv[e] = 1.f / (1.f + __expf(lg0[k] - lg0[256 + k])); }
  }
  u32x4 pre = u32x4{0u, 0u, 0u, 0u};
  if (ld_on) pre = *(const u32x4*)sbase;
  float s[8], Fp[8];
#pragma unroll
  for (int e = 0; e < 8; ++e) { s[e] = 0.f; Fp[e] = 1.f; }
  if (PASS == 3) {
#pragma unroll 4
    for (int cc = 0; cc < c; ++cc) {
      const size_t it = (size_t)((bl * 4 + h) * 32 + cc);
      const float* st = HGS + it * 4096;
      const float* ff = HGF + it * 64;
#pragma unroll
      for (int e = 0; e < 8; ++e) { const int k = kq * 8 + e; s[e] = ff[k] * s[e] + st[k * 64 + v]; }
    }
  }
#pragma unroll 1
  for (int sub = 0; sub < 8; ++sub) {
    const int t0 = c * 128 + sub * 16;
    __syncthreads();
    if (ld_on) {
      float x[8];
      x[0] = bflo(pre[0]); x[1] = bfhi(pre[0]); x[2] = bflo(pre[1]); x[3] = bfhi(pre[1]);
      x[4] = bflo(pre[2]); x[5] = bfhi(pre[2]); x[6] = bflo(pre[3]); x[7] = bfhi(pre[3]);
      const int o = stok * 64 + sch * 8;
      if (arr == 1) {
#pragma unroll
        for (int e = 0; e < 8; ++e) { sF[o + e] = lbv[e] + (1.f - lbv[e]) * sigm(x[e]); sK[o + e] = (1.f - lbv[e]) * sigm(-x[e]); }
      } else if (arr == 2) {
#pragma unroll
        for (int e = 0; e < 8; ++e) sI[o + e] = x[e];
      } else if (arr == 0) {
#pragma unroll
        for (int e = 0; e < 8; ++e) sQ[o + e] = silu(x[e]);
      } else {
#pragma unroll
        for (int e = 0; e < 8; ++e) sG[o + e] = silu(x[e]);
      }
    }
    __syncthreads();
    if (ld_on && sub + 1 < 8) pre = *(const u32x4*)(sbase + (size_t)(sub + 1) * 16 * NSG);
    {
      float ivn = sI[v];
      float4 fn[2], kn[2], qn[2];
#pragma unroll
      for (int e4 = 0; e4 < 2; ++e4) {
        fn[e4] = *(const float4*)(sF + kq * 8 + e4 * 4); kn[e4] = *(const float4*)(sK + kq * 8 + e4 * 4);
        if (PASS == 3) qn[e4] = *(const float4*)(sQ + kq * 8 + e4 * 4);
      }
#pragma unroll 4
      for (int tt = 0; tt < 16; ++tt) {
        const float iv = ivn;
        float4 fc[2], kc[2], qc[2];
#pragma unroll
        for (int e4 = 0; e4 < 2; ++e4) { fc[e4] = fn[e4]; kc[e4] = kn[e4]; if (PASS == 3) qc[e4] = qn[e4]; }
        {
          const int tn = (tt + 1) & 15;
          ivn = sI[tn * 64 + v];
#pragma unroll
          for (int e4 = 0; e4 < 2; ++e4) {
            fn[e4] = *(const float4*)(sF + tn * 64 + kq * 8 + e4 * 4); kn[e4] = *(const float4*)(sK + tn * 64 + kq * 8 + e4 * 4);
            if (PASS == 3) qn[e4] = *(const float4*)(sQ + tn * 64 + kq * 8 + e4 * 4);
          }
        }
        __builtin_amdgcn_sched_barrier(0);
        float o = 0.f;
#pragma unroll
        for (int e4 = 0; e4 < 2; ++e4) {
          const float4 f4 = fc[e4], k4 = kc[e4];
          s[e4 * 4 + 0] = f4.x * s[e4 * 4 + 0] + k4.x * iv;
          s[e4 * 4 + 1] = f4.y * s[e4 * 4 + 1] + k4.y * iv;
          s[e4 * 4 + 2] = f4.z * s[e4 * 4 + 2] + k4.z * iv;
          s[e4 * 4 + 3] = f4.w * s[e4 * 4 + 3] + k4.w * iv;
          if (PASS == 1) { Fp[e4 * 4 + 0] *= f4.x; Fp[e4 * 4 + 1] *= f4.y; Fp[e4 * 4 + 2] *= f4.z; Fp[e4 * 4 + 3] *= f4.w; }
          if (PASS == 3) {
            const float4 q4 = qc[e4];
            o += s[e4 * 4 + 0] * q4.x + s[e4 * 4 + 1] * q4.y + s[e4 * 4 + 2] * q4.z + s[e4 * 4 + 3] * q4.w;
          }
        }
        if (PASS == 3) sO[(tt * 8 + kq) * 64 + v] = o;
        __builtin_amdgcn_sched_barrier(0);
      }
    }
    if (PASS == 3) {
      __syncthreads();
      u16* Y = (u16*)(p.ws + O_Y);
      const float* ng = p.in[8] + l_ * 64;
#pragma unroll
      for (int i = 0; i < 2; ++i) {
        const int tt = i * 8 + kq;
        float o = 0.f;
#pragma unroll
        for (int qq = 0; qq < 8; ++qq) o += sO[(tt * 8 + qq) * 64 + v];
        const float ss = wave_sum(o * o);
        const float rstd = 1.0f / sqrtf(ss * (1.f / 64.f) + EPS);
        const size_t tok = (size_t)bl * S + t0 + tt;
        Y[tok * YW + 768 + h * 64 + v] = f2bf(o * rstd * ng[v] * sG[tt * 64 + v]);
      }
    }
  }
  if (PASS == 1) {
#pragma unroll
    for (int e = 0; e < 8; ++e) {
      HGS[(size_t)item * 4096 + (kq * 8 + e) * 64 + v] = s[e];
      if (v == 0) HGF[(size_t)item * 64 + kq * 8 + e] = Fp[e];
    }
  }
}

DI void rwkv_prep_item(const Params& p, int l_, int item, char* smem) {
  const int tid = otid(), lane = tid & 63, wave = tid >> 6, c = tid & 255, half = tid >> 8;
  float* lin = (float*)smem;
  float* vv = lin + 4096;
  float* t1 = vv + 4096;
  float* sV1 = t1 + 512;
  const u16* SEGD = (const u16*)(p.ws + O_SEGD);
  const float* mu = p.in[9] + l_ * 1024;
  const size_t tokb = (size_t)item * 16 + half * 8;
  u16* VF = (u16*)(p.ws + O_VFIRST);
  float xr[8], xk[8];
  float vfv[8];
  __syncthreads();
  {
    const float mr = mu[c], mk = mu[256 + c], mv = mu[512 + c], ml = mu[768 + c];
    u16 raw[9][4];
    const bool first0 = ((tokb & (S - 1)) == 0);
#pragma unroll
    for (int rr = 0; rr < 9; ++rr) {
      const u16* row = SEGD + (tokb + rr - 1) * 1024;
      if (rr == 0 && first0) { raw[rr][0] = 0; raw[rr][1] = 0; raw[rr][2] = 0; raw[rr][3] = 0; }
      else { raw[rr][0] = row[c]; raw[rr][1] = row[256 + c]; raw[rr][2] = row[512 + c]; raw[rr][3] = row[768 + c]; }
    }
    if (l_ == 1) {
#pragma unroll
      for (int tk = 0; tk < 8; ++tk) vfv[tk] = bf2f(VF[(tokb + tk) * 256 + c]);
      const float4* v1 = (const float4*)p.in[21];
#pragma unroll
      for (int i = 0; i < 4; ++i) ((float4*)sV1)[tid + NTH * i] = v1[tid + NTH * i];
    }
#pragma unroll
    for (int tk = 0; tk < 8; ++tk) {
      float a, b;
      a = bf2f(raw[tk + 1][0]); b = bf2f(raw[tk][0]); xr[tk] = a + (b - a) * mr;
      a = bf2f(raw[tk + 1][1]); b = bf2f(raw[tk][1]); xk[tk] = a + (b - a) * mk;
      a = bf2f(raw[tk + 1][2]); b = bf2f(raw[tk][2]); const float xv_ = a + (b - a) * mv;
      a = bf2f(raw[tk + 1][3]); b = bf2f(raw[tk][3]);
      float x = a + (b - a) * ml;
      if (c < 64) x = 1.f - 2.f / (__expf(2.f * x) + 1.f);
      else if (c >= 128) x = sigm(x);
      lin[(half * 8 + tk) * 256 + c] = x;
      vv[(half * 8 + tk) * 256 + c] = xv_;
    }
  }
  __syncthreads();
  float lw[8], la[8], lgg[8];
#pragma unroll
  for (int tk = 0; tk < 8; ++tk) { lw[tk] = 0.f; la[tk] = 0.f; lgg[tk] = 0.f; }
  const float* w2 = p.in[11] + l_ * 64 * 256;
  const float* a2 = p.in[13] + l_ * 64 * 256;
  const float* g2 = p.in[14] + l_ * 128 * 256;
  float wn[16];
#pragma unroll
  for (int j = 0; j < 16; ++j) wn[j] = w2[j * 256 + c];
#pragma unroll 1
  for (int ch = 0; ch < 16; ++ch) {
    float wr[16];
#pragma unroll
    for (int j = 0; j < 16; ++j) wr[j] = wn[j];
    if (ch + 1 < 16) {
      const int cn = ch + 1;
      const float* wsrc = (cn < 4) ? (w2 + cn * 16 * 256) : (cn < 8 ? (a2 + (cn - 4) * 16 * 256) : (g2 + (cn - 8) * 16 * 256));
#pragma unroll
      for (int j = 0; j < 16; ++j) wn[j] = wsrc[j * 256 + c];
    }
#pragma unroll
    for (int tk = 0; tk < 8; ++tk) {
      float acc = 0.f;
#pragma unroll
      for (int j4 = 0; j4 < 4; ++j4) {
        const float4 x4 = *(const float4*)(lin + (half * 8 + tk) * 256 + ch * 16 + j4 * 4);
        acc += x4.x * wr[j4 * 4] + x4.y * wr[j4 * 4 + 1] + x4.z * wr[j4 * 4 + 2] + x4.w * wr[j4 * 4 + 3];
      }
      if (ch < 4) lw[tk] += acc; else if (ch < 8) la[tk] += acc; else lgg[tk] += acc;
    }
  }
  float vmixw[8];
  if (l_ == 1) {
    {
      const int tk = tid >> 5, j0 = tid & 31;
      float a0 = 0.f, a1 = 0.f;
#pragma unroll 8
      for (int cc = 0; cc < 256; cc += 2) { a0 += vv[tk * 256 + cc] * sV1[cc * 32 + j0]; a1 += vv[tk * 256 + cc + 1] * sV1[(cc + 1) * 32 + j0]; }
      t1[tk * 32 + j0] = a0 + a1;
    }
    const float* v2 = p.in[22];
    float wr[32];
#pragma unroll
    for (int j = 0; j < 32; ++j) wr[j] = v2[j * 256 + c];
    __syncthreads();
#pragma unroll
    for (int tk = 0; tk < 8; ++tk) {
      float acc = 0.f;
#pragma unroll
      for (int j4 = 0; j4 < 8; ++j4) {
        const float4 x4 = *(const float4*)(t1 + (half * 8 + tk) * 32 + j4 * 4);
        acc += x4.x * wr[j4 * 4] + x4.y * wr[j4 * 4 + 1] + x4.z * wr[j4 * 4 + 2] + x4.w * wr[j4 * 4 + 3];
      }
      vmixw[tk] = acc;
    }
  }
  const float w0 = p.in[10][l_ * 256 + c], a0 = p.in[12][l_ * 256 + c];
  const float k_k = p.in[15][l_ * 256 + c], k_a = p.in[16][l_ * 256 + c], r_k = p.in[17][l_ * 256 + c];
  const float v0 = (l_ == 1) ? p.in[20][c] : 0.f;
  u16* RWR = (u16*)(p.ws + O_RWR); u16* RWK = (u16*)(p.ws + O_RWK); u16* RWV = (u16*)(p.ws + O_RWV);
  u16* RWKK = (u16*)(p.ws + O_RWKK); u16* RWKKA = (u16*)(p.ws + O_RWKKA); u16* RWG = (u16*)(p.ws + O_RWG);
  float* RWW = (float*)(p.ws + O_RWW); float* RWRK = (float*)(p.ws + O_RWRK);
#pragma unroll
  for (int tk = 0; tk < 8; ++tk) {
    const size_t tok = tokb + tk;
    const float xv_ = vv[(half * 8 + tk) * 256 + c];
    const float u = w0 + lw[tk];
    const float z = -u;
    const float sp = fmaxf(z, 0.f) + __logf(1.f + __expf(-fabsf(z)));
    const float wv = -sp - 0.5f;
    const float decay = __expf(-__expf(wv));
    const float a = sigm(a0 + la[tk]);
    const float kkx = xk[tk] * k_k;
    const float nrm = sqrtf(wave_sum(kkx * kkx));
    const float kkn = kkx / fmaxf(nrm, 1e-12f);
    const float k2 = xk[tk] * (1.f + (a - 1.f) * k_a);
    float v2v = xv_;
    if (l_ == 0) VF[tok * 256 + c] = f2bf(v2v);
    else v2v = v2v + (vfv[tk] - v2v) * sigm(v0 + vmixw[tk]);
    const float rk = wave_sum(xr[tk] * k2 * r_k);
    RWR[tok * 256 + c] = f2bf(xr[tk]);
    RWK[tok * 256 + c] = f2bf(k2);
    RWV[tok * 256 + c] = f2bf(v2v);
    RWKK[tok * 256 + c] = f2bf(kkn);
    RWKKA[tok * 256 + c] = f2bf(kkn * a);
    RWG[tok * 256 + c] = f2bf(lgg[tk]);
    RWW[tok * 256 + c] = decay;
    if (lane == 0) RWRK[tok * 4 + (wave & 3)] = rk;
  }
}

DI void rwkv_scan_item(const Params& p, int item, char* smem) {
  const int rg = item & 1, h = (item >> 1) & 3, b = item >> 3;
  const int tid = otid(), lane = tid & 63, wave = tid >> 6, kap = lane & 15, rho = lane >> 4;
  const int rowh = rg * 32 + wave * 4 + rho;
  float* sW = (float*)smem;
  float* sKK = sW + 2048;
  float* sKA = sKK + 2048;
  float* sK = sKA + 2048;
  float* sR = sK + 2048;
  float* sV = sR + 2048;
  float* sY = sV + 2048;
  const float* RWW = (const float*)(p.ws + O_RWW);
  const u16* RWR = (const u16*)(p.ws + O_RWR); const u16* RWK = (const u16*)(p.ws + O_RWK); const u16* RWV = (const u16*)(p.ws + O_RWV);
  const u16* RWKK = (const u16*)(p.ws + O_RWKK); const u16* RWKKA = (const u16*)(p.ws + O_RWKKA);
  float* RWY = (float*)(p.ws + O_RWY);
  const size_t tokb = (size_t)b * S;
  u32x4 pw, pa, pb, pv;
  const int wtok = tid >> 4, wch = tid & 15;
  const int hsel = tid >> 8, btok = (tid & 255) >> 3, bch = tid & 7;
  const u16* arrA = hsel ? RWKKA : RWKK;
  const u16* arrB = hsel ? RWR : RWK;
  float* dstA = hsel ? sKA : sKK;
  float* dstB = hsel ? sR : sK;
  const float sgnA = hsel ? 1.f : -1.f;
  pv = u32x4{0u, 0u, 0u, 0u};
  float S0 = 0.f, S1 = 0.f, S2 = 0.f, S3 = 0.f;
  {
    pw = *(const u32x4*)(RWW + (tokb + wtok) * 256 + h * 64 + wch * 4);
    const size_t off = (tokb + btok) * 256 + h * 64 + bch * 8;
    pa = *(const u32x4*)(arrA + off); pb = *(const u32x4*)(arrB + off);
    if (hsel == 0) pv = *(const u32x4*)(RWV + off);
  }
#pragma unroll 1
  for (int c = 0; c < S / 32; ++c) {
    __syncthreads();
    *(u32x4*)(sW + wtok * 64 + wch * 4) = pw;
    {
      float* da = dstA + btok * 64 + bch * 8; float* db = dstB + btok * 64 + bch * 8;
      *(f32x4*)(da) = f32x4{bflo(pa[0]) * sgnA, bfhi(pa[0]) * sgnA, bflo(pa[1]) * sgnA, bfhi(pa[1]) * sgnA};
      *(f32x4*)(da + 4) = f32x4{bflo(pa[2]) * sgnA, bfhi(pa[2]) * sgnA, bflo(pa[3]) * sgnA, bfhi(pa[3]) * sgnA};
      *(f32x4*)(db) = f32x4{bflo(pb[0]), bfhi(pb[0]), bflo(pb[1]), bfhi(pb[1])};
      *(f32x4*)(db + 4) = f32x4{bflo(pb[2]), bfhi(pb[2]), bflo(pb[3]), bfhi(pb[3])};
      if (hsel == 0) {
        float* dv = sV + btok * 64 + bch * 8;
        *(f32x4*)(dv) = f32x4{bflo(pv[0]), bfhi(pv[0]), bflo(pv[1]), bfhi(pv[1])};
        *(f32x4*)(dv + 4) = f32x4{bflo(pv[2]), bfhi(pv[2]), bflo(pv[3]), bfhi(pv[3])};
      }
    }
    __syncthreads();
    if (c + 1 < S / 32) {
      const size_t t0 = tokb + (size_t)(c + 1) * 32;
      pw = *(const u32x4*)(RWW + (t0 + wtok) * 256 + h * 64 + wch * 4);
      const size_t off = (t0 + btok) * 256 + h * 64 + bch * 8;
      pa = *(const u32x4*)(arrA + off); pb = *(const u32x4*)(arrB + off);
      if (hsel == 0) pv = *(const u32x4*)(RWV + off);
    }
    f32x4 w4n = *(const f32x4*)(sW + kap * 4), nk4n = *(const f32x4*)(sKK + kap * 4), ka4n = *(const f32x4*)(sKA + kap * 4);
    f32x4 k4n = *(const f32x4*)(sK + kap * 4), r4n = *(const f32x4*)(sR + kap * 4);
    float vvn = sV[rowh];
    f32x4 rprev = f32x4{0.f, 0.f, 0.f, 0.f};
#pragma unroll 4
    for (int tt = 0; tt < 32; ++tt) {
      const f32x4 w4 = w4n, nk4 = nk4n, ka4 = ka4n, k4 = k4n, r4 = r4n;
      const float vv = vvn;
      {
        const int tn = (tt + 1) & 31;
        w4n = *(const f32x4*)(sW + tn * 64 + kap * 4); nk4n = *(const f32x4*)(sKK + tn * 64 + kap * 4); ka4n = *(const f32x4*)(sKA + tn * 64 + kap * 4);
        k4n = *(const f32x4*)(sK + tn * 64 + kap * 4); r4n = *(const f32x4*)(sR + tn * 64 + kap * 4);
        vvn = sV[tn * 64 + rowh];
      }
      __builtin_amdgcn_sched_barrier(0);
      float sa, y;
      float u0, u1, u2, u3;
      {
        float a1 = S0 * nk4[0], b1 = S0 * rprev[0];
        float a2 = S2 * nk4[2], b2 = S2 * rprev[2];
        a1 = fmaf(S1, nk4[1], a1); b1 = fmaf(S1, rprev[1], b1);
        a2 = fmaf(S3, nk4[3], a2); b2 = fmaf(S3, rprev[3], b2);
        sa = a1 + a2; y = b1 + b2;
        u0 = vv * k4[0]; u1 = vv * k4[1];
        sa += dpp_mov<0xB1>(sa);  y += dpp_mov<0xB1>(y);
        u2 = vv * k4[2]; u3 = vv * k4[3];
        sa += dpp_mov<0x4E>(sa);  y += dpp_mov<0x4E>(y);
        u0 = fmaf(S0, w4[0], u0); u1 = fmaf(S1, w4[1], u1);
        sa += dpp_mov<0x141>(sa); y += dpp_mov<0x141>(y);
        u2 = fmaf(S2, w4[2], u2); u3 = fmaf(S3, w4[3], u3);
        sa += dpp_mov<0x140>(sa); y += dpp_mov<0x140>(y);
      }
      if (tt > 0 && kap == 0) sY[(tt - 1) * 32 + wave * 4 + rho] = y;
      S0 = fmaf(sa, ka4[0], u0);
      S1 = fmaf(sa, ka4[1], u1);
      S2 = fmaf(sa, ka4[2], u2);
      S3 = fmaf(sa, ka4[3], u3);
      rprev = r4;
      __builtin_amdgcn_sched_barrier(0);
    }
    {
      float y = (S0 * rprev[0] + S1 * rprev[1]) + (S2 * rprev[2] + S3 * rprev[3]);
      y = red16(y);
      if (kap == 0) sY[31 * 32 + wave * 4 + rho] = y;
    }
    __syncthreads();
    {
      const size_t t0 = tokb + (size_t)c * 32;
#pragma unroll
      for (int i = 0; i < 2; ++i) {
        const int idx = tid + NTH * i, tt = idx >> 5, rr = idx & 31;
        RWY[(t0 + tt) * 256 + h * 64 + rg * 32 + rr] = sY[idx];
      }
    }
  }
}

DI void rwkv_post_item(const Params& p, int l_, int item) {
  const int tid = otid(), lane = tid & 63, wave = tid >> 6, hd = lane >> 4, c = hd * 64 + (lane & 15) * 4;
  const float* RWY = (const float*)(p.ws + O_RWY);
  const float* RWRK = (const float*)(p.ws + O_RWRK);
  const u16* RWV = (const u16*)(p.ws + O_RWV); const u16* RWG = (const u16*)(p.ws + O_RWG);
  u16* YD = (u16*)(p.ws + O_YD);
  const f32x4 lg = *(const f32x4*)(p.in[18] + l_ * 256 + c), lb = *(const f32x4*)(p.in[19] + l_ * 256 + c);
#pragma unroll 1
  for (int ps = 0; ps < 2; ++ps) {
    f32x4 y[4]; u32x2 v2[4], g2[4]; float rk[4];
#pragma unroll
    for (int u = 0; u < 4; ++u) {
      const size_t tok = (size_t)item * 64 + (ps * 4 + u) * 8 + wave;
      y[u] = *(const f32x4*)(RWY + tok * 256 + c);
      v2[u] = *(const u32x2*)(RWV + tok * 256 + c); g2[u] = *(const u32x2*)(RWG + tok * 256 + c);
      rk[u] = RWRK[tok * 4 + hd];
    }
#pragma unroll
    for (int u = 0; u < 4; ++u) {
      const size_t tok = (size_t)item * 64 + (ps * 4 + u) * 8 + wave;
      const float mean = red16((y[u][0] + y[u][1]) + (y[u][2] + y[u][3])) * (1.f / 64.f);
      const f32x4 d = y[u] - mean;
      const float var = red16((d[0] * d[0] + d[1] * d[1]) + (d[2] * d[2] + d[3] * d[3])) * (1.f / 64.f);
      const float rs = 1.0f / sqrtf(var + 64e-5f);
      f32x4 o;
      o[0] = (d[0] * rs * lg[0] + lb[0] + rk[u] * bflo(v2[u][0])) * bflo(g2[u][0]);
      o[1] = (d[1] * rs * lg[1] + lb[1] + rk[u] * bfhi(v2[u][0])) * bfhi(g2[u][0]);
      o[2] = (d[2] * rs * lg[2] + lb[2] + rk[u] * bflo(v2[u][1])) * bflo(g2[u][1]);
      o[3] = (d[3] * rs * lg[3] + lb[3] + rk[u] * bfhi(v2[u][1])) * bfhi(g2[u][1]);
      *(u32x2*)(YD + tok * 256 + c) = pack4(o);
    }
  }
}

DI void dil_combine_item(const Params& p, int item) {
  const int tid = otid(), ch = tid & 31, tl = tid >> 5, h = ch >> 3;
  const u16* OG = (const u16*)(p.ws + O_OG);
  const float* LSE = (const float*)(p.ws + O_LSE);
  u16* Y = (u16*)(p.ws + O_Y);
  u32x4 o0[4], o1[4], o2[4]; float l0[4], l1[4], l2[4];
#pragma unroll
  for (int ps = 0; ps < 4; ++ps) {
    const size_t tok = (size_t)item * 64 + ps * 16 + tl;
    o0[ps] = *(const u32x4*)(OG + tok * 768 + ch * 8);
    o1[ps] = *(const u32x4*)(OG + tok * 768 + 256 + ch * 8);
    o2[ps] = *(const u32x4*)(OG + tok * 768 + 512 + ch * 8);
    l0[ps] = LSE[tok * 12 + h]; l1[ps] = LSE[tok * 12 + 4 + h]; l2[ps] = LSE[tok * 12 + 8 + h];
  }
#pragma unroll
  for (int ps = 0; ps < 4; ++ps) {
    const size_t tok = (size_t)item * 64 + ps * 16 + tl;
    const float mx = fmaxf(l0[ps], fmaxf(l1[ps], l2[ps]));
    float e0 = __expf(l0[ps] - mx), e1 = __expf(l1[ps] - mx), e2 = __expf(l2[ps] - mx);
    const float inv = 1.f / (e0 + e1 + e2);
    e0 *= inv; e1 *= inv; e2 *= inv;
    u32x4 r;
#pragma unroll
    for (int q = 0; q < 4; ++q)
      r[q] = pack2(e0 * bflo(o0[ps][q]) + e1 * bflo(o1[ps][q]) + e2 * bflo(o2[ps][q]), e0 * bfhi(o0[ps][q]) + e1 * bfhi(o1[ps][q]) + e2 * bfhi(o2[ps][q]));
    *(u32x4*)(Y + tok * YW + ch * 8) = r;
  }
}

DI int next_item(int* counter, int* s_item) {
  __syncthreads();
  if (otid() == 0) *s_item = atomicAdd(counter, 1);
  __syncthreads();
  return *s_item;
}
constexpr int N_DIL = BG * 3 * 4 * 32, N_HG = BG * 4 * 32;
constexpr int N_SCAN = NB * 8, N_DIFF = BG * 4 * 32, N_COMB = TG / 64;

DI void phase_stage1(const Params& p, int l, int grp, char* smem, int* s_item) {
  int* counter = (int*)(p.ws + O_CNT) + (l * NGRP + grp) * 2;
  const int nscan = (grp == 0) ? N_SCAN : 0;
  for (;;) {
    int it = next_item(counter, s_item);
    if (it >= nscan + N_DIFF + N_DIL + N_HG) break;
    if (it < nscan) { rwkv_scan_item(p, it, smem); continue; }
    it -= nscan;
    if (it < N_DIFF) { diff_attn_item(p, l, it, smem); continue; }
    it -= N_DIFF;
    if (it < N_DIL) dil_attn_item(p, it, smem);
    else hgrn_item<1>(p, l, it - N_DIL, smem);
  }
}
DI void phase_stage2(const Params& p, int l, int grp, char* smem, int* s_item) {
  int* counter = (int*)(p.ws + O_CNT) + (l * NGRP + grp) * 2 + 1;
  for (;;) {
    int it = next_item(counter, s_item);
    if (it >= N_HG + N_COMB) break;
    if (it < N_HG) hgrn_item<3>(p, l, it, smem);
    else dil_combine_item(p, it - N_HG);
  }
}

DI void phase_merge(const Params& p, int l, int grp, char* smem) {
  const u16* Y = (const u16*)(p.ws + O_Y);
  const u16* YD = (const u16*)(p.ws + O_YD) + (size_t)grp * TG * 256;
  const u16* SEG = (const u16*)(p.ws + O_SEG);
  u16* MG = (u16*)(p.ws + O_MERGED);
  auto sel = [&](int i, int mt, int nt, const u16*& Ai, int& lda, const u16*& Bi, int& Ki) {
    if (i == 0) { Ki = 256; Ai = Y + (size_t)mt * 128 * YW; lda = YW; Bi = (const u16*)(p.ws + O_PA) + (size_t)l * E_PA + (size_t)(nt * 256) * 256; }
    else if (i == 1) { Ki = 512; Ai = Y + (size_t)mt * 128 * YW + 256; lda = YW; Bi = (const u16*)(p.ws + O_PB) + (size_t)l * E_PB + (size_t)(nt * 256) * 512; }
    else if (i == 2) { Ki = 256; Ai = Y + (size_t)mt * 128 * YW + 768; lda = YW; Bi = (const u16*)(p.ws + O_PC) + (size_t)l * E_PC + (size_t)(nt * 256) * 256; }
    else { Ki = 256; Ai = YD + (size_t)mt * 128 * 256; lda = 256; Bi = (const u16*)(p.ws + O_PD) + (size_t)l * E_PD + (size_t)(nt * 256) * 256; }
  };
  TileWalk<8> tw(TG / 128, 4);
  int mt = 0, nt = 0, rb = 0;
  bool have = tw.next(mt, nt);
  if (have) {
    const u16* A0; const u16* B0; int lda0, K0; sel(0, mt, nt, A0, lda0, B0, K0);
    __syncthreads();
    gemm_issue0<4>(A0, lda0, B0, K0, smem, rb);
  }
  while (have) {
    int mt2 = 0, nt2 = 0;
    const bool have2 = tw.next(mt2, nt2);
    f32x4 accm[4][4]; zero_acc<4>(accm);
#pragma unroll 1
    for (int i = 0; i < 4; ++i) {
      f32x4 accp[4][4];
      zero_acc<4>(accp);
      const u16* Ai; const u16* Bi; int Ki, lda; sel(i, mt, nt, Ai, lda, Bi, Ki);
      gemm_run<4>(accp, Ai, lda, Bi, Ki, Ki, smem, true, rb);
      if (i < 3) { const u16* An; const u16* Bn; int ldn, Kn; sel(i + 1, mt, nt, An, ldn, Bn, Kn); gemm_issue0<4>(An, ldn, Bn, Kn, smem, rb); }
      else if (have2) { const u16* An; const u16* Bn; int ldn, Kn; sel(0, mt2, nt2, An, ldn, Bn, Kn); gemm_issue0<4>(An, ldn, Bn, Kn, smem, rb); }
      int mtx = mt; asm volatile("" : "+s"(mtx));
      const u16* gb = SEG + (size_t)mtx * 128 * NSG + GOFF + i * 1024 + nt * 256;
      epi_foreach<4>(accp, [&](int mi, int ni, int r, int c, f32x4& v) {
        const u32x2 g = *(const u32x2*)(gb + (unsigned)(r * NSG + c));
        accm[mi][ni][0] += bflo(g[0]) * v[0]; accm[mi][ni][1] += bfhi(g[0]) * v[1];
        accm[mi][ni][2] += bflo(g[1]) * v[2]; accm[mi][ni][3] += bfhi(g[1]) * v[3];
      });
    }
    u16* mgb = MG + (size_t)mt * 128 * 1024 + nt * 256;
    epi_foreach<4>(accm, [&](int mi, int ni, int r, int c, f32x4& v) { *(u32x2*)(mgb + (unsigned)(r * 1024 + c)) = pack4(v); });
    mt = mt2; nt = nt2; have = have2;
  }
}

enum { EPI_RESID = 0, EPI_BF16 = 1 };
template <int KIND>
DI void phase_gemm(const u16* A, int lda, const u16* Wt, int K, int N, int rows, const float* xin, float* xout, u16* cb, int ldc, float scale, char* smem) {
  const int NT = N / 256;
  TileWalk<4> tw(rows / 256, NT);
  int mt = 0, nt = 0;
  bool have = tw.next(mt, nt);
  int rb = 0;
  if (have) { __syncthreads(); gemm_issue0<8>(A + (size_t)mt * 256 * lda, lda, Wt + (size_t)nt * 256 * K, K, smem, rb); }
  while (have) {
    f32x4 acc[8][4]; zero_acc<8>(acc);
    gemm_run<8>(acc, A + (size_t)mt * 256 * lda, lda, Wt + (size_t)nt * 256 * K, K, K, smem, true, rb);
    int mt2 = 0, nt2 = 0;
    const bool have2 = tw.next(mt2, nt2);
    if (have2) gemm_issue0<8>(A + (size_t)mt2 * 256 * lda, lda, Wt + (size_t)nt2 * 256 * K, K, smem, rb);
    if (KIND == EPI_RESID) {
      const float* xib = xin + (size_t)mt * 256 * 1024 + nt * 256;
      float* xob = xout + (size_t)mt * 256 * 1024 + nt * 256;
      epi_foreach<8>(acc, [&](int mi, int ni, int r, int c, f32x4& v) {
        const unsigned o = (unsigned)(r * 1024 + c);
        const f32x4 x = *(const f32x4*)(xib + o);
        *(f32x4*)(xob + o) = x + v;
      });
    } else {
      u16* cbb = cb + (size_t)mt * 256 * ldc + nt * 256;
      epi_foreach<8>(acc, [&](int mi, int ni, int r, int c, f32x4& v) { *(u32x2*)(cbb + (unsigned)(r * ldc + c)) = pack4(v * scale); });
    }
    mt = mt2; nt = nt2; have = have2;
  }
}

DI void phase_cross(const Params& p, int l, int grp, char* smem) {
  const u16* H = (const u16*)(p.ws + O_H);
  const u16* WQ = (const u16*)(p.ws + O_MQ) + (size_t)l * E_MQ;
  u16* Q = (u16*)(p.ws + O_Q);
  for (int it = blockIdx.x; it < BG * 4 * 32; it += gridDim.x) {
    const int qb = it & 31, hm = (it >> 5) & 3, bl = it >> 7;
    const size_t row0 = (size_t)bl * S + qb * 128;
    f32x4 acc[4][4]; zero_acc<4>(acc);
    gemm_main<4>(acc, H + row0 * 1024, 1024, WQ + (size_t)hm * 256 * 1024, 1024, 1024, smem);
    u16* qbase = Q + row0 * 1024 + hm * 256;
    epi_foreach<4>(acc, [&](int mi, int ni, int r, int c, f32x4& v) { *(u32x2*)(qbase + (unsigned)(r * 1024 + c)) = pack4(v * 0.0625f); });
    __threadfence_block();
    __syncthreads();
    cross_attn_item(p, l, grp, it, smem);
  }
}

DI void phase_convact(const Params& p, int l) {
  const u16* U = (const u16*)(p.ws + O_U);
  u16* ACT = (u16*)(p.ws + O_ACT);
  const float* cw = p.in[35] + (size_t)l * 3 * NFF2;
  const float* cbias = p.in[36] + (size_t)l * NFF2;
  constexpr int CH = DFF / 8;
  const int tid = otid();
#pragma unroll 1
  for (int idx = blockIdx.x * NTH + tid; idx < (TG / 8) * CH; idx += gridDim.x * NTH) {
    const int run = idx / CH, ch = idx - run * CH;
    const int tok0 = run * 8, s0 = tok0 & (S - 1);
    u32x4 ug[10], uv[10];
#pragma unroll
    for (int rr = 0; rr < 10; ++rr) {
      if (rr < 2 && s0 == 0) { ug[rr] = u32x4{0u, 0u, 0u, 0u}; uv[rr] = u32x4{0u, 0u, 0u, 0u}; }
      else {
        const u16* row = U + (size_t)(tok0 + rr - 2) * NFF2;
        ug[rr] = *(const u32x4*)(row + ch * 8); uv[rr] = *(const u32x4*)(row + DFF + ch * 8);
      }
    }
    float wg[3][8], wv[3][8], bg[8], bv[8];
#pragma unroll
    for (int jj = 0; jj < 3; ++jj)
#pragma unroll
      for (int e4 = 0; e4 < 2; ++e4) {
        const float4 a = *(const float4*)(cw + jj * NFF2 + ch * 8 + e4 * 4), b = *(const float4*)(cw + jj * NFF2 + DFF + ch * 8 + e4 * 4);
        wg[jj][e4 * 4] = a.x; wg[jj][e4 * 4 + 1] = a.y; wg[jj][e4 * 4 + 2] = a.z; wg[jj][e4 * 4 + 3] = a.w;
        wv[jj][e4 * 4] = b.x; wv[jj][e4 * 4 + 1] = b.y; wv[jj][e4 * 4 + 2] = b.z; wv[jj][e4 * 4 + 3] = b.w;
      }
#pragma unroll
    for (int e4 = 0; e4 < 2; ++e4) {
      const float4 a = *(const float4*)(cbias + ch * 8 + e4 * 4), b = *(const float4*)(cbias + DFF + ch * 8 + e4 * 4);
      bg[e4 * 4] = a.x; bg[e4 * 4 + 1] = a.y; bg[e4 * 4 + 2] = a.z; bg[e4 * 4 + 3] = a.w;
      bv[e4 * 4] = b.x; bv[e4 * 4 + 1] = b.y; bv[e4 * 4 + 2] = b.z; bv[e4 * 4 + 3] = b.w;
    }
#pragma unroll
    for (int t = 0; t < 8; ++t) {
      u32x4 o;
#pragma unroll
      for (int e2 = 0; e2 < 4; ++e2) {
        float g0 = bg[2 * e2], g1 = bg[2 * e2 + 1], v0 = bv[2 * e2], v1 = bv[2 * e2 + 1];
#pragma unroll
        for (int jj = 0; jj < 3; ++jj) {
          g0 += bflo(ug[t + jj][e2]) * wg[jj][2 * e2]; g1 += bfhi(ug[t + jj][e2]) * wg[jj][2 * e2 + 1];
          v0 += bflo(uv[t + jj][e2]) * wv[jj][2 * e2]; v1 += bfhi(uv[t + jj][e2]) * wv[jj][2 * e2 + 1];
        }
        o[e2] = pack2(silu(g0) * v0, silu(g1) * v1);
      }
      *(u32x4*)(ACT + (size_t)(tok0 + t) * DFF + ch * 8) = o;
    }
  }
}

__global__ void __launch_bounds__(NTH, 2) fwd_megakernel(Params p) {
  cg::grid_group grid = cg::this_grid();
  __shared__ __attribute__((aligned(1024))) char smem[SMEM_BYTES];
  int& s_item = *(int*)(smem + SMEM_BYTES - 64);
  XcdBarrier xb = xcd_barrier_post((unsigned*)(p.ws + O_XBAR));

  phase_prologue(p, smem);
  grid.sync();
  phase_kv_gemm(p, smem);

#pragma unroll 1
  for (int l = 0; l < NL; ++l) {
    xcd_barrier(xb);
    phase_norm((l == 0) ? p.in[0] : (const float*)p.out, p.in[3] + l * 1024, (u16*)(p.ws + O_HALL), T);
    xcd_barrier(xb);
    phase_gemm<EPI_BF16>((const u16*)(p.ws + O_HALL), 1024, (const u16*)(p.ws + O_WIN) + (size_t)l * E_WIN + (size_t)4864 * 1024, 1024, 1024, T,
                         nullptr, nullptr, (u16*)(p.ws + O_SEGD), 1024, 1.f, smem);
    xcd_barrier(xb);
    for (int it = blockIdx.x; it < T / 16; it += gridDim.x) rwkv_prep_item(p, l, it, smem);
#pragma unroll 1
    for (int grp = 0; grp < NGRP; ++grp) {
      const size_t xoff = (size_t)grp * TG * 1024;
      const float* xin = ((l == 0) ? p.in[0] : (const float*)p.out) + xoff;
      float* xout = p.out + xoff;
      u16* H = (u16*)(p.ws + O_H);
      xcd_barrier(xb);
      phase_norm(xin, p.in[3] + l * 1024, H, TG);
      xcd_barrier(xb);
      phase_gemm1(p, l, grp, smem);
      xcd_barrier(xb);
      phase_stage1(p, l, grp, smem, &s_item);
      xcd_barrier(xb);
      phase_stage2(p, l, grp, smem, &s_item);
      if (grp == 0) {
        xcd_barrier(xb);
        for (int it = blockIdx.x; it < T / 64; it += gridDim.x) rwkv_post_item(p, l, it);
      }
      xcd_barrier(xb);
      phase_merge(p, l, grp, smem);
      xcd_barrier(xb);
      phase_gemm<EPI_RESID>((const u16*)(p.ws + O_MERGED), 1024, (const u16*)(p.ws + O_MIX) + (size_t)l * E_MIX, 1024, 1024, TG, xin, xout, nullptr, 0, 1.f, smem);
      xcd_barrier(xb);
      phase_norm(xout, p.in[28] + l * 1024, H, TG);
      xcd_barrier(xb);
      phase_cross(p, l, grp, smem);
      xcd_barrier(xb);
      phase_gemm<EPI_RESID>((const u16*)(p.ws + O_O), 1024, (const u16*)(p.ws + O_MO) + (size_t)l * E_MO, 1024, 1024, TG, xout, xout, nullptr, 0, 1.f, smem);
      xcd_barrier(xb);
      phase_norm(xout, p.in[33] + l * 1024, H, TG);
      xcd_barrier(xb);
      phase_gemm<EPI_BF16>(H, 1024, (const u16*)(p.ws + O_FIN) + (size_t)l * E_FIN, 1024, NFF2, TG, nullptr, nullptr, (u16*)(p.ws + O_U), NFF2, 1.f, smem);
      xcd_barrier(xb);
      phase_convact(p, l);
      xcd_barrier(xb);
      phase_gemm<EPI_RESID>((const u16*)(p.ws + O_ACT), DFF, (const u16*)(p.ws + O_FOUT) + (size_t)l * E_FOUT, DFF, 1024, TG, xout, xout, nullptr, 0, 1.f, smem);
    }
  }
  xcd_barrier(xb);
  phase_final_norm(p.out, p.in[38]);
}

extern "C" void kernel_launch(void* const* d_in, const int* in_sizes, int n_in, void* d_out, int out_size, void* d_ws, size_t ws_size,
                              hipStream_t stream) {
  static int grid_blocks = 0;
  if (!grid_blocks) {
    int dev = 0, cus = 0, per_cu = 0;
    (void)hipGetDevice(&dev);
    (void)hipDeviceGetAttribute(&cus, hipDeviceAttributeMultiprocessorCount, dev);
    (void)hipOccupancyMaxActiveBlocksPerMultiprocessor(&per_cu, fwd_megakernel, NTH, 0);
    if (per_cu < 1) per_cu = 1;
    if (per_cu > 1) per_cu = 1;
    grid_blocks = cus * per_cu;
  }
  Params p{};
  for (int i = 0; i < 39; ++i) p.in[i] = (const float*)d_in[i];
  p.out = (float*)d_out;
  p.ws = (char*)d_ws;
  (void)hipMemsetAsync((char*)d_ws + O_XBAR, 0, XCD_BAR_WORDS * 4, stream);
  void* args[] = {&p};
  hipError_t e = hipLaunchCooperativeKernel((void*)fwd_megakernel, dim3(grid_blocks), dim3(NTH), args, 0, stream);
  if (e != hipSuccess) fprintf(stderr, "cooperative launch failed: %s (grid %d)\n", hipGetErrorString(e), grid_blocks);
}
```
